# Optimizing an MI355X kernel written in HIP

```python
import math
import jax, jax.numpy as jnp
from jax import lax
import numpy as np

D_MODEL = 1024
BATCH = 8
SEQ = 4096
DEPTH = 1

ATT_HEADS = 16
ATT_KV_HEADS = 4
ATT_HEAD_DIM = D_MODEL // ATT_HEADS
ATT_WIDTH = ATT_HEADS * ATT_HEAD_DIM
ATT_KV_WIDTH = ATT_KV_HEADS * ATT_HEAD_DIM
WINDOW = 128
BLOCK = WINDOW
ROPE_THETA = 10000.0
M_HEADS = 4
M_HEAD_DIM = D_MODEL // M_HEADS
M_WIDTH = M_HEADS * M_HEAD_DIM
M_CHUNK = 64
CONV_WIDTH = 4
EPS = 1e-6
POS_OFFSET_MAX = 1024
IN_SPLITS = (ATT_WIDTH, ATT_KV_WIDTH, ATT_KV_WIDTH, ATT_WIDTH,
             M_WIDTH, M_WIDTH, M_WIDTH, M_WIDTH, M_WIDTH,
             M_HEADS, M_HEADS,
             D_MODEL, D_MODEL)
IN_WIDTH = sum(IN_SPLITS)

kernel_name = 'hybrid_swa_sink_mlstm_gated_adaln'


def rmsnorm(x, w):
    x32 = x.astype(jnp.float32)
    y = x32 * lax.rsqrt(jnp.mean(x32 * x32, axis=-1, keepdims=True) + EPS)
    return (y * w.astype(jnp.float32)).astype(x.dtype)


def rope(x, positions):
    hd = x.shape[-1]
    inv_freq = ROPE_THETA ** (-jnp.arange(0, hd, 2, dtype=jnp.float32) / hd)
    ang = positions.astype(jnp.float32)[..., None] * inv_freq
    cos = jnp.cos(ang)[:, :, None, :]
    sin = jnp.sin(ang)[:, :, None, :]
    x32 = x.astype(jnp.float32)
    x1, x2 = jnp.split(x32, 2, axis=-1)
    out = jnp.concatenate([x1 * cos - x2 * sin, x2 * cos + x1 * sin], axis=-1)
    return out.astype(x.dtype)


def sliding_window_attention(q, k, v, sinks):
    B, S, Hq, hd = q.shape
    Hkv = k.shape[2]
    G = Hq // Hkv
    NB = S // BLOCK
    qb = q.reshape(B, NB, BLOCK, Hkv, G, hd)
    kb = k.reshape(B, NB, BLOCK, Hkv, hd)
    vb = v.reshape(B, NB, BLOCK, Hkv, hd)
    pad = ((0, 0), (1, 0), (0, 0), (0, 0), (0, 0))
    kk = jnp.concatenate([jnp.pad(kb, pad)[:, :-1], kb], axis=2)
    vv = jnp.concatenate([jnp.pad(vb, pad)[:, :-1], vb], axis=2)
    scores = jnp.einsum('bnqhgd,bnkhd->bnhgqk', qb, kk).astype(jnp.float32) * (hd ** -0.5)
    q_in = BLOCK + jnp.arange(BLOCK)
    k_in = jnp.arange(2 * BLOCK)
    rel = q_in[:, None] - k_in[None, :]
    band = (rel >= 0) & (rel < WINDOW)
    key_abs = jnp.arange(NB)[:, None] * BLOCK - BLOCK + k_in[None, :]
    mask = band[None] & (key_abs >= 0)[:, None, :]
    scores = jnp.where(mask[None, :, None, None], scores, -jnp.inf)
    sink = sinks.astype(jnp.float32).reshape(1, 1, Hkv, G, 1, 1)
    mx = jnp.maximum(scores.max(axis=-1, keepdims=True), sink)
    p = jnp.exp(scores - mx)
    probs = p / (p.sum(axis=-1, keepdims=True) + jnp.exp(sink - mx))
    out = jnp.einsum('bnhgqk,bnkhd->bnqhgd', probs.astype(v.dtype), vv)
    return out.reshape(B, S, Hq * hd)


def causal_conv(x, w):
    S = x.shape[1]
    xp = jnp.pad(x, ((0, 0), (CONV_WIDTH - 1, 0), (0, 0)))
    return sum(w[j] * xp[:, j:j + S] for j in range(CONV_WIDTH))


def mlstm_chunkwise(q, k, v, i_pre, logf):
    B, S, H, d = q.shape
    L = M_CHUNK
    NC = S // L
    def chunks(t):
        return t.astype(jnp.float32).reshape(B, NC, L, H, d).transpose(1, 0, 3, 2, 4)
    def gchunks(t):
        return t.astype(jnp.float32).reshape(B, NC, L, H).transpose(1, 0, 3, 2)
    causal = jnp.tril(jnp.ones((L, L), dtype=bool))

    def step(carry, inp):
        C, n, m = carry
        qc, kc, vc, ic, fc = inp
        b = jnp.cumsum(fc, axis=-1)
        log_d = jnp.where(causal, b[..., :, None] - b[..., None, :] + ic[..., None, :], -jnp.inf)
        log_inter = b + m[..., None]
        m_t = jnp.maximum(log_inter, log_d.max(axis=-1))
        w_inter = jnp.exp(log_inter - m_t)
        s = jnp.einsum('bhtd,bhsd->bhts', qc, kc) * jnp.exp(log_d - m_t[..., None])
        num = w_inter[..., None] * jnp.einsum('bhtk,bhkv->bhtv', qc, C) + jnp.einsum('bhts,bhsv->bhtv', s, vc)
        nq = w_inter * jnp.einsum('bhtk,bhk->bht', qc, n) + s.sum(axis=-1)
        h = num / jnp.maximum(jnp.abs(nq), jnp.exp(-m_t))[..., None]
        b_last = b[..., -1]
        log_w = b_last[..., None] - b + ic
        m_new = jnp.maximum(b_last + m, log_w.max(axis=-1))
        decay = jnp.exp(b_last + m - m_new)
        w = jnp.exp(log_w - m_new[..., None])
        C_new = decay[..., None, None] * C + jnp.einsum('bhs,bhsk,bhsv->bhkv', w, kc, vc)
        n_new = decay[..., None] * n + jnp.einsum('bhs,bhsk->bhk', w, kc)
        return (C_new, n_new, m_new), h

    init = (jnp.zeros((B, H, d, d), jnp.float32), jnp.zeros((B, H, d), jnp.float32), jnp.zeros((B, H), jnp.float32))
    _, hs = lax.scan(step, init, (chunks(q), chunks(k), chunks(v), gchunks(i_pre), gchunks(logf)))
    return hs.transpose(1, 0, 3, 2, 4).reshape(B, S, H, d)


def setup_inputs(seed: int = 0) -> dict:
    key = jax.random.key(seed)
    ks = jax.random.split(key, 20)
    D = D_MODEL
    nrm = lambda k, shape, fan_in: jax.random.normal(k, shape, jnp.float32) * (fan_in ** -0.5)
    x = jax.random.normal(ks[0], (BATCH, SEQ, D), jnp.float32)
    c = jax.random.normal(ks[1], (BATCH, D), jnp.float32)
    offset = jax.random.randint(ks[2], (BATCH, 1), 0, POS_OFFSET_MAX, dtype=jnp.int32)
    positions = (offset + jnp.arange(SEQ, dtype=jnp.int32)[None, :]).astype(jnp.int32)
    w_ada = nrm(ks[3], (DEPTH, D, 3 * D), D)
    b_ada = 0.01 * jax.random.normal(ks[4], (DEPTH, 3 * D), jnp.float32)
    norm_w = 1.0 + 0.02 * jax.random.normal(ks[5], (DEPTH, D), jnp.float32)
    w_in = nrm(ks[6], (DEPTH, D, IN_WIDTH), D)
    b_i = 0.1 * jax.random.normal(ks[7], (DEPTH, M_HEADS), jnp.float32)
    b_f = jnp.linspace(3.0, 6.0, M_HEADS, dtype=jnp.float32)[None, :] + 0.1 * jax.random.normal(ks[8], (DEPTH, M_HEADS), jnp.float32)
    b_if = jnp.concatenate([b_i, b_f], axis=-1)
    att_sinks = 0.5 * jax.random.normal(ks[9], (DEPTH, ATT_HEADS), jnp.float32)
    conv_q = nrm(ks[10], (DEPTH, CONV_WIDTH, M_WIDTH), CONV_WIDTH)
    conv_k = nrm(ks[11], (DEPTH, CONV_WIDTH, M_WIDTH), CONV_WIDTH)
    m_norm_w = 1.0 + 0.02 * jax.random.normal(ks[12], (DEPTH, M_WIDTH), jnp.float32)
    w_att_branch = nrm(ks[13], (DEPTH, ATT_WIDTH, D), ATT_WIDTH)
    w_m_branch = nrm(ks[14], (DEPTH, M_WIDTH, D), M_WIDTH)
    w_out = nrm(ks[15], (DEPTH, D, D), D)
    final_norm_w = 1.0 + 0.02 * jax.random.normal(ks[16], (D,), jnp.float32)
    return {'x': x, 'c': c, 'positions': positions, 'w_ada': w_ada, 'b_ada': b_ada, 'norm_w': norm_w,
            'w_in': w_in, 'b_if': b_if, 'att_sinks': att_sinks, 'conv_q': conv_q, 'conv_k': conv_k,
            'm_norm_w': m_norm_w, 'w_att_branch': w_att_branch, 'w_m_branch': w_m_branch,
            'w_out': w_out, 'final_norm_w': final_norm_w}


def reference(x, c, positions, w_ada, b_ada, norm_w, w_in, b_if, att_sinks, conv_q, conv_k,
              m_norm_w, w_att_branch, w_m_branch, w_out, final_norm_w):
    B, S, _ = x.shape
    split_idx = np.cumsum(IN_SPLITS)[:-1].tolist()
    for l in range(DEPTH):
        mod = jax.nn.silu(c) @ w_ada[l] + b_ada[l]
        shift, scale, gate = jnp.split(mod, 3, axis=-1)
        h = rmsnorm(x, norm_w[l]) * (1.0 + scale[:, None, :]) + shift[:, None, :]
        proj = h @ w_in[l]
        aq, ak, av, az, mq, mk, mv, mo, mz, mi, mf, ga, gm = jnp.split(proj, split_idx, axis=-1)
        aq = rope(aq.reshape(B, S, ATT_HEADS, ATT_HEAD_DIM), positions)
        ak = rope(ak.reshape(B, S, ATT_KV_HEADS, ATT_HEAD_DIM), positions)
        av = av.reshape(B, S, ATT_KV_HEADS, ATT_HEAD_DIM)
        att = sliding_window_attention(aq, ak, av, att_sinks[l])
        y_att = (att * jax.nn.silu(az)) @ w_att_branch[l]
        mq = jax.nn.silu(causal_conv(mq, conv_q[l])).reshape(B, S, M_HEADS, M_HEAD_DIM)
        mk = (jax.nn.silu(causal_conv(mk, conv_k[l])) * (M_HEAD_DIM ** -0.5)).reshape(B, S, M_HEADS, M_HEAD_DIM)
        mv = mv.reshape(B, S, M_HEADS, M_HEAD_DIM)
        b_i, b_f = jnp.split(b_if[l], 2)
        i_pre = (mi + b_i).astype(jnp.float32)
        logf = jax.nn.log_sigmoid((mf + b_f).astype(jnp.float32))
        hm = mlstm_chunkwise(mq, mk, mv, i_pre, logf)
        hm = hm * lax.rsqrt(jnp.mean(hm * hm, axis=-1, keepdims=True) + EPS)
        hm = (hm.reshape(B, S, M_WIDTH) * m_norm_w[l].astype(jnp.float32)).astype(x.dtype)
        hm = hm * jax.nn.sigmoid(mo)
        y_m = (hm * jax.nn.silu(mz)) @ w_m_branch[l]
        merged = jax.nn.sigmoid(ga) * y_att + jax.nn.sigmoid(gm) * y_m
        x = x + gate[:, None, :] * (merged @ w_out[l])
    return rmsnorm(x, final_norm_w)
```

```cpp
#include <hip/hip_runtime.h>
#include <cstdio>
#include <cstdint>
template <int CTRL> __device__ __forceinline__ float dppf(float v) { return __builtin_bit_cast(float, __builtin_amdgcn_update_dpp(0, __builtin_bit_cast(int, v), CTRL, 0xf, 0xf, true)); }
template <int CTRL> __device__ __forceinline__ float dppf_id(float v, float ident) { return __builtin_bit_cast(float, __builtin_amdgcn_update_dpp(__builtin_bit_cast(int, ident), __builtin_bit_cast(int, v), CTRL, 0xf, 0xf, false)); }
__device__ __forceinline__ float row16_sum(float v) { v += dppf<0xB1>(v); v += dppf<0x4E>(v); v += dppf<0x141>(v); v += dppf<0x140>(v); return v; }
__device__ __forceinline__ float xor16_sum(float v) { float a = v, b = v; asm volatile("s_nop 1\n\tv_permlane16_swap_b32 %0, %1" : "+v"(a), "+v"(b)); return a + b; }
__device__ __forceinline__ float xor32_sum(float v) { float a = v, b = v; asm volatile("s_nop 1\n\tv_permlane32_swap_b32 %0, %1" : "+v"(a), "+v"(b)); return a + b; }
__device__ __forceinline__ float xor32_max(float v) { float a = v, b = v; asm volatile("s_nop 1\n\tv_permlane32_swap_b32 %0, %1" : "+v"(a), "+v"(b)); return fmaxf(a, b); }
__device__ __forceinline__ float wave_sum(float v) { return xor32_sum(xor16_sum(row16_sum(v))); }
__device__ __forceinline__ float lane_bcast(float v, int l) { return __builtin_bit_cast(float, __builtin_amdgcn_readlane(__builtin_bit_cast(int, v), l)); }
__device__ __forceinline__ float scan_sum64(float v, int lane) {
    v += dppf_id<0x111>(v, 0.f); v += dppf_id<0x112>(v, 0.f); v += dppf_id<0x114>(v, 0.f); v += dppf_id<0x118>(v, 0.f);
    const float t0 = lane_bcast(v, 15), t1 = lane_bcast(v, 31), t2 = lane_bcast(v, 47); const int row = lane >> 4;
    return v + (row >= 1 ? t0 : 0.f) + (row >= 2 ? t1 : 0.f) + (row >= 3 ? t2 : 0.f); }
__device__ __forceinline__ float scan_max64(float v, int lane) {
    const float NI = -__builtin_inff();
    v = fmaxf(v, dppf_id<0x111>(v, NI)); v = fmaxf(v, dppf_id<0x112>(v, NI)); v = fmaxf(v, dppf_id<0x114>(v, NI)); v = fmaxf(v, dppf_id<0x118>(v, NI));
    const float t0 = lane_bcast(v, 15), t1 = lane_bcast(v, 31), t2 = lane_bcast(v, 47); const int row = lane >> 4;
    return fmaxf(v, fmaxf(row >= 1 ? t0 : NI, fmaxf(row >= 2 ? t1 : NI, row >= 3 ? t2 : NI))); }
namespace pg8 {
#define PG8_LAS __attribute__((address_space(3)))
typedef unsigned short bf16_t;
typedef short bf16x8 __attribute__((ext_vector_type(8)));
typedef float f32x4 __attribute__((ext_vector_type(4)));
typedef unsigned u32x4 __attribute__((ext_vector_type(4)));
typedef unsigned u32x2 __attribute__((ext_vector_type(2)));
constexpr int BM = 256, BK = 64, HALF = 128, HTB = HALF * BK * 2  , STAGE_BYTES = 8 * HTB, NXCD = 8, WGM = 4;

__host__ __device__ __forceinline__ int lds_byte(int r, int c) { const int st = (r >> 4) * 2 + (c >> 5), rr = r & 15, cc = c & 31, ob = rr * 64 + cc * 2; return st * 1024 + (ob ^ (((ob >> 9) & 1) << 5)); }
__host__ __device__ __forceinline__ void stage_rc(int b, int& R, int& C) { const int st = b / 1024, sb = b % 1024, swz = sb ^ (((sb >> 9) & 1) << 5); R = (st >> 1) * 16 + swz / 64; C = (st & 1) * 32 + (swz % 64) / 2; }
__host__ __device__ __forceinline__ int perm32(int rho) { const int n = rho >> 4, i = rho & 15; return 8 * (i >> 2) + 4 * n + (i & 3); }

struct Unit { int pm, pn, seg; };
struct Gemm { const bf16_t* A; const bf16_t* Bt; int K, nt; };

struct StaticOrder {
    int nM, nN, nwg, G, c;
    __host__ __device__ void init(int M, int N, int G_, int c_) { nM = M / BM; nN = N / BM; nwg = nM * nN; G = G_; c = c_; }
    __host__ __device__ bool next(int i, Unit& u) const {
        const long L = (long)i * G + c; if (L >= nwg) return false;
        int wgid = (int)L; { const int q = nwg / NXCD, r = nwg % NXCD, xcd = wgid % NXCD, off = wgid / NXCD; wgid = (xcd < r ? xcd * (q + 1) : r * (q + 1) + (xcd - r) * q) + off; }
        const int nig = WGM * nN, gid = wgid / nig, fm = gid * WGM, gsz = (nM - fm) < WGM ? (nM - fm) : WGM;
        u.pm = fm + ((wgid % nig) % gsz); u.pn = (wgid % nig) / gsz; u.seg = 0; return true;
    }
    __device__ __forceinline__ void a_ready(const Unit&) const {}
    __device__ __forceinline__ void done(const Unit&) const {}
};
__device__ __forceinline__ unsigned cvt_pk_bf16(float lo, float hi) { unsigned r; asm volatile("v_cvt_pk_bf16_f32 %0, %1, %2" : "=v"(r) : "v"(lo), "v"(hi)); return r; }
__device__ __forceinline__ float bf_lo(unsigned w) { return __builtin_bit_cast(float, w << 16); }
__device__ __forceinline__ float bf_hi(unsigned w) { return __builtin_bit_cast(float, w & 0xffff0000u); }
__device__ __forceinline__ float sigmoidf_(float x) { return __builtin_amdgcn_rcpf(1.0f + __builtin_amdgcn_exp2f(-1.4426950408889634f * x)); }
__device__ __forceinline__ float og_(float mo, float mz) { return mz * __builtin_amdgcn_rcpf((1.0f + __builtin_amdgcn_exp2f(-1.4426950408889634f * mo)) * (1.0f + __builtin_amdgcn_exp2f(-1.4426950408889634f * mz))); }
typedef f32x4 acc_t[2][2][4][2];

struct EpiProj {
    static constexpr bool PERM = true; static constexpr int NT1 = 1 << 20; static constexpr ptrdiff_t DELTA_A = 0, DELTA_B = 0, SEG_A = 0, SEG_B = 0;
    bf16_t *Q, *Kb, *Vb, *AZ, *MQ, *MK, *MV, *OG, *GA, *GM; const int* pos;
    __device__ __forceinline__ void mid(acc_t&, const Unit&, int, int, int, int) const {}
    __device__ __forceinline__ void operator()(acc_t& acc, const Unit& u, int wr, int wc, int fr, int fq) const {
        asm volatile("" : "+v"(fr), "+v"(fq));
        const int pn = u.pn, row0 = u.pm * BM + wr * 64 + fr, cl = wc * 32 + 8 * fq;
        if (pn < 5) {
            const int i0 = 16 * (wc & 1) + 4 * fq;
            float cf[4];
#pragma unroll
            for (int e = 0; e < 4; ++e) cf[e] = __builtin_amdgcn_exp2f(-(float)(i0 + e) * (13.287712379549449f / 32.0f)) * 0.15915494309189535f;
            const float sc = (pn < 4) ? 0.125f * 1.4426950408889634f : 1.0f;
            bf16_t* base = (pn < 4) ? Q + (size_t)pn * BM : Kb; const int ld = (pn < 4) ? 1024 : 256;
#pragma unroll
            for (int ai = 0; ai < 2; ++ai)
#pragma unroll
                for (int m = 0; m < 4; ++m) { const int row = row0 + ai * HALF + m * 16; const float p = (float)pos[row];
                    float cs[4], sn[4];
#pragma unroll
                    for (int e = 0; e < 4; ++e) { const float rev = __builtin_amdgcn_fractf(p * cf[e]); sn[e] = __builtin_amdgcn_sinf(rev) * sc; cs[e] = __builtin_amdgcn_cosf(rev) * sc; }
#pragma unroll
                    for (int bj = 0; bj < 2; ++bj) { const f32x4 v0 = acc[ai][bj][m][0], v1 = acc[ai][bj][m][1]; u32x4 w;
                        w.x = cvt_pk_bf16(v0[0] * cs[0] - v0[1] * sn[0], v0[1] * cs[0] + v0[0] * sn[0]);
                        w.y = cvt_pk_bf16(v0[2] * cs[1] - v0[3] * sn[1], v0[3] * cs[1] + v0[2] * sn[1]);
                        w.z = cvt_pk_bf16(v1[0] * cs[2] - v1[1] * sn[2], v1[1] * cs[2] + v1[0] * sn[2]);
                        w.w = cvt_pk_bf16(v1[2] * cs[3] - v1[3] * sn[3], v1[3] * cs[3] + v1[2] * sn[3]);
                        __builtin_nontemporal_store(w, (u32x4*)(base + (size_t)row * ld + bj * HALF + cl)); } }
        } else if (pn >= 22 && pn < 30) {
            bf16_t* base = OG + (size_t)(pn - 22) * 128 + (cl >> 1);
#pragma unroll
            for (int ai = 0; ai < 2; ++ai)
#pragma unroll
                for (int m = 0; m < 4; ++m) { const int row = row0 + ai * HALF + m * 16;
#pragma unroll
                    for (int bj = 0; bj < 2; ++bj) { const f32x4 v0 = acc[ai][bj][m][0], v1 = acc[ai][bj][m][1]; u32x2 w;
                        w.x = cvt_pk_bf16(og_(v0[0], v0[1]), og_(v0[2], v0[3]));
                        w.y = cvt_pk_bf16(og_(v1[0], v1[1]), og_(v1[2], v1[3]));
                        __builtin_nontemporal_store(w, (u32x2*)(base + (size_t)row * 1024 + bj * 64)); } }
        } else {
            int act; bf16_t* base; int ld = 1024;
            if (pn == 5) { act = 0; base = Vb; ld = 256; }
            else if (pn < 10) { act = 1; base = AZ + (size_t)(pn - 6) * BM; }
            else if (pn < 14) { act = 0; base = MQ + (size_t)(pn - 10) * BM; }
            else if (pn < 18) { act = 0; base = MK + (size_t)(pn - 14) * BM; }
            else if (pn < 22) { act = 0; base = MV + (size_t)(pn - 18) * BM; }
            else if (pn < 34) { act = 2; base = GA + (size_t)(pn - 30) * BM; }
            else { act = 2; base = GM + (size_t)(pn - 34) * BM; }
#pragma unroll
            for (int ai = 0; ai < 2; ++ai)
#pragma unroll
                for (int m = 0; m < 4; ++m) { const int row = row0 + ai * HALF + m * 16;
#pragma unroll
                    for (int bj = 0; bj < 2; ++bj) { f32x4 v0 = acc[ai][bj][m][0], v1 = acc[ai][bj][m][1];
                        if (act) {
#pragma unroll
                            for (int e = 0; e < 4; ++e) { const float s0 = sigmoidf_(v0[e]), s1 = sigmoidf_(v1[e]); v0[e] = (act == 1) ? v0[e] * s0 : s0; v1[e] = (act == 1) ? v1[e] * s1 : s1; } }
                        u32x4 w; w.x = cvt_pk_bf16(v0[0], v0[1]); w.y = cvt_pk_bf16(v0[2], v0[3]); w.z = cvt_pk_bf16(v1[0], v1[1]); w.w = cvt_pk_bf16(v1[2], v1[3]);
                        __builtin_nontemporal_store(w, (u32x4*)(base + (size_t)row * ld + bj * HALF + cl)); } }
        }
    }
};

struct EpiMerge {
    static constexpr bool PERM = true; static constexpr int NT1 = 16; static constexpr ptrdiff_t DELTA_A = (ptrdiff_t)192 << 20, DELTA_B = (ptrdiff_t)2 << 20, SEG_A = 0, SEG_B = 0;
    const bf16_t *GA, *GM; bf16_t* OUT;
    __device__ __forceinline__ void mid(acc_t& acc, const Unit& u, int wr, int wc, int fr, int fq) const {
        asm volatile("" : "+v"(fr), "+v"(fq));
        const int row0 = u.pm * BM + wr * 64 + fr, col0 = u.pn * BM + wc * 32 + 8 * fq;
#pragma unroll
        for (int ai = 0; ai < 2; ++ai)
#pragma unroll
            for (int m = 0; m < 4; ++m)
#pragma unroll
                for (int bj = 0; bj < 2; ++bj) { const size_t o = (size_t)(row0 + ai * HALF + m * 16) * 1024 + col0 + bj * HALF;
                    const u32x4 a = *(const u32x4*)(GA + o), b = *(const u32x4*)(GM + o);
                    f32x4 r0, r1;
                    r0[0] = bf_lo(a.x) * __builtin_amdgcn_rcpf(fmaxf(bf_lo(b.x), 1e-30f)); r0[1] = bf_hi(a.x) * __builtin_amdgcn_rcpf(fmaxf(bf_hi(b.x), 1e-30f));
                    r0[2] = bf_lo(a.y) * __builtin_amdgcn_rcpf(fmaxf(bf_lo(b.y), 1e-30f)); r0[3] = bf_hi(a.y) * __builtin_amdgcn_rcpf(fmaxf(bf_hi(b.y), 1e-30f));
                    r1[0] = bf_lo(a.z) * __builtin_amdgcn_rcpf(fmaxf(bf_lo(b.z), 1e-30f)); r1[1] = bf_hi(a.z) * __builtin_amdgcn_rcpf(fmaxf(bf_hi(b.z), 1e-30f));
                    r1[2] = bf_lo(a.w) * __builtin_amdgcn_rcpf(fmaxf(bf_lo(b.w), 1e-30f)); r1[3] = bf_hi(a.w) * __builtin_amdgcn_rcpf(fmaxf(bf_hi(b.w), 1e-30f));
                    acc[ai][bj][m][0] *= r0; acc[ai][bj][m][1] *= r1; if (m == 3 && bj == 1) asm volatile("" ::: "memory"); }
    }
    __device__ __forceinline__ void operator()(acc_t& acc, const Unit& u, int wr, int wc, int fr, int fq) const {
        asm volatile("" : "+v"(fr), "+v"(fq));
        const int row0 = u.pm * BM + wr * 64 + fr, col0 = u.pn * BM + wc * 32 + 8 * fq;
#pragma unroll
        for (int ai = 0; ai < 2; ++ai)
#pragma unroll
            for (int m = 0; m < 4; ++m)
#pragma unroll
                for (int bj = 0; bj < 2; ++bj) { const size_t o = (size_t)(row0 + ai * HALF + m * 16) * 1024 + col0 + bj * HALF;
                    const u32x4 b = *(const u32x4*)(GM + o); const f32x4 v0 = acc[ai][bj][m][0], v1 = acc[ai][bj][m][1]; u32x4 w;
                    w.x = cvt_pk_bf16(v0[0] * bf_lo(b.x), v0[1] * bf_hi(b.x)); w.y = cvt_pk_bf16(v0[2] * bf_lo(b.y), v0[3] * bf_hi(b.y));
                    w.z = cvt_pk_bf16(v1[0] * bf_lo(b.z), v1[1] * bf_hi(b.z)); w.w = cvt_pk_bf16(v1[2] * bf_lo(b.w), v1[3] * bf_hi(b.w));
                    *(u32x4*)(OUT + o) = w; if (m == 3 && bj == 1) asm volatile("" ::: "memory"); }
    }
};

template <class Bar> struct EpiOutNorm {
    static constexpr bool PERM = true; static constexpr int NT1 = 1 << 20; static constexpr ptrdiff_t DELTA_A = 0, DELTA_B = 0, SEG_A = 0, SEG_B = 0;
    const float* X; const float* modacc; const float* b_ada; const float* fw; float* OUT; float* part; Bar bar;
    __device__ __forceinline__ void mid(acc_t&, const Unit&, int, int, int, int) const {}
    __device__ __forceinline__ void operator()(acc_t& acc, const Unit& u, int wr, int wc, int fr, int fq) const {
        asm volatile("" : "+v"(fr), "+v"(fq));
        const int row0 = u.pm * BM + wr * 64 + fr, col0 = u.pn * BM + wc * 32 + 8 * fq, b = (u.pm * BM) >> 12;
        {
            f32x4 gt[2][2];
#pragma unroll
            for (int bj = 0; bj < 2; ++bj)
#pragma unroll
                for (int n = 0; n < 2; ++n) gt[bj][n] = *(const f32x4*)(modacc + b * 3072 + 2048 + col0 + bj * HALF + 4 * n) + *(const f32x4*)(b_ada + 2048 + col0 + bj * HALF + 4 * n);
#pragma unroll
            for (int ai = 0; ai < 2; ++ai)
#pragma unroll
                for (int m = 0; m < 4; ++m) { const int row = row0 + ai * HALF + m * 16; float ss = 0.f;
#pragma unroll
                    for (int bj = 0; bj < 2; ++bj)
#pragma unroll
                        for (int n = 0; n < 2; ++n) { const size_t o = (size_t)row * 1024 + col0 + bj * HALF + 4 * n;
                            const f32x4 xv = *(const f32x4*)(X + o); const f32x4 y = xv + gt[bj][n] * acc[ai][bj][m][n];
                            acc[ai][bj][m][n] = y; ss += (y[0] * y[0] + y[1] * y[1]) + (y[2] * y[2] + y[3] * y[3]); }
                    ss = xor32_sum(xor16_sum(ss));
                    if (fq == 0) part[(size_t)row * 16 + u.pn * 4 + wc] = ss; if (m & 1) asm volatile("" ::: "memory"); }
        }
        bar();
        asm volatile("" : "+v"(fr), "+v"(fq));
        {
            const int row0b = u.pm * BM + wr * 64 + fr, col0b = u.pn * BM + wc * 32 + 8 * fq;
            f32x4 fv[2][2];
#pragma unroll
            for (int bj = 0; bj < 2; ++bj)
#pragma unroll
                for (int n = 0; n < 2; ++n) fv[bj][n] = *(const f32x4*)(fw + col0b + bj * HALF + 4 * n);
#pragma unroll
            for (int ai = 0; ai < 2; ++ai)
#pragma unroll
                for (int m = 0; m < 4; ++m) { const int row = row0b + ai * HALF + m * 16; const f32x4* pp = (const f32x4*)(part + (size_t)row * 16);
                    const f32x4 p0 = pp[0], p1 = pp[1], p2 = pp[2], p3 = pp[3];
                    const float s = ((p0[0] + p0[1]) + (p0[2] + p0[3])) + ((p1[0] + p1[1]) + (p1[2] + p1[3])) + ((p2[0] + p2[1]) + (p2[2] + p2[3])) + ((p3[0] + p3[1]) + (p3[2] + p3[3]));
                    const float rstd = 1.0f / sqrtf(s * (1.f / 1024.f) + 1e-6f);
#pragma unroll
                    for (int bj = 0; bj < 2; ++bj)
#pragma unroll
                        for (int n = 0; n < 2; ++n) *(f32x4*)(OUT + (size_t)row * 1024 + col0b + bj * HALF + 4 * n) = acc[ai][bj][m][n] * rstd * fv[bj][n];
                    if (m == 3) asm volatile("" ::: "memory"); }
        }
    }
};

template <class Epi, class Sched, bool ALIGN_EPI = true>
__device__ __forceinline__ void gemm_phase(PG8_LAS unsigned char* lds, const Gemm g, const Sched& S, const Epi& E) {
    const int tid = threadIdx.x, wid = __builtin_amdgcn_readfirstlane(tid >> 6), lane = tid & 63, wr = wid >> 2, wc = wid & 3, fr = lane & 15, fq = lane >> 4;
    const int K = g.K, nt = g.nt; constexpr int nt1 = Epi::NT1;
    unsigned voffA[2], voffB[2];
#pragma unroll
    for (int i = 0; i < 2; ++i) { int R, C; stage_rc(tid * 16 + i * 8192, R, C); const int Rb = Epi::PERM ? ((R & ~31) + perm32(R & 31)) : R;
        voffA[i] = (unsigned)(R * K + C) * 2u; voffB[i] = (unsigned)(Rb * K + C) * 2u; }
    const size_t kstep = (size_t)(BK * 2);
    const size_t hstep = (size_t)HALF * K * 2;
    const size_t tstep = 2 * hstep;
    const unsigned ldsw = (unsigned)wid * 1024u;
    const int aoff = lds_byte(wr * 64 + fr, fq * 8), boff = lds_byte(wc * 32 + fr, fq * 8);
#define PG8_SA(b, h) (((b) * 2 + (h)) * HTB)
#define PG8_SB(b, h) ((4 + (b) * 2 + (h)) * HTB)
#define PG8_STAGE(bufoff, gbase, voff) do { _Pragma("unroll") for (int _i = 0; _i < 2; ++_i) \
        __builtin_amdgcn_global_load_lds((const unsigned*)((const char*)(gbase) + (voff)[_i]), (PG8_LAS unsigned*)(lds + (bufoff) + ldsw + _i * 8192), 16, 0, 0); } while (0)
#define PG8_LDA(dst, b, h) do { _Pragma("unroll") for (int m = 0; m < 4; ++m) _Pragma("unroll") for (int k = 0; k < 2; ++k) dst[m][k] = *(const PG8_LAS bf16x8*)(lds + PG8_SA(b, h) + aoff + m * 2048 + k * 1024); } while (0)
#define PG8_LDB(dst, b, h) do { _Pragma("unroll") for (int n = 0; n < 2; ++n) _Pragma("unroll") for (int k = 0; k < 2; ++k) dst[n][k] = *(const PG8_LAS bf16x8*)(lds + PG8_SB(b, h) + boff + n * 2048 + k * 1024); } while (0)
#define PG8_MMA(ai, bj, At, Bt) do { __builtin_amdgcn_s_setprio(1); _Pragma("unroll") for (int m = 0; m < 4; ++m) _Pragma("unroll") for (int n = 0; n < 2; ++n) _Pragma("unroll") for (int k = 0; k < 2; ++k) \
        acc[ai][bj][m][n] = __builtin_amdgcn_mfma_f32_16x16x32_bf16(Bt[n][k], At[m][k], acc[ai][bj][m][n], 0, 0, 0); __builtin_amdgcn_s_setprio(0); } while (0)
#define PG8_WAIT_V(n) asm volatile("s_waitcnt vmcnt(" #n ")" ::: "memory")
#define PG8_WAIT_L(n) asm volatile("s_waitcnt lgkmcnt(" #n ")" ::: "memory")
#define PG8_BAR __builtin_amdgcn_s_barrier()
#define PG8_SCHED __builtin_amdgcn_sched_barrier(0)
#define PG8_TP(c0, dl, tt) ((c0) + ((nt1 >= (1 << 20) || (tt) < nt1) ? (ptrdiff_t)(tt) * (ptrdiff_t)kstep : (ptrdiff_t)(dl) + (ptrdiff_t)((tt) - nt1) * (ptrdiff_t)kstep))
    Unit cur, nxt; int ui = 0;
    if (!S.next(0, cur)) return;
    f32x4 acc[2][2][4][2];
#pragma unroll
    for (int a = 0; a < 2; ++a)
#pragma unroll
        for (int b = 0; b < 2; ++b)
#pragma unroll
            for (int m = 0; m < 4; ++m)
#pragma unroll
                for (int n = 0; n < 2; ++n) acc[a][b][m][n] = (f32x4){0.f, 0.f, 0.f, 0.f};
    bf16x8 At[4][2], B0[2][2], B1[2][2];
    const char* cA = (const char*)g.A + (size_t)cur.pm * tstep + (ptrdiff_t)cur.seg * Epi::SEG_A; const char* cB = (const char*)g.Bt + (size_t)cur.pn * tstep + (ptrdiff_t)cur.seg * Epi::SEG_B;
    S.a_ready(cur);
    {
        PG8_STAGE(PG8_SB(0, 0), cB, voffB); PG8_STAGE(PG8_SB(0, 1), cB + hstep, voffB); PG8_STAGE(PG8_SA(0, 0), cA, voffA); PG8_STAGE(PG8_SA(0, 1), cA + hstep, voffA);
        if (wr == 1) PG8_BAR;
        PG8_WAIT_V(2); PG8_BAR;
        PG8_STAGE(PG8_SB(1, 0), cB + kstep, voffB); PG8_STAGE(PG8_SA(1, 0), cA + kstep, voffA); PG8_STAGE(PG8_SB(1, 1), cB + hstep + kstep, voffB);
        PG8_WAIT_V(6); PG8_BAR;
    }
    for (;;) {
        const bool has_next = S.next(ui + 1, nxt);
        const char* nA = has_next ? (const char*)g.A + (size_t)nxt.pm * tstep + (ptrdiff_t)nxt.seg * Epi::SEG_A : cA; const char* nB = has_next ? (const char*)g.Bt + (size_t)nxt.pn * tstep + (ptrdiff_t)nxt.seg * Epi::SEG_B : cB;
        for (int t = 0; t < nt; t += 2) {
            const bool last = (t == nt - 2);
            if constexpr (nt1 < (1 << 20)) { if (t == nt1) E.mid(acc, cur, wr, wc, fr, fq); }
            const char* a1 = PG8_TP(cA, Epi::DELTA_A, t + 1);
            const char* a2 = last ? nA : PG8_TP(cA, Epi::DELTA_A, t + 2); const char* b2 = last ? nB : PG8_TP(cB, Epi::DELTA_B, t + 2);
            const char* a3 = last ? nA + kstep : PG8_TP(cA, Epi::DELTA_A, t + 3); const char* b3 = last ? nB + kstep : PG8_TP(cB, Epi::DELTA_B, t + 3);
            if (last && has_next) S.a_ready(nxt);
            PG8_LDB(B0, 0, 0); PG8_LDB(B1, 0, 1); PG8_SCHED; PG8_LDA(At, 0, 0); PG8_STAGE(PG8_SA(1, 1), a1 + hstep, voffA);
            PG8_WAIT_V(8); PG8_WAIT_L(0); PG8_BAR; PG8_MMA(0, 0, At, B0); PG8_MMA(0, 1, At, B1); PG8_BAR; PG8_SCHED;
            PG8_LDA(At, 0, 1); PG8_STAGE(PG8_SB(0, 0), b2, voffB); PG8_STAGE(PG8_SB(0, 1), b2 + hstep, voffB); PG8_STAGE(PG8_SA(0, 0), a2, voffA);
            PG8_WAIT_V(8); PG8_WAIT_L(0); PG8_BAR; PG8_MMA(1, 0, At, B0); PG8_MMA(1, 1, At, B1); PG8_BAR; PG8_SCHED;
            PG8_LDB(B0, 1, 0); PG8_LDB(B1, 1, 1); PG8_SCHED; PG8_LDA(At, 1, 0); PG8_STAGE(PG8_SA(0, 1), a2 + hstep, voffA);
            PG8_WAIT_V(8); PG8_WAIT_L(0); PG8_BAR; PG8_MMA(0, 0, At, B0); PG8_MMA(0, 1, At, B1); PG8_BAR; PG8_SCHED;
            PG8_LDA(At, 1, 1); PG8_STAGE(PG8_SB(1, 0), b3, voffB); PG8_STAGE(PG8_SB(1, 1), b3 + hstep, voffB); PG8_STAGE(PG8_SA(1, 0), a3, voffA);
            PG8_WAIT_V(8); PG8_WAIT_L(0); PG8_BAR; PG8_MMA(1, 0, At, B0); PG8_MMA(1, 1, At, B1); PG8_BAR; PG8_SCHED;
        }
        if constexpr (ALIGN_EPI) { if (wr == 0) PG8_BAR; }
        E(acc, cur, wr, wc, fr, fq); S.done(cur);
        if (!has_next) break;
#pragma unroll
        for (int a = 0; a < 2; ++a)
#pragma unroll
            for (int b = 0; b < 2; ++b)
#pragma unroll
                for (int m = 0; m < 4; ++m)
#pragma unroll
                    for (int n = 0; n < 2; ++n) acc[a][b][m][n] = (f32x4){0.f, 0.f, 0.f, 0.f};
        cur = nxt; cA = nA; cB = nB; ++ui;
        if constexpr (ALIGN_EPI) { if (wr == 1) PG8_BAR; }
    }
    PG8_WAIT_V(0);
    if constexpr (!ALIGN_EPI) { if (wr == 0) PG8_BAR; }
    PG8_BAR;
#undef PG8_SA
#undef PG8_SB
#undef PG8_STAGE
#undef PG8_LDA
#undef PG8_LDB
#undef PG8_MMA
#undef PG8_WAIT_V
#undef PG8_WAIT_L
#undef PG8_BAR
#undef PG8_SCHED
#undef PG8_TP
}
}

constexpr int BATCH = 8, SEQ = 4096, D = 1024, M = BATCH * SEQ;
constexpr int IN_WIDTH = 9736, NPROJ = 9728;
constexpr int COL_MI = 7680;
constexpr int AH = 16, AKV = 4, AHD = 64, WINDOW = 128;
constexpr int MH = 4, MHD = 256;
constexpr float EPS = 1e-6f;
constexpr int NWAVES = 8;

constexpr size_t MiB = 1u << 20;
constexpr size_t WS_CTL = 0, CTL_ZERO_BYTES = 1 * MiB;
constexpr size_t WS_MOD = 512 * 1024;
constexpr size_t WS_WIN = 1 * MiB;
constexpr size_t WS_NCK = 1 * MiB, WS_MCK = 2 * MiB, WS_UN = 3 * MiB, WS_UST = 4 * MiB;
constexpr size_t WS_PART = 10 * MiB;
constexpr size_t WS_WATT = 20 * MiB, WS_WM = 22 * MiB, WS_WOUT = 24 * MiB;
constexpr size_t WS_IG = 26 * MiB, WS_LF = WS_IG + 512 * 1024;
constexpr size_t WS_K = 27 * MiB, WS_V = 43 * MiB;
constexpr size_t WS_XN = 60 * MiB;
constexpr size_t WS_Q = 124 * MiB;
constexpr size_t WS_AZ = 188 * MiB;
constexpr size_t WS_MQ = 252 * MiB, WS_MK = 316 * MiB;
constexpr size_t WS_MV = 380 * MiB;
constexpr size_t WS_KC = WS_XN;
constexpr size_t WS_OG = 444 * MiB;
constexpr size_t WS_HALO = 508 * MiB;
constexpr size_t WS_END = 511 * MiB;
constexpr int CW_BAR = 4096;

constexpr int RING_OFF = 0, RING_BYTES = 131072;
constexpr int LDS_BYTES = 163840;
constexpr int LDSCTL_OFF = LDS_BYTES - 1024, MISC_OFF = LDSCTL_OFF + 320;

#define GAS __attribute__((address_space(1)))
#define LAS __attribute__((address_space(3)))
typedef unsigned short bf16;
typedef unsigned v4u __attribute__((ext_vector_type(4)));
typedef unsigned v2u __attribute__((ext_vector_type(2)));
typedef float f32x4 __attribute__((ext_vector_type(4)));
typedef short bf16x8 __attribute__((ext_vector_type(8)));
typedef GAS unsigned gu32;
#define RLX_AGENT __ATOMIC_RELAXED, __HIP_MEMORY_SCOPE_AGENT
#define LDS_WAIT() asm volatile("s_waitcnt lgkmcnt(0)" ::: "memory")
#define VM_WAIT() asm volatile("s_waitcnt vmcnt(0)" ::: "memory")
__device__ __forceinline__ unsigned f2bf(float f) { unsigned u = __builtin_bit_cast(unsigned, f); return (u + 0x7fffu + ((u >> 16) & 1u)) >> 16; }
__device__ __forceinline__ unsigned pk2(float lo, float hi) { return f2bf(lo) | (f2bf(hi) << 16); }
__device__ __forceinline__ float bf2f(bf16 v) { return __builtin_bit_cast(float, (unsigned)v << 16); }

#define XB_TMO      128
#define XB_XCNT(j)  (256  + 64 * (j))
#define XB_XSUB(j)  (1280 + 64 * (j))
#define XB_XGEN(j)  (2304 + 64 * (j))
#define XB_TOP      3328
#define XB_TOPGEN   3392
#define XCD_BAR_WORDS 3456
#define XB_SPIN_CAP (1u << 18)

__device__ __forceinline__ unsigned xb_ld(unsigned* p)              { return __hip_atomic_load(p, __ATOMIC_RELAXED, __HIP_MEMORY_SCOPE_AGENT); }
__device__ __forceinline__ unsigned xb_add(unsigned* p, unsigned v) { return __hip_atomic_fetch_add(p, v, __ATOMIC_RELAXED, __HIP_MEMORY_SCOPE_AGENT); }
__device__ __forceinline__ unsigned xb_xcc_id() { return (unsigned)__builtin_amdgcn_s_getreg((3 << 11) | 20) & 0xFu; }
#define XB_SPIN(cond, bar) do { unsigned _sp = 0; while (cond) { __builtin_amdgcn_s_sleep(1); \
    if ((++_sp & 255u) == 0u) { if (xb_ld(&(bar)[XB_TMO])) break; if (_sp > XB_SPIN_CAP) { atomicAdd(&(bar)[XB_TMO], 1u); break; } } } } while (0)

struct XcdBarrier {
    unsigned* bar; unsigned x;
    volatile LAS unsigned* st;
};
__device__ __forceinline__ XcdBarrier xcd_barrier_post(unsigned* bar, volatile LAS unsigned* st) {
    XcdBarrier b; b.bar = bar; b.x = xb_xcc_id(); b.st = st;
    if (threadIdx.x == 0) (void)xb_add(&bar[XB_XCNT(b.x)], 1u);
    return b;
}
__device__ __forceinline__ void xcd_barrier_complete(unsigned* bar, unsigned x, unsigned& nloc, unsigned& nx) {
    const unsigned G = gridDim.x * gridDim.y * gridDim.z;
    unsigned sum, cnt, mine, sp = 0u;
    for (;;) {
        sum = 0u; cnt = 0u; mine = 0u;
#pragma unroll
        for (unsigned j = 0; j < 16; ++j) { const unsigned c = xb_ld(&bar[XB_XCNT(j)]); sum += c; cnt += (c > 0u) ? 1u : 0u; mine = (j == x) ? c : mine; }
        if (sum == G) break;
        __builtin_amdgcn_s_sleep(1);
        if ((++sp & 255u) == 0u) { if (xb_ld(&bar[XB_TMO])) break; if (sp > XB_SPIN_CAP) { atomicAdd(&bar[XB_TMO], 1u); break; } }
    }
    nloc = mine > 0u ? mine : 1u; nx = cnt > 0u ? cnt : 1u;
}
__device__ __forceinline__ void xcd_barrier(const XcdBarrier& b) {
    asm volatile("s_waitcnt vmcnt(0)" ::: "memory");
    __syncthreads();
    if (threadIdx.x == 0) {
        unsigned* bar = b.bar;
        __builtin_amdgcn_s_waitcnt(0);
        unsigned nloc = b.st[0], nx = b.st[1];
        if (nloc == 0u) { xcd_barrier_complete(bar, b.x, nloc, nx); b.st[0] = nloc; b.st[1] = nx; }
        const unsigned old = xb_add(&bar[XB_XSUB(b.x)], 1u);
        const unsigned gen = old / nloc;
        if (old + 1u == (gen + 1u) * nloc) {
            __builtin_amdgcn_fence(__ATOMIC_RELEASE, "agent");
            asm volatile("s_waitcnt vmcnt(0)" ::: "memory");
            const unsigned og = xb_add(&bar[XB_TOP], 1u);
            const unsigned tg = og / nx;
            if (og + 1u == (tg + 1u) * nx) xb_add(&bar[XB_TOPGEN], 1u);
            else XB_SPIN(xb_ld(&bar[XB_TOPGEN]) == tg, bar);
            __builtin_amdgcn_fence(__ATOMIC_ACQUIRE, "agent");
            xb_add(&bar[XB_XGEN(b.x)], 1u);
            asm volatile("s_waitcnt vmcnt(0)" ::: "memory");
        } else {
            XB_SPIN(xb_ld(&bar[XB_XGEN(b.x)]) == gen, bar);
            __builtin_amdgcn_fence(__ATOMIC_ACQUIRE, "agent");
            asm volatile("s_waitcnt vmcnt(0)" ::: "memory");
        }
    }
    __syncthreads();
}

struct Frame {
    LAS unsigned char* lds;
    volatile LAS unsigned* MISC;
    gu32* ctl;
    int tid, lane, wave;
    int vcu, G;
};

__device__ __forceinline__ int win_src_col(int n) {
    if (n < 1280) { const int hb = n & ~63, j = n & 63; return hb + (j >> 1) + 32 * (j & 1); }
    if (n < 5632) return n;
    if (n < 7680) { const int idx = n - 5632; return ((idx & 1) ? 6656 : 5632) + (idx >> 1); }
    return n + 8;
}
template <bool MAP>
__device__ __forceinline__ void p0_transpose_item(const float* W, int K, int Nsrc, int ndst, bf16* WT, LAS float* scr, int item, int lane) {
    const int nblk = ndst / 32, kb = item / nblk, nb = item % nblk, k0 = 64 * kb, n0 = 32 * nb;
    const int sc = MAP ? win_src_col(n0 + (lane & 31)) : n0 + (lane & 31);
    float v[32];
#pragma unroll
    for (int i = 0; i < 32; ++i) v[i] = W[(size_t)(k0 + 2 * i + (lane >> 5)) * Nsrc + sc];
#pragma unroll
    for (int i = 0; i < 32; ++i) scr[(2 * i + (lane >> 5)) * 33 + (lane & 31)] = v[i];
    LDS_WAIT(); asm volatile("" ::: "memory");
    const int c = lane & 7;
#pragma unroll
    for (int j = 0; j < 4; ++j) { const int n = (lane >> 3) + 8 * j; const LAS float* s = scr + (8 * c) * 33 + n;
        v4u o; o.x = pk2(s[0 * 33], s[1 * 33]); o.y = pk2(s[2 * 33], s[3 * 33]); o.z = pk2(s[4 * 33], s[5 * 33]); o.w = pk2(s[6 * 33], s[7 * 33]);
        *(GAS v4u*)(WT + (size_t)(n0 + n) * K + k0 + 8 * c) = o; }
    LDS_WAIT(); asm volatile("" ::: "memory");
}

struct Args {
    const float* x; const float* c; const int* pos; const float* w_ada; const float* b_ada; const float* norm_w; const float* w_in; const float* b_if;
    const float* sinks; const float* conv_q; const float* conv_k; const float* m_norm_w; const float* w_att; const float* w_m; const float* w_out; const float* fnorm_w;
    float* out; unsigned char* ws; int ph_lo, ph_hi, li, pad;
};

__device__ __forceinline__ void p0_prologue(Frame& F, const Args& a) {
    LAS float* scr = (LAS float*)(F.lds + RING_OFF + F.wave * 16384);
    const int gw = F.vcu * NWAVES + F.wave, NGW = F.G * NWAVES;
    float* mod = (float*)(a.ws + WS_MOD);
    constexpr int I_ADA = 48 * 32;
    for (int r = gw; r < I_ADA; r += NGW) {
        const int cg = r >> 5, ks = r & 31, n = cg * 64 + F.lane, k0 = ks * 32;
#pragma unroll
        for (int j = 0; j < 4; ++j) { const int idx = F.lane + 64 * j, b = idx >> 5, kk = idx & 31; const float cv = a.c[b * D + k0 + kk]; scr[idx] = cv / (1.0f + __expf(-cv)); }
        LDS_WAIT(); asm volatile("" ::: "memory");
        float s[8] = {0.f, 0.f, 0.f, 0.f, 0.f, 0.f, 0.f, 0.f};
#pragma unroll 8
        for (int kk = 0; kk < 32; ++kk) { const float w = a.w_ada[(size_t)(k0 + kk) * 3072 + n];
#pragma unroll
            for (int b = 0; b < 8; ++b) s[b] += scr[b * 32 + kk] * w; }
#pragma unroll
        for (int b = 0; b < 8; ++b) atomicAdd(mod + b * 3072 + n, s[b]);
        LDS_WAIT(); asm volatile("" ::: "memory");
    }
}
__device__ __forceinline__ void weight_copies(Frame& F, const Args& a) {
    LAS float* scr = (LAS float*)(F.lds + RING_OFF + F.wave * 16384);
    const int gw = F.vcu * NWAVES + F.wave, NGW = F.G * NWAVES;
    bf16* WIN = (bf16*)(a.ws + WS_WIN); bf16* WATT = (bf16*)(a.ws + WS_WATT); bf16* WM = (bf16*)(a.ws + WS_WM); bf16* WOUT = (bf16*)(a.ws + WS_WOUT);
    constexpr int I_IN = (D / 64) * (NPROJ / 32), I_SQ = (D / 64) * (D / 32);
    constexpr int NITEMS = I_IN + 3 * I_SQ;
    for (int it = NGW - 1 - gw; it < NITEMS; it += NGW) {
        int r = it;
        if (r < I_IN) { p0_transpose_item<true>(a.w_in, D, IN_WIDTH, NPROJ, WIN, scr, r, F.lane); continue; } r -= I_IN;
        if (r < I_SQ) { p0_transpose_item<false>(a.w_att, D, D, D, WATT, scr, r, F.lane); continue; } r -= I_SQ;
        if (r < I_SQ) { p0_transpose_item<false>(a.w_m, D, D, D, WM, scr, r, F.lane); continue; } r -= I_SQ;
        p0_transpose_item<false>(a.w_out, D, D, D, WOUT, scr, r, F.lane);
    }
}

typedef float p1f2 __attribute__((ext_vector_type(2)));
__device__ __forceinline__ void p1_norm(Frame& F, const Args& a) {
    LAS float* wg = (LAS float*)(F.lds + RING_OFF);
    for (int k = F.tid; k < D; k += NWAVES * 64) { const f32x4* s = (const f32x4*)(a.w_in + (size_t)k * IN_WIDTH + COL_MI); const int j = k >> 8, ln = (k & 255) >> 2, e = k & 3;
        *(LAS f32x4*)(wg + (((j * 4 + e) * 2 + 0) * 64 + ln) * 4) = s[0]; *(LAS f32x4*)(wg + (((j * 4 + e) * 2 + 1) * 64 + ln) * 4) = s[1]; }
    const float* mod = (const float*)(a.ws + WS_MOD);
    LAS float* tca = wg + 8192; LAS float* tcc = tca + 8192;
    for (int i = F.tid; i < BATCH * 256; i += NWAVES * 64) { const int b = i >> 8, k = (i & 255) * 4;
        const f32x4 nw = *(const f32x4*)(a.norm_w + k);
        const f32x4 sh = *(const f32x4*)(mod + b * 3072 + k) + *(const f32x4*)(a.b_ada + k);
        const f32x4 sc = *(const f32x4*)(mod + b * 3072 + 1024 + k) + *(const f32x4*)(a.b_ada + 1024 + k);
        *(LAS f32x4*)(tca + b * 1024 + k) = nw * (sc + 1.0f); *(LAS f32x4*)(tcc + b * 1024 + k) = sh; }
    __syncthreads();
    bf16* XN = (bf16*)(a.ws + WS_XN); float* IG = (float*)(a.ws + WS_IG); float* LF = (float*)(a.ws + WS_LF);
    const int gw = F.vcu * NWAVES + F.wave, NGW = F.G * NWAVES;
    constexpr int GR = 2;
    {
        const int NG = M / GR;
        f32x4 vbuf[GR][4], vbuf2[GR][4];
#pragma unroll
        for (int q = 0; q < GR; ++q)
#pragma unroll
            for (int j = 0; j < 4; ++j) { vbuf[q][j] = (f32x4){0.f, 0.f, 0.f, 0.f}; vbuf2[q][j] = vbuf[q][j]; }
        if (gw < NG) {
#pragma unroll
            for (int q = 0; q < GR; ++q) { const GAS f32x4* xr = (const GAS f32x4*)(a.x + (size_t)(gw * GR + q) * D) + F.lane;
#pragma unroll
                for (int j = 0; j < 4; ++j) vbuf[q][j] = xr[64 * j]; } }
        if (gw + NGW < NG) {
#pragma unroll
            for (int q = 0; q < GR; ++q) { const GAS f32x4* xr = (const GAS f32x4*)(a.x + (size_t)((gw + NGW) * GR + q) * D) + F.lane;
#pragma unroll
                for (int j = 0; j < 4; ++j) vbuf2[q][j] = xr[64 * j]; } }
#pragma unroll 1
        for (int grp = gw; grp < NG; grp += NGW) {
            int rowg = grp * GR; asm volatile("" : "+s"(rowg));
            const int b = rowg >> 12;
            f32x4 vcur[GR][4];
#pragma unroll
            for (int q = 0; q < GR; ++q)
#pragma unroll
                for (int j = 0; j < 4; ++j) { vcur[q][j] = vbuf[q][j]; vbuf[q][j] = vbuf2[q][j]; }
            if (grp + 2 * NGW < NG) {
#pragma unroll
                for (int q = 0; q < GR; ++q) { const GAS f32x4* xr = (const GAS f32x4*)(a.x + (size_t)((grp + 2 * NGW) * GR + q) * D) + F.lane;
#pragma unroll
                    for (int j = 0; j < 4; ++j) vbuf2[q][j] = xr[64 * j]; } }
            float rstd[GR];
#pragma unroll
            for (int q = 0; q < GR; ++q) { float s2 = 0.f;
#pragma unroll
                for (int j = 0; j < 4; ++j) { const f32x4 v = vcur[q][j]; s2 += (v.x * v.x + v.y * v.y) + (v.z * v.z + v.w * v.w); }
                rstd[q] = __builtin_amdgcn_rsqf(wave_sum(s2) * (1.f / D) + EPS); }
            p1f2 g[GR][4];
#pragma unroll
            for (int q = 0; q < GR; ++q)
#pragma unroll
                for (int i = 0; i < 4; ++i) g[q][i] = (p1f2){0.f, 0.f};
#pragma unroll
            for (int j = 0; j < 4; ++j) { f32x4 h[GR]; const f32x4 caj = *(const LAS f32x4*)(tca + b * 1024 + 256 * j + 4 * F.lane), ccj = *(const LAS f32x4*)(tcc + b * 1024 + 256 * j + 4 * F.lane);
#pragma unroll
                for (int q = 0; q < GR; ++q) { h[q] = vcur[q][j] * rstd[q] * caj + ccj;
                    v2u o; o.x = pg8::cvt_pk_bf16(h[q].x, h[q].y); o.y = pg8::cvt_pk_bf16(h[q].z, h[q].w); ((GAS v2u*)(XN + (size_t)(rowg + q) * D) + F.lane)[64 * j] = o; }
#pragma unroll
                for (int e = 0; e < 4; ++e) { const f32x4 w0 = *(const LAS f32x4*)(wg + (((j * 4 + e) * 2 + 0) * 64 + F.lane) * 4), w1 = *(const LAS f32x4*)(wg + (((j * 4 + e) * 2 + 1) * 64 + F.lane) * 4);
                    const p1f2 wa = {w0.x, w0.y}, wb = {w0.z, w0.w}, wc = {w1.x, w1.y}, wd = {w1.z, w1.w};
#pragma unroll
                    for (int q = 0; q < GR; ++q) { const float hv = h[q][e]; g[q][0] += hv * wa; g[q][1] += hv * wb; g[q][2] += hv * wc; g[q][3] += hv * wd; } } }
#pragma unroll
            for (int q = 0; q < GR; ++q) {
                const int row = rowg + q;
                float h4[4];
#pragma unroll
                for (int i = 0; i < 4; ++i) { float aa = g[q][i >> 1][i & 1], bb = g[q][2 + (i >> 1)][i & 1]; asm volatile("s_nop 1\n\tv_permlane32_swap_b32 %0, %1" : "+v"(aa), "+v"(bb)); h4[i] = aa + bb; }
                float u0, u1;
                { float aa = h4[0], bb = h4[2]; asm volatile("s_nop 1\n\tv_permlane16_swap_b32 %0, %1" : "+v"(aa), "+v"(bb)); u0 = aa + bb; }
                { float aa = h4[1], bb = h4[3]; asm volatile("s_nop 1\n\tv_permlane16_swap_b32 %0, %1" : "+v"(aa), "+v"(bb)); u1 = aa + bb; }
                u0 += dppf<0x128>(u0); u1 += dppf<0x128>(u1);
                float val = (F.lane & 8) ? u1 : u0;
                val += dppf<0x141>(val); val += dppf<0xB1>(val); val += dppf<0x4E>(val);
                const int gi = 4 * (F.lane >> 5) + 2 * ((F.lane >> 4) & 1) + ((F.lane >> 3) & 1);
                val += a.b_if[gi];
                if ((F.lane & 7) == 0) {
                    if (gi < 4) IG[((size_t)b * MH + gi) * SEQ + (row & (SEQ - 1))] = val;
                    else LF[((size_t)b * MH + (gi - 4)) * SEQ + (row & (SEQ - 1))] = fminf(val, 0.f) - __logf(1.0f + __expf(-fabsf(val))); }
            }
        }
    }
}


typedef float f32x16 __attribute__((ext_vector_type(16)));
typedef short s16x4 __attribute__((ext_vector_type(4)));
__device__ __forceinline__ int crow(int r, int hi) { return (r & 3) + 8 * (r >> 2) + 4 * hi; }
constexpr int ATT_VT_OFF = 32768, ATT_VT_PITCH = 520;
__device__ __forceinline__ void attn_phase(Frame& F, const Args& a, const int nostore = 0) {
    const bf16* Q = (const bf16*)(a.ws + WS_Q); const bf16* K = (const bf16*)(a.ws + WS_K); const bf16* V = (const bf16*)(a.ws + WS_V); bf16* AZ = (bf16*)(a.ws + WS_AZ);
    LAS unsigned char* Ks = F.lds; LAS unsigned char* Vt = F.lds + ATT_VT_OFF;
    const int tid = F.tid, lane = F.lane, w = F.wave, q32 = lane & 31, hi = lane >> 5;
    const int kp = tid >> 2, dq = tid & 3;
    v4u kreg[4], va0, va1, vb0, vb1;
#define AT_LOAD(uid_) do { int tid = F.tid; asm volatile("" : "+v"(tid)); const int kp = tid >> 2, dq = tid & 3; const int b_ = (uid_) >> 7, kvh_ = ((uid_) >> 5) & 3, qb_ = (uid_) & 31; const long f0_ = (long)b_ * SEQ + qb_ * 128 - 128; \
        _Pragma("unroll") for (int j = 0; j < 4; ++j) { const int idx = tid + 512 * j, key = idx >> 3, c = idx & 7; kreg[j] = (v4u){0u, 0u, 0u, 0u}; \
            if (qb_ > 0 || key >= 128) kreg[j] = *(const v4u*)(K + (f0_ + key) * 256 + kvh_ * 64 + c * 8); } \
        va0 = (v4u){0u, 0u, 0u, 0u}; va1 = va0; vb0 = va0; vb1 = va0; \
        if (qb_ > 0 || kp >= 64) { const bf16* p = V + (f0_ + 2 * kp) * 256 + kvh_ * 64 + dq * 16; va0 = *(const v4u*)p; va1 = *(const v4u*)(p + 8); vb0 = *(const v4u*)(p + 256); vb1 = *(const v4u*)(p + 264); } } while (0)
    const int uid0 = F.vcu;
    if (uid0 < BATCH * AKV * 32) AT_LOAD(uid0);
    for (int uid = uid0; uid < BATCH * AKV * 32; uid += F.G) {
        const int b = uid >> 7, kvh = (uid >> 5) & 3, qblk = uid & 31;
        const int head = kvh * 4 + (w >> 1);
        bf16x8 qf[2][4]; v2u zz[2][8];
#pragma unroll
        for (int sb = 0; sb < 2; ++sb) { const long qrow = (long)b * SEQ + qblk * 128 + (w & 1) * 64 + sb * 32 + q32;
#pragma unroll
            for (int s = 0; s < 4; ++s) qf[sb][s] = *(const bf16x8*)(Q + qrow * 1024 + head * 64 + 16 * s + 8 * hi);
#pragma unroll
            for (int i = 0; i < 8; ++i) zz[sb][i] = *(const v2u*)(AZ + qrow * 1024 + head * 64 + 4 * hi + (i >> 2) * 32 + 8 * (i & 3)); }
        __syncthreads();
#pragma unroll
        for (int j = 0; j < 4; ++j) { const int idx = tid + 512 * j, key = idx >> 3, c = idx & 7; *(LAS v4u*)(Ks + key * 128 + ((c ^ (key & 7)) << 4)) = kreg[j]; }
        { LAS unsigned char* dst = Vt + (16 * dq) * ATT_VT_PITCH + kp * 4;
#define VT_W(e, x, y) *(LAS unsigned*)(dst + (e) * ATT_VT_PITCH) = ((x) & 0xffffu) | ((y) << 16); *(LAS unsigned*)(dst + ((e) + 1) * ATT_VT_PITCH) = ((x) >> 16) | ((y) & 0xffff0000u)
            VT_W(0, va0.x, vb0.x); VT_W(2, va0.y, vb0.y); VT_W(4, va0.z, vb0.z); VT_W(6, va0.w, vb0.w); VT_W(8, va1.x, vb1.x); VT_W(10, va1.y, vb1.y); VT_W(12, va1.z, vb1.z); VT_W(14, va1.w, vb1.w);
#undef VT_W
        }
        __syncthreads();
        { const int nuid = uid + F.G; if (nuid < BATCH * AKV * 32) AT_LOAD(nuid); }
        const float sink2 = a.sinks[head] * 1.4426950408889634f;
#pragma unroll
        for (int sb = 0; sb < 2; ++sb) {
            const int r0 = (w & 1) * 64 + sb * 32, kt0 = r0 >> 5, rq = r0 + q32;
            const long qrow = (long)b * SEQ + qblk * 128 + rq;
            f32x16 p[5];
#pragma unroll
            for (int kt = 0; kt < 5; ++kt) { const int key = 32 * (kt0 + kt) + q32; f32x16 acc = {};
#pragma unroll
                for (int s = 0; s < 4; ++s) { const bf16x8 kf = *(const LAS bf16x8*)(Ks + key * 128 + (((2 * s + hi) ^ (key & 7)) << 4)); acc = __builtin_amdgcn_mfma_f32_32x32x16_bf16(kf, qf[sb][s], acc, 0, 0, 0); }
                p[kt] = acc; }
            float mx = sink2;
#pragma unroll
            for (int r = 0; r < 16; ++r) { p[0][r] = (crow(r, hi) > q32) ? p[0][r] : -INFINITY; p[4][r] = (crow(r, hi) <= q32) ? p[4][r] : -INFINITY; }
            if (qblk == 0) {
#pragma unroll
                for (int kt = 0; kt < 4; ++kt) if (kt0 + kt < 4) {
#pragma unroll
                    for (int r = 0; r < 16; ++r) p[kt][r] = -INFINITY; } }
#pragma unroll
            for (int kt = 0; kt < 5; ++kt)
#pragma unroll
                for (int r = 0; r < 16; ++r) mx = fmaxf(mx, p[kt][r]);
            mx = xor32_max(mx);
            float l = 0.f;
#pragma unroll
            for (int kt = 0; kt < 5; ++kt)
#pragma unroll
                for (int r = 0; r < 16; ++r) { const float e = __builtin_amdgcn_exp2f(p[kt][r] - mx); p[kt][r] = e; l += e; }
            l = xor32_sum(l) + __builtin_amdgcn_exp2f(sink2 - mx);
            f32x16 o[2] = {f32x16{}, f32x16{}};
#pragma unroll
            for (int kt = 0; kt < 5; ++kt)
#pragma unroll
                for (int s = 0; s < 2; ++s) { v4u pw; pw.x = pg8::cvt_pk_bf16(p[kt][8 * s + 0], p[kt][8 * s + 1]); pw.y = pg8::cvt_pk_bf16(p[kt][8 * s + 2], p[kt][8 * s + 3]);
                    pw.z = pg8::cvt_pk_bf16(p[kt][8 * s + 4], p[kt][8 * s + 5]); pw.w = pg8::cvt_pk_bf16(p[kt][8 * s + 6], p[kt][8 * s + 7]);
                    const bf16x8 pb = __builtin_bit_cast(bf16x8, pw); const int kb = 32 * (kt0 + kt) + 16 * s + 4 * hi;
#pragma unroll
                    for (int dt = 0; dt < 2; ++dt) { const LAS unsigned char* vp = Vt + (dt * 32 + q32) * ATT_VT_PITCH + kb * 2;
                        const s16x4 v0 = *(const LAS s16x4*)vp, v1 = *(const LAS s16x4*)(vp + 16);
                        const bf16x8 vf = (bf16x8){v0[0], v0[1], v0[2], v0[3], v1[0], v1[1], v1[2], v1[3]};
                        o[dt] = __builtin_amdgcn_mfma_f32_32x32x16_bf16(vf, pb, o[dt], 0, 0, 0); } }
            const float rl = 1.0f / l; bf16* ap = AZ + qrow * 1024 + head * 64 + 4 * hi;
#pragma unroll
            for (int dt = 0; dt < 2; ++dt)
#pragma unroll
                for (int g = 0; g < 4; ++g) { bf16* pp = ap + dt * 32 + 8 * g; const v2u z = zz[sb][dt * 4 + g]; v2u ov;
                    ov.x = pg8::cvt_pk_bf16(o[dt][4 * g + 0] * rl * pg8::bf_lo(z.x), o[dt][4 * g + 1] * rl * pg8::bf_hi(z.x));
                    ov.y = pg8::cvt_pk_bf16(o[dt][4 * g + 2] * rl * pg8::bf_lo(z.y), o[dt][4 * g + 3] * rl * pg8::bf_hi(z.y));
                    asm volatile("" :: "v"(ov.x), "v"(ov.y)); if (!nostore) *(v2u*)pp = ov; }
        }
    }
#undef AT_LOAD
    __syncthreads();
}


constexpr int ML_PQ = 528, ML_PK2 = 576, ML_PS = 144, ML_PV = 80;
typedef short v4i16_t __attribute__((ext_vector_type(4)));
typedef __bf16 bf16x2_t __attribute__((ext_vector_type(2)));
__device__ __forceinline__ float dot2bf(unsigned a, unsigned b, float c) { return __builtin_amdgcn_fdot2_f32_bf16(__builtin_bit_cast(bf16x2_t, a), __builtin_bit_cast(bf16x2_t, b), c, false); }
__device__ __forceinline__ s16x4 lds_tr(const LAS unsigned char* p) { return __builtin_bit_cast(s16x4, __builtin_amdgcn_ds_read_tr16_b64_v4i16((LAS v4i16_t*)p)); }
constexpr int ML_TBL = 1536;
#define ML_GATES_T(T) do { const float bc = scan_sum64(lf_n, lane), u = ig_n - bc, pm = scan_max64(u, lane); \
            const float g = fmaxf(m_run, pm), g63 = lane_bcast(g, 63), bl = lane_bcast(bc, 63); \
            (T)[lane] = u; (T)[64 + lane] = g; { const float wv_ = __expf(u - g63); (T)[128 + lane] = wv_; ((LAS unsigned short*)((T) + 336))[lane] = (unsigned short)(pg8::cvt_pk_bf16(wv_, 0.f) & 0xffffu); } (T)[192 + lane] = __expf(m_run - g); (T)[256 + lane] = __expf(-(bc + g)); if (lane == 0) (T)[320] = __expf(m_run - g63); \
            m_run = bl + g63; } while (0)

constexpr int UP_K = 0, UP_V = UP_K + 2 * 64 * ML_PK2, UP_W = UP_V + 2 * 64 * ML_PK2, UP_WB = UP_W + 2048, UP_RED = UP_WB + 1024, UP_CW = UP_RED + 128, UP_END = UP_CW + 4096;
__device__ __forceinline__ void mlstm_usum_phase(Frame& F, const Args& a) {
    const bf16* MK = (const bf16*)(a.ws + WS_MK); bf16* KCO = (bf16*)(a.ws + WS_KC); const bf16* VH = (const bf16*)(a.ws + WS_MV);
    const float* IG = (const float*)(a.ws + WS_IG); const float* LF = (const float*)(a.ws + WS_LF);
    bf16* UK = (bf16*)(a.ws + WS_Q); float* UN = (float*)(a.ws + WS_UN); float* ST = (float*)(a.ws + WS_UST);
    LAS unsigned char* L = F.lds;
    const int w = F.wave;
    for (int uid = F.vcu; uid < BATCH * MH * 8; uid += F.G) {
        int t__ = F.tid; asm volatile("" : "+v"(t__)); const int tid = t__, lane = tid & 63, l31 = lane & 31, hi = lane >> 5;
        const int bh = uid >> 3, j = uid & 7, b = bh >> 2, h = bh & 3;
        const size_t rowb = (size_t)b * SEQ + (size_t)j * 512; const int colh = h * 256;
        v4u rk[7], rv[4];
#define UP_LOAD(c) do { int t_ = F.tid; asm volatile("" : "+v"(t_)); const int ss = t_ >> 3, cq = t_ & 7, c8 = t_ & 31, rg = t_ >> 5; (void)ss; (void)cq; (void)c8; (void)rg; unsigned o_ = (unsigned)((((c) * 64 + 4 * rg) * 1024 + colh + 8 * c8) * 2); asm volatile("" : "+v"(o_)); const char* k_ = (const char*)(MK + rowb * 1024) + o_; \
            _Pragma("unroll") for (int r = 0; r < 7; ++r) { rk[r] = (v4u){0u, 0u, 0u, 0u}; if (r >= 3 || j > 0 || (c) > 0 || rg > 0) rk[r] = *(const v4u*)(k_ + (r - 3) * 2048); } \
            unsigned ov_ = (unsigned)((((c) * 64 + ss) * 1024 + colh + 8 * cq) * 2); asm volatile("" : "+v"(ov_)); const char* v_ = (const char*)(VH + rowb * 1024) + ov_; \
            _Pragma("unroll") for (int i = 0; i < 4; ++i) rv[i] = *(const v4u*)(v_ + 128 * i); } while (0)
#define UP_LOADK(c) do { int t_ = F.tid; asm volatile("" : "+v"(t_)); const int c8 = t_ & 31, rg = t_ >> 5; unsigned o_ = (unsigned)((((c) * 64 + 4 * rg) * 1024 + colh + 8 * c8) * 2); asm volatile("" : "+v"(o_)); const char* k_ = (const char*)(MK + rowb * 1024) + o_; \
            _Pragma("unroll") for (int r = 0; r < 7; ++r) { rk[r] = (v4u){0u, 0u, 0u, 0u}; if (r >= 3 || j > 0 || (c) > 0 || rg > 0) rk[r] = *(const v4u*)(k_ + (r - 3) * 2048); } } while (0)
#define UP_SILU16(v) ((v) * pg8::sigmoidf_(v) * 0.0625f)
#define UP_CONV(kc) do { int t_ = F.tid; asm volatile("" : "+v"(t_)); const int c8 = t_ & 31; \
            _Pragma("unroll") for (int hf = 0; hf < 2; ++hf) {                  \
                f32x4 wt[4], sm[4]; \
                _Pragma("unroll") for (int t = 0; t < 4; ++t) { wt[t] = *(const LAS f32x4*)(L + UP_CW + (t * 256 + 8 * c8 + 4 * hf) * 4); sm[t] = (f32x4){0.f, 0.f, 0.f, 0.f}; } \
                _Pragma("unroll") for (int row = 0; row < 7; ++row) { const unsigned xa = hf ? rk[row].z : rk[row].x, xb = hf ? rk[row].w : rk[row].y; \
                    const f32x4 xv = (f32x4){pg8::bf_lo(xa), pg8::bf_hi(xa), pg8::bf_lo(xb), pg8::bf_hi(xb)}; \
                    _Pragma("unroll") for (int t = 0; t < 4; ++t) { const int r = row - t; if (r >= 0 && r < 4) sm[r] += wt[t] * xv; } } \
                _Pragma("unroll") for (int r = 0; r < 4; ++r) { const unsigned pa = pg8::cvt_pk_bf16(UP_SILU16(sm[r][0]), UP_SILU16(sm[r][1])), pb = pg8::cvt_pk_bf16(UP_SILU16(sm[r][2]), UP_SILU16(sm[r][3])); \
                    if (hf) { kc[r].z = pa; kc[r].w = pb; } else { kc[r].x = pa; kc[r].y = pb; } } \
                __builtin_amdgcn_sched_barrier(0); } } while (0)
#define UP_KOUT(kc, c) do { int t_ = F.tid; asm volatile("" : "+v"(t_)); const int ss = t_ >> 3, cq = t_ & 7, c8 = t_ & 31, rg = t_ >> 5; (void)ss; (void)cq; (void)c8; (void)rg; unsigned o_ = (unsigned)((((c) * 64 + 4 * rg) * 1024 + colh + 8 * c8) * 2); asm volatile("" : "+v"(o_)); char* k_ = (char*)(KCO + rowb * 1024) + o_; \
            _Pragma("unroll") for (int r = 0; r < 4; ++r) *(v4u*)(k_ + r * 2048) = kc[r]; } while (0)
        __syncthreads();
        { ((LAS float*)(L + UP_CW))[tid] = a.conv_k[(tid >> 8) * 1024 + colh + (tid & 255)]; ((LAS float*)(L + UP_CW))[tid + 512] = a.conv_k[((tid >> 8) + 2) * 1024 + colh + (tid & 255)]; }
        if (j == 7) {
            __syncthreads();
#pragma unroll 1
            for (int c = 0; c < 8; ++c) { UP_LOADK(c); v4u kc[4]; UP_CONV(kc); UP_KOUT(kc, c); }
            continue;
        }
#define UP_STAGE(bu, c) do { v4u kc[4]; UP_CONV(kc); UP_KOUT(kc, c); int t_ = F.tid; asm volatile("" : "+v"(t_)); const int ss = t_ >> 3, cq = t_ & 7, c8 = t_ & 31, rg = t_ >> 5; (void)ss; (void)cq; (void)c8; (void)rg; \
            _Pragma("unroll") for (int r = 0; r < 4; ++r) *(LAS v4u*)(L + UP_K + (bu) * 64 * ML_PK2 + (4 * rg + r) * ML_PK2 + 16 * c8) = kc[r]; \
            const float ws_ = ((const LAS float*)(L + UP_W))[(c) * 64 + ss]; \
            _Pragma("unroll") for (int i = 0; i < 4; ++i) { v4u x; \
                x.x = pg8::cvt_pk_bf16(pg8::bf_lo(rv[i].x) * ws_, pg8::bf_hi(rv[i].x) * ws_); x.y = pg8::cvt_pk_bf16(pg8::bf_lo(rv[i].y) * ws_, pg8::bf_hi(rv[i].y) * ws_); \
                x.z = pg8::cvt_pk_bf16(pg8::bf_lo(rv[i].z) * ws_, pg8::bf_hi(rv[i].z) * ws_); x.w = pg8::cvt_pk_bf16(pg8::bf_lo(rv[i].w) * ws_, pg8::bf_hi(rv[i].w) * ws_); \
                *(LAS v4u*)(L + UP_V + (bu) * 64 * ML_PK2 + ss * ML_PK2 + 16 * (cq + 8 * i)) = x; } } while (0)
        UP_LOAD(0);
        {
            const float lfv = LF[(size_t)bh * SEQ + j * 512 + tid], igv = IG[(size_t)bh * SEQ + j * 512 + tid];
            const float bc = scan_sum64(lfv, lane), tot = lane_bcast(bc, 63);
            LAS float* RED = (LAS float*)(L + UP_RED);
            if (lane == 0) RED[w] = tot;
            __syncthreads();
            float later = 0.f, gtot = 0.f;
#pragma unroll
            for (int c = 0; c < 8; ++c) { const float tc = RED[c]; gtot += tc; later += (c > w) ? tc : 0.f; }
            const float ls = (tot - bc) + later + igv;
            float mx = ls; mx = fmaxf(mx, dppf_id<0x111>(mx, -__builtin_inff())); mx = fmaxf(mx, dppf_id<0x112>(mx, -__builtin_inff())); mx = fmaxf(mx, dppf_id<0x114>(mx, -__builtin_inff())); mx = fmaxf(mx, dppf_id<0x118>(mx, -__builtin_inff()));
            const float wmax = fmaxf(fmaxf(lane_bcast(mx, 15), lane_bcast(mx, 31)), fmaxf(lane_bcast(mx, 47), lane_bcast(mx, 63)));
            if (lane == 0) RED[8 + w] = wmax;
            __syncthreads();
            float mp = RED[8];
#pragma unroll
            for (int c = 1; c < 8; ++c) mp = fmaxf(mp, RED[8 + c]);
            const float wv = __expf(ls - mp);
            ((LAS float*)(L + UP_W))[tid] = wv; ((LAS unsigned short*)(L + UP_WB))[tid] = (unsigned short)(pg8::cvt_pk_bf16(wv, 0.f) & 0xffffu);
            if (tid == 0) { ST[(bh * 8 + j) * 2] = gtot; ST[(bh * 8 + j) * 2 + 1] = mp; }
        }
        __syncthreads();
        UP_STAGE(0, 0); UP_LOAD(1);
        __syncthreads();
        f32x16 acc[8];
#pragma unroll
        for (int i = 0; i < 8; ++i) acc[i] = f32x16{};
        float nacc = 0.f;
#pragma unroll 1
        for (int c = 0; c < 8; ++c) {
            const int bu = c & 1;
            { int ln__ = F.lane; asm volatile("" : "+v"(ln__)); const int lane = ln__, hi = lane >> 5;
            float nsum = 0.f;
#pragma unroll
            for (int kk = 0; kk < 4; ++kk) {
                const LAS unsigned char* vp = L + UP_V + bu * 64 * ML_PK2 + (16 * kk + 8 * hi + ((lane & 15) >> 2)) * ML_PK2 + (32 * w + 16 * ((lane >> 4) & 1) + 4 * (lane & 3)) * 2;
                const s16x4 va = lds_tr(vp), vb = lds_tr(vp + 4 * ML_PK2); const bf16x8 vf = (bf16x8){va[0], va[1], va[2], va[3], vb[0], vb[1], vb[2], vb[3]};
#pragma unroll
                for (int i = 0; i < 8; ++i) { const LAS unsigned char* kp = L + UP_K + bu * 64 * ML_PK2 + (16 * kk + 8 * hi + ((lane & 15) >> 2)) * ML_PK2 + (32 * i + 16 * ((lane >> 4) & 1) + 4 * (lane & 3)) * 2;
                    const s16x4 ka = lds_tr(kp), kb = lds_tr(kp + 4 * ML_PK2); const bf16x8 kf = (bf16x8){ka[0], ka[1], ka[2], ka[3], kb[0], kb[1], kb[2], kb[3]};
                    acc[i] = __builtin_amdgcn_mfma_f32_32x32x16_bf16(kf, vf, acc[i], 0, 0, 0); }
                { const LAS unsigned char* kp = L + UP_K + bu * 64 * ML_PK2 + (16 * kk + 8 * hi + ((lane & 15) >> 2)) * ML_PK2 + (32 * w + 16 * ((lane >> 4) & 1) + 4 * (lane & 3)) * 2;
                    const s16x4 ka = lds_tr(kp), kb = lds_tr(kp + 4 * ML_PK2); const v4u kw = __builtin_bit_cast(v4u, (bf16x8){ka[0], ka[1], ka[2], ka[3], kb[0], kb[1], kb[2], kb[3]}), wq = *(const LAS v4u*)((const LAS unsigned short*)(L + UP_WB) + c * 64 + 16 * kk + 8 * hi);
                    nsum = dot2bf(kw.x, wq.x, nsum); nsum = dot2bf(kw.y, wq.y, nsum); nsum = dot2bf(kw.z, wq.z, nsum); nsum = dot2bf(kw.w, wq.w, nsum); } }
            nacc += xor32_sum(nsum); }
            if (c + 1 < 8) { UP_STAGE(bu ^ 1, c + 1); if (c + 2 < 8) UP_LOAD(c + 2); }
            __syncthreads();
        }
#undef UP_LOAD
#undef UP_LOADK
#undef UP_CONV
#undef UP_SILU16
#undef UP_KOUT
#undef UP_STAGE
        { bf16* up = UK + ((size_t)(bh * 8 + j) * 256 + 32 * w + l31) * 256 + 4 * hi;
#pragma unroll
            for (int i = 0; i < 8; ++i)
#pragma unroll
                for (int g = 0; g < 4; ++g) { v2u x; x.x = pg8::cvt_pk_bf16(acc[i][4 * g + 0], acc[i][4 * g + 1]); x.y = pg8::cvt_pk_bf16(acc[i][4 * g + 2], acc[i][4 * g + 3]); *(v2u*)(up + 32 * i + 8 * g) = x; }
            if (hi == 0) UN[(size_t)(bh * 8 + j) * 256 + 32 * w + l31] = nacc; }
    }
}

__device__ __forceinline__ void mlstm_combine_phase(Frame& F, const Args& a) {
    const bf16* UK = (const bf16*)(a.ws + WS_Q); const float* UN = (const float*)(a.ws + WS_UN); const float* ST = (const float*)(a.ws + WS_UST);
    bf16* CK = (bf16*)(a.ws + WS_Q) + (size_t)32 * 8 * 65536; float* NCK = (float*)(a.ws + WS_NCK); float* MCK = (float*)(a.ws + WS_MCK);
    for (int blk = F.vcu; blk < 32 * 8; blk += F.G) {
        const int bh = blk >> 3, part = blk & 7;
        float ca[7], cb[7], m = 0.f;
#pragma unroll
        for (int j = 0; j < 7; ++j) { const float G = ST[(bh * 8 + j) * 2], mp = ST[(bh * 8 + j) * 2 + 1], mn = fmaxf(G + m, mp); ca[j] = __expf(G + m - mn); cb[j] = __expf(mp - mn); m = mn;
            if (part == 0 && F.tid == 0) MCK[bh * 8 + j + 1] = mn; }
#pragma unroll
        for (int q = 0; q < 2; ++q) { const size_t piece = (size_t)part * 1024 + q * 512 + F.tid;
            float c[8] = {0.f, 0.f, 0.f, 0.f, 0.f, 0.f, 0.f, 0.f};
            v4u uu[7];
#pragma unroll
            for (int j = 0; j < 7; ++j) uu[j] = *(const v4u*)(UK + ((size_t)(bh * 8 + j) * 65536) + piece * 8);
#pragma unroll
            for (int j = 0; j < 7; ++j) { const v4u u = uu[j];
                c[0] = ca[j] * c[0] + cb[j] * pg8::bf_lo(u.x); c[1] = ca[j] * c[1] + cb[j] * pg8::bf_hi(u.x); c[2] = ca[j] * c[2] + cb[j] * pg8::bf_lo(u.y); c[3] = ca[j] * c[3] + cb[j] * pg8::bf_hi(u.y);
                c[4] = ca[j] * c[4] + cb[j] * pg8::bf_lo(u.z); c[5] = ca[j] * c[5] + cb[j] * pg8::bf_hi(u.z); c[6] = ca[j] * c[6] + cb[j] * pg8::bf_lo(u.w); c[7] = ca[j] * c[7] + cb[j] * pg8::bf_hi(u.w);
                v4u o; o.x = pg8::cvt_pk_bf16(c[0], c[1]); o.y = pg8::cvt_pk_bf16(c[2], c[3]); o.z = pg8::cvt_pk_bf16(c[4], c[5]); o.w = pg8::cvt_pk_bf16(c[6], c[7]);
                *(v4u*)(CK + ((size_t)(bh * 8 + j + 1) * 65536) + piece * 8) = o; } }
        if (part == 0 && F.tid < 256) { float nn = 0.f;
#pragma unroll
            for (int j = 0; j < 7; ++j) { nn = ca[j] * nn + cb[j] * UN[(size_t)(bh * 8 + j) * 256 + F.tid]; NCK[(size_t)(bh * 8 + j + 1) * 256 + F.tid] = nn; } }
    }
}

#define ML_LANES() int ln__ = F.lane, td__ = F.tid; asm volatile("" : "+v"(ln__), "+v"(td__)); const int lane = ln__, tid = td__, l15 = lane & 15, kq = lane >> 4, l31 = lane & 31, hi = lane >> 5, ss = tid >> 3, cq = tid & 7; (void)l15; (void)kq; (void)l31; (void)hi; (void)ss; (void)cq
constexpr int OU_QS = 0, OU_KS = OU_QS + 64 * ML_PQ, OU_VS = OU_KS + 64 * 512,
               OU_ST = OU_VS + 64 * ML_PK2, OU_NV = OU_ST + 64 * ML_PS, OU_GT = OU_NV + 1024, OU_RS = OU_GT + 2 * ML_TBL, OU_HT = OU_RS + 2 * 1024, OU_CW = OU_HT + 64 * ML_PQ, OU_END = OU_CW + 4096;
static_assert(OU_END <= LDSCTL_OFF && UP_END <= LDSCTL_OFF, "mLSTM LDS maps");
__device__ __forceinline__ void mlstm_out_phase(Frame& F, const Args& a, const int nostore = 0) {
    const bf16* MQ = (const bf16*)(a.ws + WS_MQ); const bf16* KC = (const bf16*)(a.ws + WS_KC); bf16* VH = (bf16*)(a.ws + WS_MV); const bf16* OG = (const bf16*)(a.ws + WS_OG);
    const float* IG = (const float*)(a.ws + WS_IG); const float* LF = (const float*)(a.ws + WS_LF);
    const bf16* CK = (const bf16*)(a.ws + WS_Q) + (size_t)32 * 8 * 65536; const float* NCK = (const float*)(a.ws + WS_NCK); const float* MCK = (const float*)(a.ws + WS_MCK);
    LAS unsigned char* L = F.lds;
    const int w = F.wave, ti = w >> 1, sh = (w ^ (w >> 2)) & 1;
    for (int uid = F.vcu; uid < BATCH * MH * 8; uid += F.G) {
        int t__ = F.tid; asm volatile("" : "+v"(t__)); const int tid = t__, lane = tid & 63, l15 = lane & 15, kq = lane >> 4, l31 = lane & 31, hi = lane >> 5; (void)l15; (void)kq;
        const int bh = uid >> 3, j = uid & 7, b = bh >> 2, h = bh & 3;
        const size_t rowb = (size_t)b * SEQ + (size_t)j * 512; const int colh = h * 256;
        const float* ig = IG + (size_t)bh * SEQ + j * 512; const float* lf = LF + (size_t)bh * SEQ + j * 512;
        const int ss = tid >> 3, cq = tid & 7;
        float m_run = (j > 0) ? MCK[bh * 8 + j] : 0.f, lf_n = 0.f, ig_n = 0.f;
        __syncthreads();
        unsigned Cp[8][8];
        { const bf16* ck = CK + ((size_t)(bh * 8 + j) * 256 + 32 * w + l31) * 256 + 4 * hi;
#pragma unroll
            for (int i = 0; i < 8; ++i)
#pragma unroll
                for (int g = 0; g < 4; ++g) { v2u x = (v2u){0u, 0u}; if (j > 0) x = *(const v2u*)(ck + 32 * i + 8 * g); Cp[i][2 * g] = x.x; Cp[i][2 * g + 1] = x.y; } }
        if (tid < 256) ((LAS float*)(L + OU_NV))[tid] = (j > 0) ? NCK[(size_t)(bh * 8 + j) * 256 + tid] : 0.f;
        if (tid < 512) ((LAS float*)(L + OU_RS))[tid] = 0.f;
#define OU_GLOAD(cc) do { if (w == 0) { lf_n = lf[(cc) * 64 + lane]; ig_n = ig[(cc) * 64 + lane]; } } while (0)
        v4u rq[7], rqc[4], rk[4], rv[4];
#define OU_LOAD(cc) do { int tl_ = F.tid; asm volatile("" : "+v"(tl_)); unsigned oq_ = (unsigned)((((cc) * 64 + 4 * (tl_ >> 5)) * 1024 + colh + 8 * (tl_ & 31)) * 2); asm volatile("" : "+v"(oq_)); const char* q_ = (const char*)(MQ + rowb * 1024) + oq_; \
            _Pragma("unroll") for (int r = 0; r < 7; ++r) { rq[r] = (v4u){0u, 0u, 0u, 0u}; if (r >= 3 || j > 0 || (cc) > 0 || (tl_ >> 5) > 0) rq[r] = *(const v4u*)(q_ + (r - 3) * 2048); } \
            unsigned o_ = (unsigned)((((cc) * 64 + (tl_ >> 3)) * 1024 + colh + 8 * (tl_ & 7)) * 2); asm volatile("" : "+v"(o_));     \
            const char* k_ = (const char*)(KC + rowb * 1024) + o_; const char* v_ = (const char*)(VH + rowb * 1024) + o_; \
            _Pragma("unroll") for (int i = 0; i < 4; ++i) { rk[i] = *(const v4u*)(k_ + 128 * i); rv[i] = *(const v4u*)(v_ + 128 * i); } } while (0)
#define OU_SILU(v) ((v) * pg8::sigmoidf_(v))
#define OU_QCONV() do { int t_ = F.tid; asm volatile("" : "+v"(t_)); const int c8_ = t_ & 31; \
            _Pragma("unroll") for (int hf = 0; hf < 2; ++hf) { f32x4 wt[4], sm[4]; \
                _Pragma("unroll") for (int t = 0; t < 4; ++t) { wt[t] = *(const LAS f32x4*)(L + OU_CW + (t * 256 + 8 * c8_ + 4 * hf) * 4); sm[t] = (f32x4){0.f, 0.f, 0.f, 0.f}; } \
                _Pragma("unroll") for (int row = 0; row < 7; ++row) { const unsigned xa = hf ? rq[row].z : rq[row].x, xb = hf ? rq[row].w : rq[row].y; \
                    const f32x4 xv = (f32x4){pg8::bf_lo(xa), pg8::bf_hi(xa), pg8::bf_lo(xb), pg8::bf_hi(xb)}; \
                    _Pragma("unroll") for (int t = 0; t < 4; ++t) { const int r = row - t; if (r >= 0 && r < 4) sm[r] += wt[t] * xv; } } \
                _Pragma("unroll") for (int r = 0; r < 4; ++r) { const unsigned pa = pg8::cvt_pk_bf16(OU_SILU(sm[r][0]), OU_SILU(sm[r][1])), pb = pg8::cvt_pk_bf16(OU_SILU(sm[r][2]), OU_SILU(sm[r][3])); \
                    if (hf) { rqc[r].z = pa; rqc[r].w = pb; } else { rqc[r].x = pa; rqc[r].y = pb; } } \
                __builtin_amdgcn_sched_barrier(0); } } while (0)
#define OU_STAGE() do { int ts_ = F.tid; asm volatile("" : "+v"(ts_)); const int ss_ = ts_ >> 3, cq_ = ts_ & 7, rg_ = ts_ >> 5, c8_ = ts_ & 31; \
            _Pragma("unroll") for (int r = 0; r < 4; ++r) *(LAS v4u*)(L + OU_QS + (4 * rg_ + r) * ML_PQ + 16 * c8_) = rqc[r]; \
            _Pragma("unroll") for (int i = 0; i < 4; ++i) { *(LAS v4u*)(L + OU_KS + ss_ * 512 + 16 * ((((cq_ + 8 * i) >> 2) ^ (ss_ & 3)) << 2 | ((cq_ + 8 * i) & 3))) = rk[i]; *(LAS v4u*)(L + OU_VS + ss_ * ML_PK2 + 16 * (cq_ + 8 * i)) = rv[i]; } } while (0)
        { ((LAS float*)(L + OU_CW))[tid] = a.conv_q[(tid >> 8) * 1024 + colh + (tid & 255)]; ((LAS float*)(L + OU_CW))[tid + 512] = a.conv_q[((tid >> 8) + 2) * 1024 + colh + (tid & 255)]; }
        OU_GLOAD(0); if (w == 0) { LAS float* T0 = (LAS float*)(L + OU_GT); ML_GATES_T(T0); } OU_GLOAD(1);
        OU_LOAD(0);
        __syncthreads();
        OU_QCONV(); OU_STAGE();
        __syncthreads();
#pragma unroll 1
        for (int cc = 0; cc < 8; ++cc) {
            const int tb = cc & 1; const LAS float* T = (const LAS float*)(L + OU_GT + tb * ML_TBL); LAS float* RS = (LAS float*)(L + OU_RS + tb * 1024);
            if (cc + 1 < 8) OU_LOAD(cc + 1);
            if (w == 0 && cc + 1 < 8) { LAS float* T1 = (LAS float*)(L + OU_GT + (tb ^ 1) * ML_TBL); ML_GATES_T(T1); if (cc + 2 < 8) OU_GLOAD(cc + 2); }
            {
                ML_LANES();
                f32x4 aS0 = {0.f, 0.f, 0.f, 0.f}, aS1 = aS0; float qn = 0.f;
#pragma unroll 2
                for (int kk = 0; kk < 8; ++kk) {
                    const bf16x8 qf = *(const LAS bf16x8*)(L + OU_QS + (16 * ti + l15) * ML_PQ + (32 * kk + 8 * kq) * 2);
                    const bf16x8 k0 = *(const LAS bf16x8*)(L + OU_KS + (32 * sh + l15) * 512 + ((kk ^ (l15 & 3)) << 6) + kq * 16);
                    const bf16x8 k1 = *(const LAS bf16x8*)(L + OU_KS + (32 * sh + 16 + l15) * 512 + ((kk ^ (l15 & 3)) << 6) + kq * 16);
                    aS0 = __builtin_amdgcn_mfma_f32_16x16x32_bf16(qf, k0, aS0, 0, 0, 0);
                    aS1 = __builtin_amdgcn_mfma_f32_16x16x32_bf16(qf, k1, aS1, 0, 0, 0);
                    if (sh == 0) { const f32x4 n0 = *(const LAS f32x4*)(L + OU_NV + (32 * kk + 8 * kq) * 4), n1 = *(const LAS f32x4*)(L + OU_NV + (32 * kk + 8 * kq + 4) * 4);
                        const v4u qw = __builtin_bit_cast(v4u, qf);
                        qn += pg8::bf_lo(qw.x) * n0[0] + pg8::bf_hi(qw.x) * n0[1] + pg8::bf_lo(qw.y) * n0[2] + pg8::bf_hi(qw.y) * n0[3] + pg8::bf_lo(qw.z) * n1[0] + pg8::bf_hi(qw.z) * n1[1] + pg8::bf_lo(qw.w) * n1[2] + pg8::bf_hi(qw.w) * n1[3]; }
                }
                if (sh == 0) { qn = xor32_sum(xor16_sum(qn)); if (kq == 0) RS[64 + 16 * ti + l15] = qn; }
                const float us0 = T[32 * sh + l15], us1 = T[32 * sh + 16 + l15];
                float rs[4];
#pragma unroll
                for (int r = 0; r < 4; ++r) { const int t = 16 * ti + 4 * kq + r; const float gt = T[64 + t];
                    const int s0 = 32 * sh + l15, s1 = s0 + 16;
                    const float d0 = (s0 <= t) ? aS0[r] * __expf(us0 - gt) : 0.f, d1 = (s1 <= t) ? aS1[r] * __expf(us1 - gt) : 0.f;
                    const unsigned pk = pg8::cvt_pk_bf16(d0, d1);
                    *(LAS unsigned short*)(L + OU_ST + t * ML_PS + s0 * 2) = (unsigned short)(pk & 0xffffu); *(LAS unsigned short*)(L + OU_ST + t * ML_PS + s1 * 2) = (unsigned short)(pk >> 16);
                    rs[r] = pg8::bf_lo(pk) + pg8::bf_hi(pk); }
#pragma unroll
                for (int r = 0; r < 4; ++r) { const float v = row16_sum(rs[r]); if (l15 == 0) atomicAdd((float*)(RS + 16 * ti + 4 * kq + r), v); }
            }
            if (cc + 1 < 8) OU_QCONV();
            __syncthreads();
            v4u ogr[4];
            { unsigned o_ = (unsigned)(((cc * 64 + (F.tid >> 5)) * 1024 + colh + 8 * (F.tid & 31)) * 2); asm volatile("" : "+v"(o_)); const char* g_ = (const char*)(OG + rowb * 1024) + o_;
#pragma unroll
                for (int i = 0; i < 4; ++i) ogr[i] = *(const v4u*)(g_ + (size_t)i * 16 * 2048); }
            { ML_LANES();
#pragma unroll 1
            for (int tt = 0; tt < 2; ++tt) {
                f32x16 aH = {}, aI = {};
#pragma unroll
                for (int kk = 0; kk < 4; ++kk) {
                    const int srow = 16 * kk + 8 * hi + ((lane & 15) >> 2);
                    const LAS unsigned char* vp = L + OU_VS + srow * ML_PK2 + (32 * w + 16 * ((lane >> 4) & 1) + 4 * (lane & 3)) * 2;
                    const s16x4 va = lds_tr(vp), vb = lds_tr(vp + 4 * ML_PK2);
                    const bf16x8 vfk = (bf16x8){va[0], va[1], va[2], va[3], vb[0], vb[1], vb[2], vb[3]};
                    const bf16x8 sf = *(const LAS bf16x8*)(L + OU_ST + (32 * tt + l31) * ML_PS + (16 * kk + 8 * hi) * 2);
                    aH = __builtin_amdgcn_mfma_f32_32x32x16_bf16(sf, vfk, aH, 0, 0, 0);
                }
#pragma unroll
                for (int i = 0; i < 8; ++i)
#pragma unroll
                    for (int s = 0; s < 2; ++s) { const v4u cw = (v4u){Cp[i][4 * s + 0], Cp[i][4 * s + 1], Cp[i][4 * s + 2], Cp[i][4 * s + 3]};
                        const bf16x8 cb = __builtin_bit_cast(bf16x8, cw);
                        const LAS unsigned char* qp = L + OU_QS + (32 * tt + l31) * ML_PQ + (32 * i + 16 * s + 4 * hi) * 2;
                        const s16x4 q0 = *(const LAS s16x4*)qp, q1 = *(const LAS s16x4*)(qp + 16);
                        const bf16x8 qf = (bf16x8){q0[0], q0[1], q0[2], q0[3], q1[0], q1[1], q1[2], q1[3]};
                        aI = __builtin_amdgcn_mfma_f32_32x32x16_bf16(qf, cb, aI, 0, 0, 0); }
#pragma unroll
                for (int g = 0; g < 4; ++g) { const int t0 = 32 * tt + 8 * g + 4 * hi;
                    const f32x4 wi = *(const LAS f32x4*)(T + 192 + t0), cl = *(const LAS f32x4*)(T + 256 + t0), rsum = *(const LAS f32x4*)(RS + t0), qnv = *(const LAS f32x4*)(RS + 64 + t0);
#pragma unroll
                    for (int e = 0; e < 4; ++e) { const float num = aH[4 * g + e] + wi[e] * aI[4 * g + e], den = rsum[e] + wi[e] * qnv[e];
                        const float hv = num * __builtin_amdgcn_rcpf(fmaxf(fabsf(den), cl[e]));
                        *(LAS unsigned short*)(L + OU_HT + (t0 + e) * ML_PQ + (32 * w + l31) * 2) = (unsigned short)(pg8::cvt_pk_bf16(hv, 0.f) & 0xffffu); } }
            }
            float nnew = 0.f;
            if (cc < 7) {
                const float decay = T[320];
                bf16x8 vw[4];
#pragma unroll
                for (int kk = 0; kk < 4; ++kk) { const f32x4 w0 = *(const LAS f32x4*)(T + 128 + 16 * kk + 8 * hi), w1 = *(const LAS f32x4*)(T + 128 + 16 * kk + 8 * hi + 4);
                    const LAS unsigned char* vp = L + OU_VS + (16 * kk + 8 * hi + ((lane & 15) >> 2)) * ML_PK2 + (32 * w + 16 * ((lane >> 4) & 1) + 4 * (lane & 3)) * 2; const s16x4 va = lds_tr(vp), vb = lds_tr(vp + 4 * ML_PK2);
                    const v4u x = __builtin_bit_cast(v4u, (bf16x8){va[0], va[1], va[2], va[3], vb[0], vb[1], vb[2], vb[3]}); v4u y;
                    y.x = pg8::cvt_pk_bf16(pg8::bf_lo(x.x) * w0[0], pg8::bf_hi(x.x) * w0[1]); y.y = pg8::cvt_pk_bf16(pg8::bf_lo(x.y) * w0[2], pg8::bf_hi(x.y) * w0[3]);
                    y.z = pg8::cvt_pk_bf16(pg8::bf_lo(x.z) * w1[0], pg8::bf_hi(x.z) * w1[1]); y.w = pg8::cvt_pk_bf16(pg8::bf_lo(x.w) * w1[2], pg8::bf_hi(x.w) * w1[3]); vw[kk] = __builtin_bit_cast(bf16x8, y); }
                float nsum = 0.f;
                const LAS unsigned char* kbase[4];
#pragma unroll
                for (int bq = 0; bq < 4; ++bq) kbase[bq] = L + OU_KS + (8 * hi + ((lane & 15) >> 2)) * 512 + ((bq ^ ((lane & 15) >> 2)) << 6) + (16 * ((lane >> 4) & 1) + 4 * (lane & 3)) * 2;
#pragma unroll
                for (int i = 0; i < 8; ++i) {
                    f32x16 ct;
#pragma unroll
                    for (int q = 0; q < 8; ++q) { ct[2 * q] = pg8::bf_lo(Cp[i][q]) * decay; ct[2 * q + 1] = pg8::bf_hi(Cp[i][q]) * decay; }
#pragma unroll
                    for (int kk = 0; kk < 4; ++kk) {
                        const int srow = 16 * kk + 8 * hi + ((lane & 15) >> 2);
                        const LAS unsigned char* kp = kbase[i & 3] + (16 * kk) * 512 + 256 * (i >> 2);
                        const s16x4 ka = lds_tr(kp), kb = lds_tr(kp + 4 * 512);
                        const bf16x8 kf = (bf16x8){ka[0], ka[1], ka[2], ka[3], kb[0], kb[1], kb[2], kb[3]};
                        ct = __builtin_amdgcn_mfma_f32_32x32x16_bf16(kf, vw[kk], ct, 0, 0, 0);
                        if (i == w) { const f32x4 w0 = *(const LAS f32x4*)(T + 128 + 16 * kk + 8 * hi), w1 = *(const LAS f32x4*)(T + 128 + 16 * kk + 8 * hi + 4); const v4u kw = __builtin_bit_cast(v4u, kf);
                            nsum += pg8::bf_lo(kw.x) * w0[0] + pg8::bf_hi(kw.x) * w0[1] + pg8::bf_lo(kw.y) * w0[2] + pg8::bf_hi(kw.y) * w0[3] + pg8::bf_lo(kw.z) * w1[0] + pg8::bf_hi(kw.z) * w1[1] + pg8::bf_lo(kw.w) * w1[2] + pg8::bf_hi(kw.w) * w1[3]; }
                    }
#pragma unroll
                    for (int q = 0; q < 8; ++q) Cp[i][q] = pg8::cvt_pk_bf16(ct[2 * q], ct[2 * q + 1]);
                }
                nsum = xor32_sum(nsum);
                nnew = decay * ((const LAS float*)(L + OU_NV))[32 * w + l31] + nsum;
            }
            __syncthreads();
            if (hi == 0) ((LAS float*)(L + OU_NV))[32 * w + l31] = nnew;
            }
            { ML_LANES();
#pragma unroll
            for (int i = 0; i < 4; ++i) { const int id = tid + 512 * i, t = id >> 5, c8 = id & 31;
                const v4u hx = *(const LAS v4u*)(L + OU_HT + t * ML_PQ + c8 * 16);
                float s2 = (pg8::bf_lo(hx.x) * pg8::bf_lo(hx.x) + pg8::bf_hi(hx.x) * pg8::bf_hi(hx.x)) + (pg8::bf_lo(hx.y) * pg8::bf_lo(hx.y) + pg8::bf_hi(hx.y) * pg8::bf_hi(hx.y))
                         + (pg8::bf_lo(hx.z) * pg8::bf_lo(hx.z) + pg8::bf_hi(hx.z) * pg8::bf_hi(hx.z)) + (pg8::bf_lo(hx.w) * pg8::bf_lo(hx.w) + pg8::bf_hi(hx.w) * pg8::bf_hi(hx.w));
                s2 = xor16_sum(row16_sum(s2));
                const float rsq = __builtin_amdgcn_rsqf(s2 * (1.f / 256.f) + EPS);
                const size_t o = (rowb + (size_t)cc * 64 + t) * 1024 + colh + c8 * 8;
                const v4u g = ogr[i]; const f32x4 m0 = *(const f32x4*)(a.m_norm_w + colh + c8 * 8) * rsq, m1 = *(const f32x4*)(a.m_norm_w + colh + c8 * 8 + 4) * rsq; v4u ov;
                ov.x = pg8::cvt_pk_bf16(pg8::bf_lo(hx.x) * m0[0] * pg8::bf_lo(g.x), pg8::bf_hi(hx.x) * m0[1] * pg8::bf_hi(g.x)); ov.y = pg8::cvt_pk_bf16(pg8::bf_lo(hx.y) * m0[2] * pg8::bf_lo(g.y), pg8::bf_hi(hx.y) * m0[3] * pg8::bf_hi(g.y));
                ov.z = pg8::cvt_pk_bf16(pg8::bf_lo(hx.z) * m1[0] * pg8::bf_lo(g.z), pg8::bf_hi(hx.z) * m1[1] * pg8::bf_hi(g.z)); ov.w = pg8::cvt_pk_bf16(pg8::bf_lo(hx.w) * m1[2] * pg8::bf_lo(g.w), pg8::bf_hi(hx.w) * m1[3] * pg8::bf_hi(g.w));
                asm volatile("" :: "v"(ov.x), "v"(ov.y), "v"(ov.z), "v"(ov.w)); if (!nostore) __builtin_nontemporal_store(ov, (v4u*)(VH + o)); }
            if (tid < 256) ((LAS float*)(L + OU_RS + (tb ^ 1) * 1024))[tid] = 0.f;
            if (cc + 1 < 8) OU_STAGE();
            }
            __syncthreads();
        }
#undef OU_GLOAD
#undef OU_LOAD
#undef OU_STAGE
#undef OU_QCONV
#undef OU_SILU
    }
}
#undef ML_GATES_T

constexpr int N_PHASES = 8;
#ifndef PROBE
#define PROBE 0
#endif
__global__ void __launch_bounds__(NWAVES * 64, 2) skel_fwd(Args args) {
    extern __shared__ __attribute__((aligned(16))) unsigned char lds[];
    Frame F;
    F.lds = (LAS unsigned char*)lds;
    F.MISC = (volatile LAS unsigned*)(F.lds + MISC_OFF);
    F.tid = threadIdx.x; F.lane = F.tid & 63; F.wave = __builtin_amdgcn_readfirstlane(F.tid >> 6);
    F.G = gridDim.x; { const int bx = blockIdx.x; F.vcu = (F.G % 8 == 0) ? (bx % 8) * (F.G / 8) + bx / 8 : bx; }
    unsigned char* ws = args.ws;
    F.ctl = (gu32*)(ws + WS_CTL);
    for (int u = F.tid; u < (LDS_BYTES - LDSCTL_OFF) / 4; u += NWAVES * 64) ((LAS unsigned*)(F.lds + LDSCTL_OFF))[u] = 0u;
    __syncthreads();
    const int lo = args.ph_lo, hi = args.ph_hi;
    XcdBarrier bar; bar.bar = (unsigned*)(F.ctl + CW_BAR); bar.x = 0; bar.st = nullptr;
    if (hi - lo > 1) bar = xcd_barrier_post((unsigned*)(F.ctl + CW_BAR), F.MISC + 8);
#define IN(k) (lo <= (k) && (k) < hi)
#define BOTH(k) (IN(k) && IN((k) + 1))
#define GRID_BAR() xcd_barrier(bar)
    bf16* XN = (bf16*)(ws + WS_XN); bf16* QB = (bf16*)(ws + WS_Q); bf16* KB = (bf16*)(ws + WS_K); bf16* VB = (bf16*)(ws + WS_V); bf16* AZ = (bf16*)(ws + WS_AZ);
    bf16* MQ = (bf16*)(ws + WS_MQ); bf16* MK = (bf16*)(ws + WS_MK); bf16* MV = (bf16*)(ws + WS_MV); bf16* OG = (bf16*)(ws + WS_OG);
    bf16* GA = (bf16*)args.out; bf16* GM = (bf16*)args.out + (size_t)M * D;

    if (IN(0)) { p0_prologue(F, args); if (BOTH(0)) GRID_BAR(); }
    if (IN(1)) { p1_norm(F, args); if (PROBE == 1) p1_norm(F, args); __syncthreads(); weight_copies(F, args); if (BOTH(1)) GRID_BAR(); }
    if (IN(2)) {
        pg8::Gemm g{XN, (const bf16*)(ws + WS_WIN), D, D / 64};
        pg8::StaticOrder S; S.init(M, NPROJ, F.G, (int)blockIdx.x);
        pg8::EpiProj E{QB, KB, VB, AZ, MQ, MK, MV, OG, GA, GM, args.pos};
        pg8::gemm_phase<pg8::EpiProj, pg8::StaticOrder, true>(F.lds + RING_OFF, g, S, E);
        if (PROBE == 2) pg8::gemm_phase<pg8::EpiProj, pg8::StaticOrder, true>(F.lds + RING_OFF, g, S, E);
        if (BOTH(2)) GRID_BAR();
    }
    if (IN(3)) { attn_phase(F, args); if (PROBE == 3) attn_phase(F, args, args.pad); if (BOTH(3)) GRID_BAR(); }
    if (IN(4)) { mlstm_usum_phase(F, args); if (PROBE == 4) mlstm_usum_phase(F, args); GRID_BAR(); mlstm_combine_phase(F, args); if (BOTH(4)) GRID_BAR(); }
    if (IN(5)) { mlstm_out_phase(F, args); if (PROBE == 5) mlstm_out_phase(F, args, args.pad); if (BOTH(5)) GRID_BAR(); }
    if (IN(6)) {
        pg8::Gemm g{AZ, (const bf16*)(ws + WS_WATT), D, 2 * D / 64};
        static_assert(WS_MV - WS_AZ == (size_t)pg8::EpiMerge::DELTA_A && WS_WM - WS_WATT == (size_t)pg8::EpiMerge::DELTA_B, "segment deltas");
        pg8::StaticOrder S; S.init(M, D, F.G, (int)blockIdx.x);
        pg8::EpiMerge E{GA, GM, XN};
        pg8::gemm_phase<pg8::EpiMerge, pg8::StaticOrder, true>(F.lds + RING_OFF, g, S, E);
        if (PROBE == 6) pg8::gemm_phase<pg8::EpiMerge, pg8::StaticOrder, true>(F.lds + RING_OFF, g, S, E);
        if (BOTH(6)) GRID_BAR();
    }
    if (IN(7)) {
        pg8::Gemm g{XN, (const bf16*)(ws + WS_WOUT), D, D / 64};
        pg8::StaticOrder S; S.init(M, D, F.G, (int)blockIdx.x);
        struct BarCall { XcdBarrier b; __device__ __forceinline__ void operator()() const { xcd_barrier(b); } };
        pg8::EpiOutNorm<BarCall> E{args.x, (const float*)(ws + WS_MOD), args.b_ada, args.fnorm_w, args.out, (float*)(ws + WS_PART), BarCall{bar}};
        pg8::gemm_phase<pg8::EpiOutNorm<BarCall>, pg8::StaticOrder, true>(F.lds + RING_OFF, g, S, E);
    }
#undef IN
#undef BOTH
#undef GRID_BAR
}

extern "C" void kernel_launch(void* const* d_in, const int* in_sizes, int n_in, void* d_out, int out_size, void* d_ws, size_t ws_size, hipStream_t stream) {
    static int grid = 0;
    if (grid == 0) {
        if (n_in != 16 || in_sizes[0] != M * D || out_size != M * D || ws_size < WS_END) { fprintf(stderr, "kernel_launch: unexpected shapes (n_in %d, in0 %d, out %d, ws %zu); nothing launched\n", n_in, n_in > 0 ? in_sizes[0] : -1, out_size, ws_size); grid = -1; return; }
        int dev = 0, cus = 0, per_cu = 0;
        if (hipGetDevice(&dev) != hipSuccess || hipDeviceGetAttribute(&cus, hipDeviceAttributeMultiprocessorCount, dev) != hipSuccess) { grid = -1; return; }
        if (hipFuncSetAttribute((const void*)skel_fwd, hipFuncAttributeMaxDynamicSharedMemorySize, LDS_BYTES) != hipSuccess) { fprintf(stderr, "kernel_launch: hipFuncSetAttribute failed\n"); grid = -1; return; }
        if (hipOccupancyMaxActiveBlocksPerMultiprocessor(&per_cu, (const void*)skel_fwd, NWAVES * 64, LDS_BYTES) != hipSuccess || per_cu < 1) fprintf(stderr, "kernel_launch: note: occupancy query reports %d\n", per_cu);
        (void)hipGetLastError();
        grid = cus;
    }
    if (grid < 0) return;
    if (hipMemsetAsync((char*)d_ws + WS_CTL, 0, CTL_ZERO_BYTES, stream) != hipSuccess) return;
    Args a{};
    a.x = (const float*)d_in[0]; a.c = (const float*)d_in[1]; a.pos = (const int*)d_in[2]; a.w_ada = (const float*)d_in[3]; a.b_ada = (const float*)d_in[4]; a.norm_w = (const float*)d_in[5];
    a.w_in = (const float*)d_in[6]; a.b_if = (const float*)d_in[7]; a.sinks = (const float*)d_in[8]; a.conv_q = (const float*)d_in[9]; a.conv_k = (const float*)d_in[10]; a.m_norm_w = (const float*)d_in[11];
    a.w_att = (const float*)d_in[12]; a.w_m = (const float*)d_in[13]; a.w_out = (const float*)d_in[14]; a.fnorm_w = (const float*)d_in[15];
    a.out = (float*)d_out; a.ws = (unsigned char*)d_ws; a.pad = PROBE ? 1 : 0;
    unsigned char* ws = (unsigned char*)d_ws;
    auto run = [&](int lo, int hi, int li) { a.ph_lo = lo; a.ph_hi = hi; a.li = li; hipLaunchKernelGGL(skel_fwd, dim3(grid), dim3(NWAVES * 64), LDS_BYTES, stream, a); };
    run(0, N_PHASES, 0);
}
```

```cpp
#include <hip/hip_runtime.h>
#include <cstdio>
#include <cstdint>
template <int CTRL> __device__ __forceinline__ float dppf(float v) { return __builtin_bit_cast(float, __builtin_amdgcn_update_dpp(0, __builtin_bit_cast(int, v), CTRL, 0xf, 0xf, true)); }
template <int CTRL> __device__ __forceinline__ float dppf_id(float v, float ident) { return __builtin_bit_cast(float, __builtin_amdgcn_update_dpp(__builtin_bit_cast(int, ident), __builtin_bit_cast(int, v), CTRL, 0xf, 0xf, false)); }
__device__ __forceinline__ float row16_sum(float v) { v += dppf<0xB1>(v); v += dppf<0x4E>(v); v += dppf<0x141>(v); v += dppf<0x140>(v); return v; }
__device__ __forceinline__ float xor16_sum(float v) { float a = v, b = v; asm volatile("s_nop 1\n\tv_permlane16_swap_b32 %0, %1" : "+v"(a), "+v"(b)); return a + b; }
__device__ __forceinline__ float xor32_sum(float v) { float a = v, b = v; asm volatile("s_nop 1\n\tv_permlane32_swap_b32 %0, %1" : "+v"(a), "+v"(b)); return a + b; }
__device__ __forceinline__ float xor32_max(float v) { float a = v, b = v; asm volatile("s_nop 1\n\tv_permlane32_swap_b32 %0, %1" : "+v"(a), "+v"(b)); return fmaxf(a, b); }
__device__ __forceinline__ float wave_sum(float v) { return xor32_sum(xor16_sum(row16_sum(v))); }
__device__ __forceinline__ float lane_bcast(float v, int l) { return __builtin_bit_cast(float, __builtin_amdgcn_readlane(__builtin_bit_cast(int, v), l)); }
__device__ __forceinline__ float scan_sum64(float v, int lane) {
    v += dppf_id<0x111>(v, 0.f); v += dppf_id<0x112>(v, 0.f); v += dppf_id<0x114>(v, 0.f); v += dppf_id<0x118>(v, 0.f);
    const float t0 = lane_bcast(v, 15), t1 = lane_bcast(v, 31), t2 = lane_bcast(v, 47); const int row = lane >> 4;
    return v + (row >= 1 ? t0 : 0.f) + (row >= 2 ? t1 : 0.f) + (row >= 3 ? t2 : 0.f); }
__device__ __forceinline__ float scan_max64(float v, int lane) {
    const float NI = -__builtin_inff();
    v = fmaxf(v, dppf_id<0x111>(v, NI)); v = fmaxf(v, dppf_id<0x112>(v, NI)); v = fmaxf(v, dppf_id<0x114>(v, NI)); v = fmaxf(v, dppf_id<0x118>(v, NI));
    const float t0 = lane_bcast(v, 15), t1 = lane_bcast(v, 31), t2 = lane_bcast(v, 47); const int row = lane >> 4;
    return fmaxf(v, fmaxf(row >= 1 ? t0 : NI, fmaxf(row >= 2 ? t1 : NI, row >= 3 ? t2 : NI))); }
namespace pg8 {
#define PG8_LAS __attribute__((address_space(3)))
typedef unsigned short bf16_t;
typedef short bf16x8 __attribute__((ext_vector_type(8)));
typedef float f32x4 __attribute__((ext_vector_type(4)));
typedef unsigned u32x4 __attribute__((ext_vector_type(4)));
typedef unsigned u32x2 __attribute__((ext_vector_type(2)));
constexpr int BM = 256, BK = 64, HALF = 128, HTB = HALF * BK * 2  , STAGE_BYTES = 8 * HTB, NXCD = 8, WGM = 4;

__host__ __device__ __forceinline__ int lds_byte(int r, int c) { const int st = (r >> 4) * 2 + (c >> 5), rr = r & 15, cc = c & 31, ob = rr * 64 + cc * 2; return st * 1024 + (ob ^ (((ob >> 9) & 1) << 5)); }
__host__ __device__ __forceinline__ void stage_rc(int b, int& R, int& C) { const int st = b / 1024, sb = b % 1024, swz = sb ^ (((sb >> 9) & 1) << 5); R = (st >> 1) * 16 + swz / 64; C = (st & 1) * 32 + (swz % 64) / 2; }
__host__ __device__ __forceinline__ int perm32(int rho) { const int n = rho >> 4, i = rho & 15; return 8 * (i >> 2) + 4 * n + (i & 3); }

struct Unit { int pm, pn, seg; };
struct Gemm { const bf16_t* A; const bf16_t* Bt; int K, nt; };

struct StaticOrder {
    int nM, nN, nwg, G, c;
    __host__ __device__ void init(int M, int N, int G_, int c_) { nM = M / BM; nN = N / BM; nwg = nM * nN; G = G_; c = c_; }
    __host__ __device__ bool next(int i, Unit& u) const {
        const long L = (long)i * G + c; if (L >= nwg) return false;
        int wgid = (int)L; { const int q = nwg / NXCD, r = nwg % NXCD, xcd = wgid % NXCD, off = wgid / NXCD; wgid = (xcd < r ? xcd * (q + 1) : r * (q + 1) + (xcd - r) * q) + off; }
        const int nig = WGM * nN, gid = wgid / nig, fm = gid * WGM, gsz = (nM - fm) < WGM ? (nM - fm) : WGM;
        u.pm = fm + ((wgid % nig) % gsz); u.pn = (wgid % nig) / gsz; u.seg = 0; return true;
    }
    __device__ __forceinline__ void a_ready(const Unit&) const {}
    __device__ __forceinline__ void done(const Unit&) const {}
};
__device__ __forceinline__ unsigned cvt_pk_bf16(float lo, float hi) { unsigned r; asm volatile("v_cvt_pk_bf16_f32 %0, %1, %2" : "=v"(r) : "v"(lo), "v"(hi)); return r; }
__device__ __forceinline__ float bf_lo(unsigned w) { return __builtin_bit_cast(float, w << 16); }
__device__ __forceinline__ float bf_hi(unsigned w) { return __builtin_bit_cast(float, w & 0xffff0000u); }
__device__ __forceinline__ float sigmoidf_(float x) { return __builtin_amdgcn_rcpf(1.0f + __builtin_amdgcn_exp2f(-1.4426950408889634f * x)); }
__device__ __forceinline__ float og_(float mo, float mz) { return mz * __builtin_amdgcn_rcpf((1.0f + __builtin_amdgcn_exp2f(-1.4426950408889634f * mo)) * (1.0f + __builtin_amdgcn_exp2f(-1.4426950408889634f * mz))); }
typedef f32x4 acc_t[2][2][4][2];

struct EpiProj {
    static constexpr bool PERM = true; static constexpr int NT1 = 1 << 20; static constexpr ptrdiff_t DELTA_A = 0, DELTA_B = 0, SEG_A = 0, SEG_B = 0;
    bf16_t *Q, *Kb, *Vb, *AZ, *MQ, *MK, *MV, *OG, *GA, *GM; const int* pos;
    __device__ __forceinline__ void mid(acc_t&, const Unit&, int, int, int, int) const {}
    __device__ __forceinline__ void operator()(acc_t& acc, const Unit& u, int wr, int wc, int fr, int fq) const {
        asm volatile("" : "+v"(fr), "+v"(fq));
        const int pn = u.pn, row0 = u.pm * BM + wr * 64 + fr, cl = wc * 32 + 8 * fq;
        if (pn < 5) {
            const int i0 = 16 * (wc & 1) + 4 * fq;
            float cf[4];
#pragma unroll
            for (int e = 0; e < 4; ++e) cf[e] = __builtin_amdgcn_exp2f(-(float)(i0 + e) * (13.287712379549449f / 32.0f)) * 0.15915494309189535f;
            const float sc = (pn < 4) ? 0.125f * 1.4426950408889634f : 1.0f;
            bf16_t* base = (pn < 4) ? Q + (size_t)pn * BM : Kb; const int ld = (pn < 4) ? 1024 : 256;
#pragma unroll
            for (int ai = 0; ai < 2; ++ai)
#pragma unroll
                for (int m = 0; m < 4; ++m) { const int row = row0 + ai * HALF + m * 16; const float p = (float)pos[row];
                    float cs[4], sn[4];
#pragma unroll
                    for (int e = 0; e < 4; ++e) { const float rev = __builtin_amdgcn_fractf(p * cf[e]); sn[e] = __builtin_amdgcn_sinf(rev) * sc; cs[e] = __builtin_amdgcn_cosf(rev) * sc; }
#pragma unroll
                    for (int bj = 0; bj < 2; ++bj) { const f32x4 v0 = acc[ai][bj][m][0], v1 = acc[ai][bj][m][1]; u32x4 w;
                        w.x = cvt_pk_bf16(v0[0] * cs[0] - v0[1] * sn[0], v0[1] * cs[0] + v0[0] * sn[0]);
                        w.y = cvt_pk_bf16(v0[2] * cs[1] - v0[3] * sn[1], v0[3] * cs[1] + v0[2] * sn[1]);
                        w.z = cvt_pk_bf16(v1[0] * cs[2] - v1[1] * sn[2], v1[1] * cs[2] + v1[0] * sn[2]);
                        w.w = cvt_pk_bf16(v1[2] * cs[3] - v1[3] * sn[3], v1[3] * cs[3] + v1[2] * sn[3]);
                        __builtin_nontemporal_store(w, (u32x4*)(base + (size_t)row * ld + bj * HALF + cl)); } }
        } else if (pn >= 22 && pn < 30) {
            bf16_t* base = OG + (size_t)(pn - 22) * 128 + (cl >> 1);
#pragma unroll
            for (int ai = 0; ai < 2; ++ai)
#pragma unroll
                for (int m = 0; m < 4; ++m) { const int row = row0 + ai * HALF + m * 16;
#pragma unroll
                    for (int bj = 0; bj < 2; ++bj) { const f32x4 v0 = acc[ai][bj][m][0], v1 = acc[ai][bj][m][1]; u32x2 w;
                        w.x = cvt_pk_bf16(og_(v0[0], v0[1]), og_(v0[2], v0[3]));
                        w.y = cvt_pk_bf16(og_(v1[0], v1[1]), og_(v1[2], v1[3]));
                        __builtin_nontemporal_store(w, (u32x2*)(base + (size_t)row * 1024 + bj * 64)); } }
        } else {
            int act; bf16_t* base; int ld = 1024;
            if (pn == 5) { act = 0; base = Vb; ld = 256; }
            else if (pn < 10) { act = 1; base = AZ + (size_t)(pn - 6) * BM; }
            else if (pn < 14) { act = 0; base = MQ + (size_t)(pn - 10) * BM; }
            else if (pn < 18) { act = 0; base = MK + (size_t)(pn - 14) * BM; }
            else if (pn < 22) { act = 0; base = MV + (size_t)(pn - 18) * BM; }
            else if (pn < 34) { act = 2; base = GA + (size_t)(pn - 30) * BM; }
            else { act = 2; base = GM + (size_t)(pn - 34) * BM; }
#pragma unroll
            for (int ai = 0; ai < 2; ++ai)
#pragma unroll
                for (int m = 0; m < 4; ++m) { const int row = row0 + ai * HALF + m * 16;
#pragma unroll
                    for (int bj = 0; bj < 2; ++bj) { f32x4 v0 = acc[ai][bj][m][0], v1 = acc[ai][bj][m][1];
                        if (act) {
#pragma unroll
                            for (int e = 0; e < 4; ++e) { const float s0 = sigmoidf_(v0[e]), s1 = sigmoidf_(v1[e]); v0[e] = (act == 1) ? v0[e] * s0 : s0; v1[e] = (act == 1) ? v1[e] * s1 : s1; } }
                        u32x4 w; w.x = cvt_pk_bf16(v0[0], v0[1]); w.y = cvt_pk_bf16(v0[2], v0[3]); w.z = cvt_pk_bf16(v1[0], v1[1]); w.w = cvt_pk_bf16(v1[2], v1[3]);
                        __builtin_nontemporal_store(w, (u32x4*)(base + (size_t)row * ld + bj * HALF + cl)); } }
        }
    }
};

struct EpiMerge {
    static constexpr bool PERM = true; static constexpr int NT1 = 16; static constexpr ptrdiff_t DELTA_A = (ptrdiff_t)192 << 20, DELTA_B = (ptrdiff_t)2 << 20, SEG_A = 0, SEG_B = 0;
    const bf16_t *GA, *GM; bf16_t* OUT;
    __device__ __forceinline__ void mid(acc_t& acc, const Unit& u, int wr, int wc, int fr, int fq) const {
        asm volatile("" : "+v"(fr), "+v"(fq));
        const int row0 = u.pm * BM + wr * 64 + fr, col0 = u.pn * BM + wc * 32 + 8 * fq;
#pragma unroll
        for (int ai = 0; ai < 2; ++ai)
#pragma unroll
            for (int m = 0; m < 4; ++m)
#pragma unroll
                for (int bj = 0; bj < 2; ++bj) { const size_t o = (size_t)(row0 + ai * HALF + m * 16) * 1024 + col0 + bj * HALF;
                    const u32x4 a = *(const u32x4*)(GA + o), b = *(const u32x4*)(GM + o);
                    f32x4 r0, r1;
                    r0[0] = bf_lo(a.x) * __builtin_amdgcn_rcpf(fmaxf(bf_lo(b.x), 1e-30f)); r0[1] = bf_hi(a.x) * __builtin_amdgcn_rcpf(fmaxf(bf_hi(b.x), 1e-30f));
                    r0[2] = bf_lo(a.y) * __builtin_amdgcn_rcpf(fmaxf(bf_lo(b.y), 1e-30f)); r0[3] = bf_hi(a.y) * __builtin_amdgcn_rcpf(fmaxf(bf_hi(b.y), 1e-30f));
                    r1[0] = bf_lo(a.z) * __builtin_amdgcn_rcpf(fmaxf(bf_lo(b.z), 1e-30f)); r1[1] = bf_hi(a.z) * __builtin_amdgcn_rcpf(fmaxf(bf_hi(b.z), 1e-30f));
                    r1[2] = bf_lo(a.w) * __builtin_amdgcn_rcpf(fmaxf(bf_lo(b.w), 1e-30f)); r1[3] = bf_hi(a.w) * __builtin_amdgcn_rcpf(fmaxf(bf_hi(b.w), 1e-30f));
                    acc[ai][bj][m][0] *= r0; acc[ai][bj][m][1] *= r1; if (m == 3 && bj == 1) asm volatile("" ::: "memory"); }
    }
    __device__ __forceinline__ void operator()(acc_t& acc, const Unit& u, int wr, int wc, int fr, int fq) const {
        asm volatile("" : "+v"(fr), "+v"(fq));
        const int row0 = u.pm * BM + wr * 64 + fr, col0 = u.pn * BM + wc * 32 + 8 * fq;
#pragma unroll
        for (int ai = 0; ai < 2; ++ai)
#pragma unroll
            for (int m = 0; m < 4; ++m)
#pragma unroll
                for (int bj = 0; bj < 2; ++bj) { const size_t o = (size_t)(row0 + ai * HALF + m * 16) * 1024 + col0 + bj * HALF;
                    const u32x4 b = *(const u32x4*)(GM + o); const f32x4 v0 = acc[ai][bj][m][0], v1 = acc[ai][bj][m][1]; u32x4 w;
                    w.x = cvt_pk_bf16(v0[0] * bf_lo(b.x), v0[1] * bf_hi(b.x)); w.y = cvt_pk_bf16(v0[2] * bf_lo(b.y), v0[3] * bf_hi(b.y));
                    w.z = cvt_pk_bf16(v1[0] * bf_lo(b.z), v1[1] * bf_hi(b.z)); w.w = cvt_pk_bf16(v1[2] * bf_lo(b.w), v1[3] * bf_hi(b.w));
                    *(u32x4*)(OUT + o) = w; if (m == 3 && bj == 1) asm volatile("" ::: "memory"); }
    }
};

template <class Bar> struct EpiOutNorm {
    static constexpr bool PERM = true; static constexpr int NT1 = 1 << 20; static constexpr ptrdiff_t DELTA_A = 0, DELTA_B = 0, SEG_A = 0, SEG_B = 0;
    const float* X; const float* modacc; const float* b_ada; const float* fw; float* OUT; float* part; Bar bar;
    __device__ __forceinline__ void mid(acc_t&, const Unit&, int, int, int, int) const {}
    __device__ __forceinline__ void operator()(acc_t& acc, const Unit& u, int wr, int wc, int fr, int fq) const {
        asm volatile("" : "+v"(fr), "+v"(fq));
        const int row0 = u.pm * BM + wr * 64 + fr, col0 = u.pn * BM + wc * 32 + 8 * fq, b = (u.pm * BM) >> 12;
        {
            f32x4 gt[2][2];
#pragma unroll
            for (int bj = 0; bj < 2; ++bj)
#pragma unroll
                for (int n = 0; n < 2; ++n) gt[bj][n] = *(const f32x4*)(modacc + b * 3072 + 2048 + col0 + bj * HALF + 4 * n) + *(const f32x4*)(b_ada + 2048 + col0 + bj * HALF + 4 * n);
#pragma unroll
            for (int ai = 0; ai < 2; ++ai)
#pragma unroll
                for (int m = 0; m < 4; ++m) { const int row = row0 + ai * HALF + m * 16; float ss = 0.f;
#pragma unroll
                    for (int bj = 0; bj < 2; ++bj)
#pragma unroll
                        for (int n = 0; n < 2; ++n) { const size_t o = (size_t)row * 1024 + col0 + bj * HALF + 4 * n;
                            const f32x4 xv = __builtin_nontemporal_load((const f32x4*)(X + o)); const f32x4 y = xv + gt[bj][n] * acc[ai][bj][m][n];
                            acc[ai][bj][m][n] = y; ss += (y[0] * y[0] + y[1] * y[1]) + (y[2] * y[2] + y[3] * y[3]); }
                    ss = xor32_sum(xor16_sum(ss));
                    if (fq == 0) part[(size_t)row * 16 + u.pn * 4 + wc] = ss; if (m & 1) asm volatile("" ::: "memory"); }
        }
        bar();
        asm volatile("" : "+v"(fr), "+v"(fq));
        {
            const int row0b = u.pm * BM + wr * 64 + fr, col0b = u.pn * BM + wc * 32 + 8 * fq;
            f32x4 fv[2][2];
#pragma unroll
            for (int bj = 0; bj < 2; ++bj)
#pragma unroll
                for (int n = 0; n < 2; ++n) fv[bj][n] = *(const f32x4*)(fw + col0b + bj * HALF + 4 * n);
#pragma unroll
            for (int ai = 0; ai < 2; ++ai)
#pragma unroll
                for (int m = 0; m < 4; ++m) { const int row = row0b + ai * HALF + m * 16; const f32x4* pp = (const f32x4*)(part + (size_t)row * 16);
                    const f32x4 p0 = pp[0], p1 = pp[1], p2 = pp[2], p3 = pp[3];
                    const float s = ((p0[0] + p0[1]) + (p0[2] + p0[3])) + ((p1[0] + p1[1]) + (p1[2] + p1[3])) + ((p2[0] + p2[1]) + (p2[2] + p2[3])) + ((p3[0] + p3[1]) + (p3[2] + p3[3]));
                    const float rstd = 1.0f / sqrtf(s * (1.f / 1024.f) + 1e-6f);
#pragma unroll
                    for (int bj = 0; bj < 2; ++bj)
#pragma unroll
                        for (int n = 0; n < 2; ++n) *(f32x4*)(OUT + (size_t)row * 1024 + col0b + bj * HALF + 4 * n) = acc[ai][bj][m][n] * rstd * fv[bj][n];
                    if (m == 3) asm volatile("" ::: "memory"); }
        }
    }
};

template <class Epi, class Sched, bool ALIGN_EPI = true>
__device__ __forceinline__ void gemm_phase(PG8_LAS unsigned char* lds, const Gemm g, const Sched& S, const Epi& E) {
    const int tid = threadIdx.x, wid = __builtin_amdgcn_readfirstlane(tid >> 6), lane = tid & 63, wr = wid >> 2, wc = wid & 3, fr = lane & 15, fq = lane >> 4;
    const int K = g.K, nt = g.nt; constexpr int nt1 = Epi::NT1;
    unsigned voffA[2], voffB[2];
#pragma unroll
    for (int i = 0; i < 2; ++i) { int R, C; stage_rc(tid * 16 + i * 8192, R, C); const int Rb = Epi::PERM ? ((R & ~31) + perm32(R & 31)) : R;
        voffA[i] = (unsigned)(R * K + C) * 2u; voffB[i] = (unsigned)(Rb * K + C) * 2u; }
    const size_t kstep = (size_t)(BK * 2);
    const size_t hstep = (size_t)HALF * K * 2;
    const size_t tstep = 2 * hstep;
    const unsigned ldsw = (unsigned)wid * 1024u;
    const int aoff = lds_byte(wr * 64 + fr, fq * 8), boff = lds_byte(wc * 32 + fr, fq * 8);
#define PG8_SA(b, h) (((b) * 2 + (h)) * HTB)
#define PG8_SB(b, h) ((4 + (b) * 2 + (h)) * HTB)
#define PG8_STAGE(bufoff, gbase, voff) do { _Pragma("unroll") for (int _i = 0; _i < 2; ++_i) \
        __builtin_amdgcn_global_load_lds((const unsigned*)((const char*)(gbase) + (voff)[_i]), (PG8_LAS unsigned*)(lds + (bufoff) + ldsw + _i * 8192), 16, 0, 0); } while (0)
#define PG8_LDA(dst, b, h) do { _Pragma("unroll") for (int m = 0; m < 4; ++m) _Pragma("unroll") for (int k = 0; k < 2; ++k) dst[m][k] = *(const PG8_LAS bf16x8*)(lds + PG8_SA(b, h) + aoff + m * 2048 + k * 1024); } while (0)
#define PG8_LDB(dst, b, h) do { _Pragma("unroll") for (int n = 0; n < 2; ++n) _Pragma("unroll") for (int k = 0; k < 2; ++k) dst[n][k] = *(const PG8_LAS bf16x8*)(lds + PG8_SB(b, h) + boff + n * 2048 + k * 1024); } while (0)
#define PG8_MMA(ai, bj, At, Bt) do { __builtin_amdgcn_s_setprio(1); _Pragma("unroll") for (int m = 0; m < 4; ++m) _Pragma("unroll") for (int n = 0; n < 2; ++n) _Pragma("unroll") for (int k = 0; k < 2; ++k) \
        acc[ai][bj][m][n] = __builtin_amdgcn_mfma_f32_16x16x32_bf16(Bt[n][k], At[m][k], acc[ai][bj][m][n], 0, 0, 0); __builtin_amdgcn_s_setprio(0); } while (0)
#define PG8_WAIT_V(n) asm volatile("s_waitcnt vmcnt(" #n ")" ::: "memory")
#define PG8_WAIT_L(n) asm volatile("s_waitcnt lgkmcnt(" #n ")" ::: "memory")
#define PG8_BAR __builtin_amdgcn_s_barrier()
#define PG8_SCHED __builtin_amdgcn_sched_barrier(0)
#define PG8_TP(c0, dl, tt) ((c0) + ((nt1 >= (1 << 20) || (tt) < nt1) ? (ptrdiff_t)(tt) * (ptrdiff_t)kstep : (ptrdiff_t)(dl) + (ptrdiff_t)((tt) - nt1) * (ptrdiff_t)kstep))
    Unit cur, nxt; int ui = 0;
    if (!S.next(0, cur)) return;
    f32x4 acc[2][2][4][2];
#pragma unroll
    for (int a = 0; a < 2; ++a)
#pragma unroll
        for (int b = 0; b < 2; ++b)
#pragma unroll
            for (int m = 0; m < 4; ++m)
#pragma unroll
                for (int n = 0; n < 2; ++n) acc[a][b][m][n] = (f32x4){0.f, 0.f, 0.f, 0.f};
    bf16x8 At[4][2], B0[2][2], B1[2][2];
    const char* cA = (const char*)g.A + (size_t)cur.pm * tstep + (ptrdiff_t)cur.seg * Epi::SEG_A; const char* cB = (const char*)g.Bt + (size_t)cur.pn * tstep + (ptrdiff_t)cur.seg * Epi::SEG_B;
    S.a_ready(cur);
    {
        PG8_STAGE(PG8_SB(0, 0), cB, voffB); PG8_STAGE(PG8_SB(0, 1), cB + hstep, voffB); PG8_STAGE(PG8_SA(0, 0), cA, voffA); PG8_STAGE(PG8_SA(0, 1), cA + hstep, voffA);
        if (wr == 1) PG8_BAR;
        PG8_WAIT_V(2); PG8_BAR;
        PG8_STAGE(PG8_SB(1, 0), cB + kstep, voffB); PG8_STAGE(PG8_SA(1, 0), cA + kstep, voffA); PG8_STAGE(PG8_SB(1, 1), cB + hstep + kstep, voffB);
        PG8_WAIT_V(6); PG8_BAR;
    }
    for (;;) {
        const bool has_next = S.next(ui + 1, nxt);
        const char* nA = has_next ? (const char*)g.A + (size_t)nxt.pm * tstep + (ptrdiff_t)nxt.seg * Epi::SEG_A : cA; const char* nB = has_next ? (const char*)g.Bt + (size_t)nxt.pn * tstep + (ptrdiff_t)nxt.seg * Epi::SEG_B : cB;
        for (int t = 0; t < nt; t += 2) {
            const bool last = (t == nt - 2);
            if constexpr (nt1 < (1 << 20)) { if (t == nt1) E.mid(acc, cur, wr, wc, fr, fq); }
            const char* a1 = PG8_TP(cA, Epi::DELTA_A, t + 1);
            const char* a2 = last ? nA : PG8_TP(cA, Epi::DELTA_A, t + 2); const char* b2 = last ? nB : PG8_TP(cB, Epi::DELTA_B, t + 2);
            const char* a3 = last ? nA + kstep : PG8_TP(cA, Epi::DELTA_A, t + 3); const char* b3 = last ? nB + kstep : PG8_TP(cB, Epi::DELTA_B, t + 3);
            if (last && has_next) S.a_ready(nxt);
            PG8_LDB(B0, 0, 0); PG8_LDB(B1, 0, 1); PG8_SCHED; PG8_LDA(At, 0, 0); PG8_STAGE(PG8_SA(1, 1), a1 + hstep, voffA);
            PG8_WAIT_V(8); PG8_WAIT_L(0); PG8_BAR; PG8_MMA(0, 0, At, B0); PG8_MMA(0, 1, At, B1); PG8_BAR; PG8_SCHED;
            PG8_LDA(At, 0, 1); PG8_STAGE(PG8_SB(0, 0), b2, voffB); PG8_STAGE(PG8_SB(0, 1), b2 + hstep, voffB); PG8_STAGE(PG8_SA(0, 0), a2, voffA);
            PG8_WAIT_V(8); PG8_WAIT_L(0); PG8_BAR; PG8_MMA(1, 0, At, B0); PG8_MMA(1, 1, At, B1); PG8_BAR; PG8_SCHED;
            PG8_LDB(B0, 1, 0); PG8_LDB(B1, 1, 1); PG8_SCHED; PG8_LDA(At, 1, 0); PG8_STAGE(PG8_SA(0, 1), a2 + hstep, voffA);
            PG8_WAIT_V(8); PG8_WAIT_L(0); PG8_BAR; PG8_MMA(0, 0, At, B0); PG8_MMA(0, 1, At, B1); PG8_BAR; PG8_SCHED;
            PG8_LDA(At, 1, 1); PG8_STAGE(PG8_SB(1, 0), b3, voffB); PG8_STAGE(PG8_SB(1, 1), b3 + hstep, voffB); PG8_STAGE(PG8_SA(1, 0), a3, voffA);
            PG8_WAIT_V(8); PG8_WAIT_L(0); PG8_BAR; PG8_MMA(1, 0, At, B0); PG8_MMA(1, 1, At, B1); PG8_BAR; PG8_SCHED;
        }
        if constexpr (ALIGN_EPI) { if (wr == 0) PG8_BAR; }
        E(acc, cur, wr, wc, fr, fq); S.done(cur);
        if (!has_next) break;
#pragma unroll
        for (int a = 0; a < 2; ++a)
#pragma unroll
            for (int b = 0; b < 2; ++b)
#pragma unroll
                for (int m = 0; m < 4; ++m)
#pragma unroll
                    for (int n = 0; n < 2; ++n) acc[a][b][m][n] = (f32x4){0.f, 0.f, 0.f, 0.f};
        cur = nxt; cA = nA; cB = nB; ++ui;
        if constexpr (ALIGN_EPI) { if (wr == 1) PG8_BAR; }
    }
    PG8_WAIT_V(0);
    if constexpr (!ALIGN_EPI) { if (wr == 0) PG8_BAR; }
    PG8_BAR;
#undef PG8_SA
#undef PG8_SB
#undef PG8_STAGE
#undef PG8_LDA
#undef PG8_LDB
#undef PG8_MMA
#undef PG8_WAIT_V
#undef PG8_WAIT_L
#undef PG8_BAR
#undef PG8_SCHED
#undef PG8_TP
}
}

constexpr int BATCH = 8, SEQ = 4096, D = 1024, M = BATCH * SEQ;
constexpr int IN_WIDTH = 9736, NPROJ = 9728;
constexpr int COL_MI = 7680;
constexpr int AH = 16, AKV = 4, AHD = 64, WINDOW = 128;
constexpr int MH = 4, MHD = 256;
constexpr float EPS = 1e-6f;
constexpr int NWAVES = 8;

constexpr size_t MiB = 1u << 20;
constexpr size_t WS_CTL = 0, CTL_ZERO_BYTES = 1 * MiB;
constexpr size_t WS_MOD = 512 * 1024;
constexpr size_t WS_WIN = 1 * MiB;
constexpr size_t WS_NCK = 1 * MiB, WS_MCK = 2 * MiB, WS_UN = 3 * MiB, WS_UST = 4 * MiB;
constexpr size_t WS_PART = 10 * MiB;
constexpr size_t WS_WATT = 20 * MiB, WS_WM = 22 * MiB, WS_WOUT = 24 * MiB;
constexpr size_t WS_IG = 26 * MiB, WS_LF = WS_IG + 512 * 1024;
constexpr size_t WS_K = 27 * MiB, WS_V = 43 * MiB;
constexpr size_t WS_XN = 60 * MiB;
constexpr size_t WS_Q = 124 * MiB;
constexpr size_t WS_AZ = 188 * MiB;
constexpr size_t WS_MQ = 252 * MiB, WS_MK = 316 * MiB;
constexpr size_t WS_MV = 380 * MiB;
constexpr size_t WS_KC = WS_XN;
constexpr size_t WS_OG = 444 * MiB;
constexpr size_t WS_HALO = 508 * MiB;
constexpr size_t WS_END = 511 * MiB;
constexpr int CW_BAR = 4096;

constexpr int RING_OFF = 0, RING_BYTES = 131072;
constexpr int LDS_BYTES = 163840;
constexpr int LDSCTL_OFF = LDS_BYTES - 1024, MISC_OFF = LDSCTL_OFF + 320;

#define GAS __attribute__((address_space(1)))
#define LAS __attribute__((address_space(3)))
typedef unsigned short bf16;
typedef unsigned v4u __attribute__((ext_vector_type(4)));
typedef unsigned v2u __attribute__((ext_vector_type(2)));
typedef float f32x4 __attribute__((ext_vector_type(4)));
typedef short bf16x8 __attribute__((ext_vector_type(8)));
typedef GAS unsigned gu32;
#define RLX_AGENT __ATOMIC_RELAXED, __HIP_MEMORY_SCOPE_AGENT
#define LDS_WAIT() asm volatile("s_waitcnt lgkmcnt(0)" ::: "memory")
#define VM_WAIT() asm volatile("s_waitcnt vmcnt(0)" ::: "memory")
__device__ __forceinline__ unsigned f2bf(float f) { unsigned u = __builtin_bit_cast(unsigned, f); return (u + 0x7fffu + ((u >> 16) & 1u)) >> 16; }
__device__ __forceinline__ unsigned pk2(float lo, float hi) { return f2bf(lo) | (f2bf(hi) << 16); }
__device__ __forceinline__ float bf2f(bf16 v) { return __builtin_bit_cast(float, (unsigned)v << 16); }

#define XB_TMO      128
#define XB_XCNT(j)  (256  + 64 * (j))
#define XB_XSUB(j)  (1280 + 64 * (j))
#define XB_XGEN(j)  (2304 + 64 * (j))
#define XB_TOP      3328
#define XB_TOPGEN   3392
#define XCD_BAR_WORDS 3456
#define XB_SPIN_CAP (1u << 18)

__device__ __forceinline__ unsigned xb_ld(unsigned* p)              { return __hip_atomic_load(p, __ATOMIC_RELAXED, __HIP_MEMORY_SCOPE_AGENT); }
__device__ __forceinline__ unsigned xb_add(unsigned* p, unsigned v) { return __hip_atomic_fetch_add(p, v, __ATOMIC_RELAXED, __HIP_MEMORY_SCOPE_AGENT); }
__device__ __forceinline__ unsigned xb_xcc_id() { return (unsigned)__builtin_amdgcn_s_getreg((3 << 11) | 20) & 0xFu; }
#define XB_SPIN(cond, bar) do { unsigned _sp = 0; while (cond) { __builtin_amdgcn_s_sleep(1); \
    if ((++_sp & 255u) == 0u) { if (xb_ld(&(bar)[XB_TMO])) break; if (_sp > XB_SPIN_CAP) { atomicAdd(&(bar)[XB_TMO], 1u); break; } } } } while (0)

struct XcdBarrier {
    unsigned* bar; unsigned x;
    volatile LAS unsigned* st;
};
__device__ __forceinline__ XcdBarrier xcd_barrier_post(unsigned* bar, volatile LAS unsigned* st) {
    XcdBarrier b; b.bar = bar; b.x = xb_xcc_id(); b.st = st;
    if (threadIdx.x == 0) (void)xb_add(&bar[XB_XCNT(b.x)], 1u);
    return b;
}
__device__ __forceinline__ void xcd_barrier_complete(unsigned* bar, unsigned x, unsigned& nloc, unsigned& nx) {
    const unsigned G = gridDim.x * gridDim.y * gridDim.z;
    unsigned sum, cnt, mine, sp = 0u;
    for (;;) {
        sum = 0u; cnt = 0u; mine = 0u;
#pragma unroll
        for (unsigned j = 0; j < 16; ++j) { const unsigned c = xb_ld(&bar[XB_XCNT(j)]); sum += c; cnt += (c > 0u) ? 1u : 0u; mine = (j == x) ? c : mine; }
        if (sum == G) break;
        __builtin_amdgcn_s_sleep(1);
        if ((++sp & 255u) == 0u) { if (xb_ld(&bar[XB_TMO])) break; if (sp > XB_SPIN_CAP) { atomicAdd(&bar[XB_TMO], 1u); break; } }
    }
    nloc = mine > 0u ? mine : 1u; nx = cnt > 0u ? cnt : 1u;
}
__device__ __forceinline__ void xcd_barrier(const XcdBarrier& b) {
    asm volatile("s_waitcnt vmcnt(0)" ::: "memory");
    __syncthreads();
    if (threadIdx.x == 0) {
        unsigned* bar = b.bar;
        __builtin_amdgcn_s_waitcnt(0);
        unsigned nloc = b.st[0], nx = b.st[1];
        if (nloc == 0u) { xcd_barrier_complete(bar, b.x, nloc, nx); b.st[0] = nloc; b.st[1] = nx; }
        const unsigned old = xb_add(&bar[XB_XSUB(b.x)], 1u);
        const unsigned gen = old / nloc;
        if (old + 1u == (gen + 1u) * nloc) {
            __builtin_amdgcn_fence(__ATOMIC_RELEASE, "agent");
            asm volatile("s_waitcnt vmcnt(0)" ::: "memory");
            const unsigned og = xb_add(&bar[XB_TOP], 1u);
            const unsigned tg = og / nx;
            if (og + 1u == (tg + 1u) * nx) xb_add(&bar[XB_TOPGEN], 1u);
            else XB_SPIN(xb_ld(&bar[XB_TOPGEN]) == tg, bar);
            __builtin_amdgcn_fence(__ATOMIC_ACQUIRE, "agent");
            xb_add(&bar[XB_XGEN(b.x)], 1u);
            asm volatile("s_waitcnt vmcnt(0)" ::: "memory");
        } else {
            XB_SPIN(xb_ld(&bar[XB_XGEN(b.x)]) == gen, bar);
            __builtin_amdgcn_fence(__ATOMIC_ACQUIRE, "agent");
            asm volatile("s_waitcnt vmcnt(0)" ::: "memory");
        }
    }
    __syncthreads();
}

struct Frame {
    LAS unsigned char* lds;
    volatile LAS unsigned* MISC;
    gu32* ctl;
    int tid, lane, wave;
    int vcu, G;
};

__device__ __forceinline__ int win_src_col(int n) {
    if (n < 1280) { const int hb = n & ~63, j = n & 63; return hb + (j >> 1) + 32 * (j & 1); }
    if (n < 5632) return n;
    if (n < 7680) { const int idx = n - 5632; return ((idx & 1) ? 6656 : 5632) + (idx >> 1); }
    return n + 8;
}
template <bool MAP>
__device__ __forceinline__ void p0_transpose_item(const float* W, int K, int Nsrc, int ndst, bf16* WT, LAS float* scr, int item, int lane) {
    const int nblk = ndst / 32, kb = item / nblk, nb = item % nblk, k0 = 64 * kb, n0 = 32 * nb;
    const int sc = MAP ? win_src_col(n0 + (lane & 31)) : n0 + (lane & 31);
    float v[32];
#pragma unroll
    for (int i = 0; i < 32; ++i) v[i] = W[(size_t)(k0 + 2 * i + (lane >> 5)) * Nsrc + sc];
#pragma unroll
    for (int i = 0; i < 32; ++i) scr[(2 * i + (lane >> 5)) * 33 + (lane & 31)] = v[i];
    LDS_WAIT(); asm volatile("" ::: "memory");
    const int c = lane & 7;
#pragma unroll
    for (int j = 0; j < 4; ++j) { const int n = (lane >> 3) + 8 * j; const LAS float* s = scr + (8 * c) * 33 + n;
        v4u o; o.x = pk2(s[0 * 33], s[1 * 33]); o.y = pk2(s[2 * 33], s[3 * 33]); o.z = pk2(s[4 * 33], s[5 * 33]); o.w = pk2(s[6 * 33], s[7 * 33]);
        *(GAS v4u*)(WT + (size_t)(n0 + n) * K + k0 + 8 * c) = o; }
    LDS_WAIT(); asm volatile("" ::: "memory");
}

struct Args {
    const float* x; const float* c; const int* pos; const float* w_ada; const float* b_ada; const float* norm_w; const float* w_in; const float* b_if;
    const float* sinks; const float* conv_q; const float* conv_k; const float* m_norm_w; const float* w_att; const float* w_m; const float* w_out; const float* fnorm_w;
    float* out; unsigned char* ws; int ph_lo, ph_hi, li, pad;
};

__device__ __forceinline__ void p0_prologue(Frame& F, const Args& a) {
    LAS float* scr = (LAS float*)(F.lds + RING_OFF + F.wave * 16384);
    const int gw = F.vcu * NWAVES + F.wave, NGW = F.G * NWAVES;
    float* mod = (float*)(a.ws + WS_MOD);
    constexpr int I_ADA = 48 * 32;
    for (int r = gw; r < I_ADA; r += NGW) {
        const int cg = r >> 5, ks = r & 31, n = cg * 64 + F.lane, k0 = ks * 32;
#pragma unroll
        for (int j = 0; j < 4; ++j) { const int idx = F.lane + 64 * j, b = idx >> 5, kk = idx & 31; const float cv = a.c[b * D + k0 + kk]; scr[idx] = cv / (1.0f + __expf(-cv)); }
        LDS_WAIT(); asm volatile("" ::: "memory");
        float s[8] = {0.f, 0.f, 0.f, 0.f, 0.f, 0.f, 0.f, 0.f};
#pragma unroll 8
        for (int kk = 0; kk < 32; ++kk) { const float w = a.w_ada[(size_t)(k0 + kk) * 3072 + n];
#pragma unroll
            for (int b = 0; b < 8; ++b) s[b] += scr[b * 32 + kk] * w; }
#pragma unroll
        for (int b = 0; b < 8; ++b) atomicAdd(mod + b * 3072 + n, s[b]);
        LDS_WAIT(); asm volatile("" ::: "memory");
    }
}
__device__ __forceinline__ void weight_copies(Frame& F, const Args& a) {
    LAS float* scr = (LAS float*)(F.lds + RING_OFF + F.wave * 16384);
    const int gw = F.vcu * NWAVES + F.wave, NGW = F.G * NWAVES;
    bf16* WIN = (bf16*)(a.ws + WS_WIN); bf16* WATT = (bf16*)(a.ws + WS_WATT); bf16* WM = (bf16*)(a.ws + WS_WM); bf16* WOUT = (bf16*)(a.ws + WS_WOUT);
    constexpr int I_IN = (D / 64) * (NPROJ / 32), I_SQ = (D / 64) * (D / 32);
    constexpr int NITEMS = I_IN + 3 * I_SQ;
    for (int it = NGW - 1 - gw; it < NITEMS; it += NGW) {
        int r = it;
        if (r < I_IN) { p0_transpose_item<true>(a.w_in, D, IN_WIDTH, NPROJ, WIN, scr, r, F.lane); continue; } r -= I_IN;
        if (r < I_SQ) { p0_transpose_item<false>(a.w_att, D, D, D, WATT, scr, r, F.lane); continue; } r -= I_SQ;
        if (r < I_SQ) { p0_transpose_item<false>(a.w_m, D, D, D, WM, scr, r, F.lane); continue; } r -= I_SQ;
        p0_transpose_item<false>(a.w_out, D, D, D, WOUT, scr, r, F.lane);
    }
}

typedef float p1f2 __attribute__((ext_vector_type(2)));
__device__ __forceinline__ void p1_norm(Frame& F, const Args& a) {
    LAS float* wg = (LAS float*)(F.lds + RING_OFF);
    for (int k = F.tid; k < D; k += NWAVES * 64) { const f32x4* s = (const f32x4*)(a.w_in + (size_t)k * IN_WIDTH + COL_MI); const int j = k >> 8, ln = (k & 255) >> 2, e = k & 3;
        *(LAS f32x4*)(wg + (((j * 4 + e) * 2 + 0) * 64 + ln) * 4) = s[0]; *(LAS f32x4*)(wg + (((j * 4 + e) * 2 + 1) * 64 + ln) * 4) = s[1]; }
    const float* mod = (const float*)(a.ws + WS_MOD);
    LAS float* tca = wg + 8192; LAS float* tcc = tca + 8192;
    for (int i = F.tid; i < BATCH * 256; i += NWAVES * 64) { const int b = i >> 8, k = (i & 255) * 4;
        const f32x4 nw = *(const f32x4*)(a.norm_w + k);
        const f32x4 sh = *(const f32x4*)(mod + b * 3072 + k) + *(const f32x4*)(a.b_ada + k);
        const f32x4 sc = *(const f32x4*)(mod + b * 3072 + 1024 + k) + *(const f32x4*)(a.b_ada + 1024 + k);
        *(LAS f32x4*)(tca + b * 1024 + k) = nw * (sc + 1.0f); *(LAS f32x4*)(tcc + b * 1024 + k) = sh; }
    __syncthreads();
    bf16* XN = (bf16*)(a.ws + WS_XN); float* IG = (float*)(a.ws + WS_IG); float* LF = (float*)(a.ws + WS_LF);
    const int gw = F.vcu * NWAVES + F.wave, NGW = F.G * NWAVES;
    constexpr int GR = 2;
    {
        const int NG = M / GR;
        f32x4 vbuf[GR][4], vbuf2[GR][4];
#pragma unroll
        for (int q = 0; q < GR; ++q)
#pragma unroll
            for (int j = 0; j < 4; ++j) { vbuf[q][j] = (f32x4){0.f, 0.f, 0.f, 0.f}; vbuf2[q][j] = vbuf[q][j]; }
        if (gw < NG) {
#pragma unroll
            for (int q = 0; q < GR; ++q) { const GAS f32x4* xr = (const GAS f32x4*)(a.x + (size_t)(gw * GR + q) * D) + F.lane;
#pragma unroll
                for (int j = 0; j < 4; ++j) vbuf[q][j] = __builtin_nontemporal_load(xr + 64 * j); } }
        if (gw + NGW < NG) {
#pragma unroll
            for (int q = 0; q < GR; ++q) { const GAS f32x4* xr = (const GAS f32x4*)(a.x + (size_t)((gw + NGW) * GR + q) * D) + F.lane;
#pragma unroll
                for (int j = 0; j < 4; ++j) vbuf2[q][j] = __builtin_nontemporal_load(xr + 64 * j); } }
#pragma unroll 1
        for (int grp = gw; grp < NG; grp += NGW) {
            int rowg = grp * GR; asm volatile("" : "+s"(rowg));
            const int b = rowg >> 12;
            f32x4 vcur[GR][4];
#pragma unroll
            for (int q = 0; q < GR; ++q)
#pragma unroll
                for (int j = 0; j < 4; ++j) { vcur[q][j] = vbuf[q][j]; vbuf[q][j] = vbuf2[q][j]; }
            if (grp + 2 * NGW < NG) {
#pragma unroll
                for (int q = 0; q < GR; ++q) { const GAS f32x4* xr = (const GAS f32x4*)(a.x + (size_t)((grp + 2 * NGW) * GR + q) * D) + F.lane;
#pragma unroll
                    for (int j = 0; j < 4; ++j) vbuf2[q][j] = __builtin_nontemporal_load(xr + 64 * j); } }
            float rstd[GR];
#pragma unroll
            for (int q = 0; q < GR; ++q) { float s2 = 0.f;
#pragma unroll
                for (int j = 0; j < 4; ++j) { const f32x4 v = vcur[q][j]; s2 += (v.x * v.x + v.y * v.y) + (v.z * v.z + v.w * v.w); }
                rstd[q] = __builtin_amdgcn_rsqf(wave_sum(s2) * (1.f / D) + EPS); }
            p1f2 g[GR][4];
#pragma unroll
            for (int q = 0; q < GR; ++q)
#pragma unroll
                for (int i = 0; i < 4; ++i) g[q][i] = (p1f2){0.f, 0.f};
#pragma unroll
            for (int j = 0; j < 4; ++j) { f32x4 h[GR]; const f32x4 caj = *(const LAS f32x4*)(tca + b * 1024 + 256 * j + 4 * F.lane), ccj = *(const LAS f32x4*)(tcc + b * 1024 + 256 * j + 4 * F.lane);
#pragma unroll
                for (int q = 0; q < GR; ++q) { h[q] = vcur[q][j] * rstd[q] * caj + ccj;
                    v2u o; o.x = pg8::cvt_pk_bf16(h[q].x, h[q].y); o.y = pg8::cvt_pk_bf16(h[q].z, h[q].w); ((GAS v2u*)(XN + (size_t)(rowg + q) * D) + F.lane)[64 * j] = o; }
#pragma unroll
                for (int e = 0; e < 4; ++e) { const f32x4 w0 = *(const LAS f32x4*)(wg + (((j * 4 + e) * 2 + 0) * 64 + F.lane) * 4), w1 = *(const LAS f32x4*)(wg + (((j * 4 + e) * 2 + 1) * 64 + F.lane) * 4);
                    const p1f2 wa = {w0.x, w0.y}, wb = {w0.z, w0.w}, wc = {w1.x, w1.y}, wd = {w1.z, w1.w};
#pragma unroll
                    for (int q = 0; q < GR; ++q) { const float hv = h[q][e]; g[q][0] += hv * wa; g[q][1] += hv * wb; g[q][2] += hv * wc; g[q][3] += hv * wd; } } }
#pragma unroll
            for (int q = 0; q < GR; ++q) {
                const int row = rowg + q;
                float h4[4];
#pragma unroll
                for (int i = 0; i < 4; ++i) { float aa = g[q][i >> 1][i & 1], bb = g[q][2 + (i >> 1)][i & 1]; asm volatile("s_nop 1\n\tv_permlane32_swap_b32 %0, %1" : "+v"(aa), "+v"(bb)); h4[i] = aa + bb; }
                float u0, u1;
                { float aa = h4[0], bb = h4[2]; asm volatile("s_nop 1\n\tv_permlane16_swap_b32 %0, %1" : "+v"(aa), "+v"(bb)); u0 = aa + bb; }
                { float aa = h4[1], bb = h4[3]; asm volatile("s_nop 1\n\tv_permlane16_swap_b32 %0, %1" : "+v"(aa), "+v"(bb)); u1 = aa + bb; }
                u0 += dppf<0x128>(u0); u1 += dppf<0x128>(u1);
                float val = (F.lane & 8) ? u1 : u0;
                val += dppf<0x141>(val); val += dppf<0xB1>(val); val += dppf<0x4E>(val);
                const int gi = 4 * (F.lane >> 5) + 2 * ((F.lane >> 4) & 1) + ((F.lane >> 3) & 1);
                val += a.b_if[gi];
                if ((F.lane & 7) == 0) {
                    if (gi < 4) IG[((size_t)b * MH + gi) * SEQ + (row & (SEQ - 1))] = val;
                    else LF[((size_t)b * MH + (gi - 4)) * SEQ + (row & (SEQ - 1))] = fminf(val, 0.f) - __logf(1.0f + __expf(-fabsf(val))); }
            }
        }
    }
}


typedef float f32x16 __attribute__((ext_vector_type(16)));
typedef short s16x4 __attribute__((ext_vector_type(4)));
__device__ __forceinline__ int crow(int r, int hi) { return (r & 3) + 8 * (r >> 2) + 4 * hi; }
constexpr int ATT_VT_OFF = 32768, ATT_VT_PITCH = 520;
__device__ __forceinline__ void attn_phase(Frame& F, const Args& a, const int nostore = 0) {
    const bf16* Q = (const bf16*)(a.ws + WS_Q); const bf16* K = (const bf16*)(a.ws + WS_K); const bf16* V = (const bf16*)(a.ws + WS_V); bf16* AZ = (bf16*)(a.ws + WS_AZ);
    LAS unsigned char* Ks = F.lds; LAS unsigned char* Vt = F.lds + ATT_VT_OFF;
    const int tid = F.tid, lane = F.lane, w = F.wave, q32 = lane & 31, hi = lane >> 5;
    const int kp = tid >> 2, dq = tid & 3;
    v4u kreg[4], va0, va1, vb0, vb1;
#define AT_LOAD(uid_) do { int tid = F.tid; asm volatile("" : "+v"(tid)); const int kp = tid >> 2, dq = tid & 3; const int b_ = (uid_) >> 7, kvh_ = ((uid_) >> 5) & 3, qb_ = (uid_) & 31; const long f0_ = (long)b_ * SEQ + qb_ * 128 - 128; \
        _Pragma("unroll") for (int j = 0; j < 4; ++j) { const int idx = tid + 512 * j, key = idx >> 3, c = idx & 7; kreg[j] = (v4u){0u, 0u, 0u, 0u}; \
            if (qb_ > 0 || key >= 128) kreg[j] = *(const v4u*)(K + (f0_ + key) * 256 + kvh_ * 64 + c * 8); } \
        va0 = (v4u){0u, 0u, 0u, 0u}; va1 = va0; vb0 = va0; vb1 = va0; \
        if (qb_ > 0 || kp >= 64) { const bf16* p = V + (f0_ + 2 * kp) * 256 + kvh_ * 64 + dq * 16; va0 = *(const v4u*)p; va1 = *(const v4u*)(p + 8); vb0 = *(const v4u*)(p + 256); vb1 = *(const v4u*)(p + 264); } } while (0)
    const int uid0 = F.vcu;
    if (uid0 < BATCH * AKV * 32) AT_LOAD(uid0);
    for (int uid = uid0; uid < BATCH * AKV * 32; uid += F.G) {
        const int b = uid >> 7, kvh = (uid >> 5) & 3, qblk = uid & 31;
        const int head = kvh * 4 + (w >> 1);
        bf16x8 qf[2][4]; v2u zz[2][8];
#pragma unroll
        for (int sb = 0; sb < 2; ++sb) { const long qrow = (long)b * SEQ + qblk * 128 + (w & 1) * 64 + sb * 32 + q32;
#pragma unroll
            for (int s = 0; s < 4; ++s) qf[sb][s] = *(const bf16x8*)(Q + qrow * 1024 + head * 64 + 16 * s + 8 * hi);
#pragma unroll
            for (int i = 0; i < 8; ++i) zz[sb][i] = *(const v2u*)(AZ + qrow * 1024 + head * 64 + 4 * hi + (i >> 2) * 32 + 8 * (i & 3)); }
        __syncthreads();
#pragma unroll
        for (int j = 0; j < 4; ++j) { const int idx = tid + 512 * j, key = idx >> 3, c = idx & 7; *(LAS v4u*)(Ks + key * 128 + ((c ^ (key & 7)) << 4)) = kreg[j]; }
        { LAS unsigned char* dst = Vt + (16 * dq) * ATT_VT_PITCH + kp * 4;
#define VT_W(e, x, y) *(LAS unsigned*)(dst + (e) * ATT_VT_PITCH) = ((x) & 0xffffu) | ((y) << 16); *(LAS unsigned*)(dst + ((e) + 1) * ATT_VT_PITCH) = ((x) >> 16) | ((y) & 0xffff0000u)
            VT_W(0, va0.x, vb0.x); VT_W(2, va0.y, vb0.y); VT_W(4, va0.z, vb0.z); VT_W(6, va0.w, vb0.w); VT_W(8, va1.x, vb1.x); VT_W(10, va1.y, vb1.y); VT_W(12, va1.z, vb1.z); VT_W(14, va1.w, vb1.w);
#undef VT_W
        }
        __syncthreads();
        { const int nuid = uid + F.G; if (nuid < BATCH * AKV * 32) AT_LOAD(nuid); }
        const float sink2 = a.sinks[head] * 1.4426950408889634f;
#pragma unroll
        for (int sb = 0; sb < 2; ++sb) {
            const int r0 = (w & 1) * 64 + sb * 32, kt0 = r0 >> 5, rq = r0 + q32;
            const long qrow = (long)b * SEQ + qblk * 128 + rq;
            f32x16 p[5];
#pragma unroll
            for (int kt = 0; kt < 5; ++kt) { const int key = 32 * (kt0 + kt) + q32; f32x16 acc = {};
#pragma unroll
                for (int s = 0; s < 4; ++s) { const bf16x8 kf = *(const LAS bf16x8*)(Ks + key * 128 + (((2 * s + hi) ^ (key & 7)) << 4)); acc = __builtin_amdgcn_mfma_f32_32x32x16_bf16(kf, qf[sb][s], acc, 0, 0, 0); }
                p[kt] = acc; }
            float mx = sink2;
#pragma unroll
            for (int r = 0; r < 16; ++r) { p[0][r] = (crow(r, hi) > q32) ? p[0][r] : -INFINITY; p[4][r] = (crow(r, hi) <= q32) ? p[4][r] : -INFINITY; }
            if (qblk == 0) {
#pragma unroll
                for (int kt = 0; kt < 4; ++kt) if (kt0 + kt < 4) {
#pragma unroll
                    for (int r = 0; r < 16; ++r) p[kt][r] = -INFINITY; } }
#pragma unroll
            for (int kt = 0; kt < 5; ++kt)
#pragma unroll
                for (int r = 0; r < 16; ++r) mx = fmaxf(mx, p[kt][r]);
            mx = xor32_max(mx);
            float l = 0.f;
#pragma unroll
            for (int kt = 0; kt < 5; ++kt)
#pragma unroll
                for (int r = 0; r < 16; ++r) { const float e = __builtin_amdgcn_exp2f(p[kt][r] - mx); p[kt][r] = e; l += e; }
            l = xor32_sum(l) + __builtin_amdgcn_exp2f(sink2 - mx);
            f32x16 o[2] = {f32x16{}, f32x16{}};
#pragma unroll
            for (int kt = 0; kt < 5; ++kt)
#pragma unroll
                for (int s = 0; s < 2; ++s) { v4u pw; pw.x = pg8::cvt_pk_bf16(p[kt][8 * s + 0], p[kt][8 * s + 1]); pw.y = pg8::cvt_pk_bf16(p[kt][8 * s + 2], p[kt][8 * s + 3]);
                    pw.z = pg8::cvt_pk_bf16(p[kt][8 * s + 4], p[kt][8 * s + 5]); pw.w = pg8::cvt_pk_bf16(p[kt][8 * s + 6], p[kt][8 * s + 7]);
                    const bf16x8 pb = __builtin_bit_cast(bf16x8, pw); const int kb = 32 * (kt0 + kt) + 16 * s + 4 * hi;
#pragma unroll
                    for (int dt = 0; dt < 2; ++dt) { const LAS unsigned char* vp = Vt + (dt * 32 + q32) * ATT_VT_PITCH + kb * 2;
                        const s16x4 v0 = *(const LAS s16x4*)vp, v1 = *(const LAS s16x4*)(vp + 16);
                        const bf16x8 vf = (bf16x8){v0[0], v0[1], v0[2], v0[3], v1[0], v1[1], v1[2], v1[3]};
                        o[dt] = __builtin_amdgcn_mfma_f32_32x32x16_bf16(vf, pb, o[dt], 0, 0, 0); } }
            const float rl = 1.0f / l; bf16* ap = AZ + qrow * 1024 + head * 64 + 4 * hi;
#pragma unroll
            for (int dt = 0; dt < 2; ++dt)
#pragma unroll
                for (int g = 0; g < 4; ++g) { bf16* pp = ap + dt * 32 + 8 * g; const v2u z = zz[sb][dt * 4 + g]; v2u ov;
                    ov.x = pg8::cvt_pk_bf16(o[dt][4 * g + 0] * rl * pg8::bf_lo(z.x), o[dt][4 * g + 1] * rl * pg8::bf_hi(z.x));
                    ov.y = pg8::cvt_pk_bf16(o[dt][4 * g + 2] * rl * pg8::bf_lo(z.y), o[dt][4 * g + 3] * rl * pg8::bf_hi(z.y));
                    asm volatile("" :: "v"(ov.x), "v"(ov.y)); if (!nostore) *(v2u*)pp = ov; }
        }
    }
#undef AT_LOAD
    __syncthreads();
}


constexpr int ML_PQ = 528, ML_PK2 = 576, ML_PS = 144, ML_PV = 80;
typedef short v4i16_t __attribute__((ext_vector_type(4)));
typedef __bf16 bf16x2_t __attribute__((ext_vector_type(2)));
__device__ __forceinline__ float dot2bf(unsigned a, unsigned b, float c) { return __builtin_amdgcn_fdot2_f32_bf16(__builtin_bit_cast(bf16x2_t, a), __builtin_bit_cast(bf16x2_t, b), c, false); }
__device__ __forceinline__ s16x4 lds_tr(const LAS unsigned char* p) { return __builtin_bit_cast(s16x4, __builtin_amdgcn_ds_read_tr16_b64_v4i16((LAS v4i16_t*)p)); }
constexpr int ML_TBL = 1536;
#define ML_GATES_T(T) do { const float bc = scan_sum64(lf_n, lane), u = ig_n - bc, pm = scan_max64(u, lane); \
            const float g = fmaxf(m_run, pm), g63 = lane_bcast(g, 63), bl = lane_bcast(bc, 63); \
            (T)[lane] = u; (T)[64 + lane] = g; { const float wv_ = __expf(u - g63); (T)[128 + lane] = wv_; ((LAS unsigned short*)((T) + 336))[lane] = (unsigned short)(pg8::cvt_pk_bf16(wv_, 0.f) & 0xffffu); } (T)[192 + lane] = __expf(m_run - g); (T)[256 + lane] = __expf(-(bc + g)); if (lane == 0) (T)[320] = __expf(m_run - g63); \
            m_run = bl + g63; } while (0)

constexpr int UP_K = 0, UP_V = UP_K + 2 * 64 * ML_PK2, UP_W = UP_V + 2 * 64 * ML_PK2, UP_WB = UP_W + 2048, UP_RED = UP_WB + 1024, UP_CW = UP_RED + 128, UP_END = UP_CW + 4096;
__device__ __forceinline__ void mlstm_usum_phase(Frame& F, const Args& a) {
    const bf16* MK = (const bf16*)(a.ws + WS_MK); bf16* KCO = (bf16*)(a.ws + WS_KC); const bf16* VH = (const bf16*)(a.ws + WS_MV);
    const float* IG = (const float*)(a.ws + WS_IG); const float* LF = (const float*)(a.ws + WS_LF);
    bf16* UK = (bf16*)(a.ws + WS_Q); float* UN = (float*)(a.ws + WS_UN); float* ST = (float*)(a.ws + WS_UST);
    LAS unsigned char* L = F.lds;
    const int w = F.wave;
    for (int uid = F.vcu; uid < BATCH * MH * 8; uid += F.G) {
        int t__ = F.tid; asm volatile("" : "+v"(t__)); const int tid = t__, lane = tid & 63, l31 = lane & 31, hi = lane >> 5;
        const int bh = uid >> 3, j = uid & 7, b = bh >> 2, h = bh & 3;
        const size_t rowb = (size_t)b * SEQ + (size_t)j * 512; const int colh = h * 256;
        v4u rk[7], rv[4];
#define UP_LOAD(c) do { int t_ = F.tid; asm volatile("" : "+v"(t_)); const int ss = t_ >> 3, cq = t_ & 7, c8 = t_ & 31, rg = t_ >> 5; (void)ss; (void)cq; (void)c8; (void)rg; unsigned o_ = (unsigned)((((c) * 64 + 4 * rg) * 1024 + colh + 8 * c8) * 2); asm volatile("" : "+v"(o_)); const char* k_ = (const char*)(MK + rowb * 1024) + o_; \
            _Pragma("unroll") for (int r = 0; r < 7; ++r) { rk[r] = (v4u){0u, 0u, 0u, 0u}; if (r >= 3 || j > 0 || (c) > 0 || rg > 0) rk[r] = *(const v4u*)(k_ + (r - 3) * 2048); } \
            unsigned ov_ = (unsigned)((((c) * 64 + ss) * 1024 + colh + 8 * cq) * 2); asm volatile("" : "+v"(ov_)); const char* v_ = (const char*)(VH + rowb * 1024) + ov_; \
            _Pragma("unroll") for (int i = 0; i < 4; ++i) rv[i] = *(const v4u*)(v_ + 128 * i); } while (0)
#define UP_LOADK(c) do { int t_ = F.tid; asm volatile("" : "+v"(t_)); const int c8 = t_ & 31, rg = t_ >> 5; unsigned o_ = (unsigned)((((c) * 64 + 4 * rg) * 1024 + colh + 8 * c8) * 2); asm volatile("" : "+v"(o_)); const char* k_ = (const char*)(MK + rowb * 1024) + o_; \
            _Pragma("unroll") for (int r = 0; r < 7; ++r) { rk[r] = (v4u){0u, 0u, 0u, 0u}; if (r >= 3 || j > 0 || (c) > 0 || rg > 0) rk[r] = *(const v4u*)(k_ + (r - 3) * 2048); } } while (0)
#define UP_SILU16(v) ((v) * pg8::sigmoidf_(v) * 0.0625f)
#define UP_CONV(kc) do { int t_ = F.tid; asm volatile("" : "+v"(t_)); const int c8 = t_ & 31; \
            _Pragma("unroll") for (int hf = 0; hf < 2; ++hf) {                  \
                f32x4 wt[4], sm[4]; \
                _Pragma("unroll") for (int t = 0; t < 4; ++t) { wt[t] = *(const LAS f32x4*)(L + UP_CW + (t * 256 + 8 * c8 + 4 * hf) * 4); sm[t] = (f32x4){0.f, 0.f, 0.f, 0.f}; } \
                _Pragma("unroll") for (int row = 0; row < 7; ++row) { const unsigned xa = hf ? rk[row].z : rk[row].x, xb = hf ? rk[row].w : rk[row].y; \
                    const f32x4 xv = (f32x4){pg8::bf_lo(xa), pg8::bf_hi(xa), pg8::bf_lo(xb), pg8::bf_hi(xb)}; \
                    _Pragma("unroll") for (int t = 0; t < 4; ++t) { const int r = row - t; if (r >= 0 && r < 4) sm[r] += wt[t] * xv; } } \
                _Pragma("unroll") for (int r = 0; r < 4; ++r) { const unsigned pa = pg8::cvt_pk_bf16(UP_SILU16(sm[r][0]), UP_SILU16(sm[r][1])), pb = pg8::cvt_pk_bf16(UP_SILU16(sm[r][2]), UP_SILU16(sm[r][3])); \
                    if (hf) { kc[r].z = pa; kc[r].w = pb; } else { kc[r].x = pa; kc[r].y = pb; } } \
                __builtin_amdgcn_sched_barrier(0); } } while (0)
#define UP_KOUT(kc, c) do { int t_ = F.tid; asm volatile("" : "+v"(t_)); const int ss = t_ >> 3, cq = t_ & 7, c8 = t_ & 31, rg = t_ >> 5; (void)ss; (void)cq; (void)c8; (void)rg; unsigned o_ = (unsigned)((((c) * 64 + 4 * rg) * 1024 + colh + 8 * c8) * 2); asm volatile("" : "+v"(o_)); char* k_ = (char*)(KCO + rowb * 1024) + o_; \
            _Pragma("unroll") for (int r = 0; r < 4; ++r) *(v4u*)(k_ + r * 2048) = kc[r]; } while (0)
        __syncthreads();
        { ((LAS float*)(L + UP_CW))[tid] = a.conv_k[(tid >> 8) * 1024 + colh + (tid & 255)]; ((LAS float*)(L + UP_CW))[tid + 512] = a.conv_k[((tid >> 8) + 2) * 1024 + colh + (tid & 255)]; }
        if (j == 7) {
            __syncthreads();
#pragma unroll 1
            for (int c = 0; c < 8; ++c) { UP_LOADK(c); v4u kc[4]; UP_CONV(kc); UP_KOUT(kc, c); }
            continue;
        }
#define UP_STAGE(bu, c) do { v4u kc[4]; UP_CONV(kc); UP_KOUT(kc, c); int t_ = F.tid; asm volatile("" : "+v"(t_)); const int ss = t_ >> 3, cq = t_ & 7, c8 = t_ & 31, rg = t_ >> 5; (void)ss; (void)cq; (void)c8; (void)rg; \
            _Pragma("unroll") for (int r = 0; r < 4; ++r) *(LAS v4u*)(L + UP_K + (bu) * 64 * ML_PK2 + (4 * rg + r) * ML_PK2 + 16 * c8) = kc[r]; \
            const float ws_ = ((const LAS float*)(L + UP_W))[(c) * 64 + ss]; \
            _Pragma("unroll") for (int i = 0; i < 4; ++i) { v4u x; \
                x.x = pg8::cvt_pk_bf16(pg8::bf_lo(rv[i].x) * ws_, pg8::bf_hi(rv[i].x) * ws_); x.y = pg8::cvt_pk_bf16(pg8::bf_lo(rv[i].y) * ws_, pg8::bf_hi(rv[i].y) * ws_); \
                x.z = pg8::cvt_pk_bf16(pg8::bf_lo(rv[i].z) * ws_, pg8::bf_hi(rv[i].z) * ws_); x.w = pg8::cvt_pk_bf16(pg8::bf_lo(rv[i].w) * ws_, pg8::bf_hi(rv[i].w) * ws_); \
                *(LAS v4u*)(L + UP_V + (bu) * 64 * ML_PK2 + ss * ML_PK2 + 16 * (cq + 8 * i)) = x; } } while (0)
        UP_LOAD(0);
        {
            const float lfv = LF[(size_t)bh * SEQ + j * 512 + tid], igv = IG[(size_t)bh * SEQ + j * 512 + tid];
            const float bc = scan_sum64(lfv, lane), tot = lane_bcast(bc, 63);
            LAS float* RED = (LAS float*)(L + UP_RED);
            if (lane == 0) RED[w] = tot;
            __syncthreads();
            float later = 0.f, gtot = 0.f;
#pragma unroll
            for (int c = 0; c < 8; ++c) { const float tc = RED[c]; gtot += tc; later += (c > w) ? tc : 0.f; }
            const float ls = (tot - bc) + later + igv;
            float mx = ls; mx = fmaxf(mx, dppf_id<0x111>(mx, -__builtin_inff())); mx = fmaxf(mx, dppf_id<0x112>(mx, -__builtin_inff())); mx = fmaxf(mx, dppf_id<0x114>(mx, -__builtin_inff())); mx = fmaxf(mx, dppf_id<0x118>(mx, -__builtin_inff()));
            const float wmax = fmaxf(fmaxf(lane_bcast(mx, 15), lane_bcast(mx, 31)), fmaxf(lane_bcast(mx, 47), lane_bcast(mx, 63)));
            if (lane == 0) RED[8 + w] = wmax;
            __syncthreads();
            float mp = RED[8];
#pragma unroll
            for (int c = 1; c < 8; ++c) mp = fmaxf(mp, RED[8 + c]);
            const float wv = __expf(ls - mp);
            ((LAS float*)(L + UP_W))[tid] = wv; ((LAS unsigned short*)(L + UP_WB))[tid] = (unsigned short)(pg8::cvt_pk_bf16(wv, 0.f) & 0xffffu);
            if (tid == 0) { ST[(bh * 8 + j) * 2] = gtot; ST[(bh * 8 + j) * 2 + 1] = mp; }
        }
        __syncthreads();
        UP_STAGE(0, 0); UP_LOAD(1);
        __syncthreads();
        f32x16 acc[8];
#pragma unroll
        for (int i = 0; i < 8; ++i) acc[i] = f32x16{};
        float nacc = 0.f;
#pragma unroll 1
        for (int c = 0; c < 8; ++c) {
            const int bu = c & 1;
            { int ln__ = F.lane; asm volatile("" : "+v"(ln__)); const int lane = ln__, hi = lane >> 5;
            float nsum = 0.f;
#pragma unroll
            for (int kk = 0; kk < 4; ++kk) {
                const LAS unsigned char* vp = L + UP_V + bu * 64 * ML_PK2 + (16 * kk + 8 * hi + ((lane & 15) >> 2)) * ML_PK2 + (32 * w + 16 * ((lane >> 4) & 1) + 4 * (lane & 3)) * 2;
                const s16x4 va = lds_tr(vp), vb = lds_tr(vp + 4 * ML_PK2); const bf16x8 vf = (bf16x8){va[0], va[1], va[2], va[3], vb[0], vb[1], vb[2], vb[3]};
#pragma unroll
                for (int i = 0; i < 8; ++i) { const LAS unsigned char* kp = L + UP_K + bu * 64 * ML_PK2 + (16 * kk + 8 * hi + ((lane & 15) >> 2)) * ML_PK2 + (32 * i + 16 * ((lane >> 4) & 1) + 4 * (lane & 3)) * 2;
                    const s16x4 ka = lds_tr(kp), kb = lds_tr(kp + 4 * ML_PK2); const bf16x8 kf = (bf16x8){ka[0], ka[1], ka[2], ka[3], kb[0], kb[1], kb[2], kb[3]};
                    acc[i] = __builtin_amdgcn_mfma_f32_32x32x16_bf16(kf, vf, acc[i], 0, 0, 0); }
                { const LAS unsigned char* kp = L + UP_K + bu * 64 * ML_PK2 + (16 * kk + 8 * hi + ((lane & 15) >> 2)) * ML_PK2 + (32 * w + 16 * ((lane >> 4) & 1) + 4 * (lane & 3)) * 2;
                    const s16x4 ka = lds_tr(kp), kb = lds_tr(kp + 4 * ML_PK2); const v4u kw = __builtin_bit_cast(v4u, (bf16x8){ka[0], ka[1], ka[2], ka[3], kb[0], kb[1], kb[2], kb[3]}), wq = *(const LAS v4u*)((const LAS unsigned short*)(L + UP_WB) + c * 64 + 16 * kk + 8 * hi);
                    nsum = dot2bf(kw.x, wq.x, nsum); nsum = dot2bf(kw.y, wq.y, nsum); nsum = dot2bf(kw.z, wq.z, nsum); nsum = dot2bf(kw.w, wq.w, nsum); } }
            nacc += xor32_sum(nsum); }
            if (c + 1 < 8) { UP_STAGE(bu ^ 1, c + 1); if (c + 2 < 8) UP_LOAD(c + 2); }
            __syncthreads();
        }
#undef UP_LOAD
#undef UP_LOADK
#undef UP_CONV
#undef UP_SILU16
#undef UP_KOUT
#undef UP_STAGE
        { bf16* up = UK + ((size_t)(bh * 8 + j) * 256 + 32 * w + l31) * 256 + 4 * hi;
#pragma unroll
            for (int i = 0; i < 8; ++i)
#pragma unroll
                for (int g = 0; g < 4; ++g) { v2u x; x.x = pg8::cvt_pk_bf16(acc[i][4 * g + 0], acc[i][4 * g + 1]); x.y = pg8::cvt_pk_bf16(acc[i][4 * g + 2], acc[i][4 * g + 3]); *(v2u*)(up + 32 * i + 8 * g) = x; }
            if (hi == 0) UN[(size_t)(bh * 8 + j) * 256 + 32 * w + l31] = nacc; }
    }
}

__device__ __forceinline__ void mlstm_combine_phase(Frame& F, const Args& a) {
    const bf16* UK = (const bf16*)(a.ws + WS_Q); const float* UN = (const float*)(a.ws + WS_UN); const float* ST = (const float*)(a.ws + WS_UST);
    bf16* CK = (bf16*)(a.ws + WS_Q) + (size_t)32 * 8 * 65536; float* NCK = (float*)(a.ws + WS_NCK); float* MCK = (float*)(a.ws + WS_MCK);
    for (int blk = F.vcu; blk < 32 * 8; blk += F.G) {
        const int bh = blk >> 3, part = blk & 7;
        float ca[7], cb[7], m = 0.f;
#pragma unroll
        for (int j = 0; j < 7; ++j) { const float G = ST[(bh * 8 + j) * 2], mp = ST[(bh * 8 + j) * 2 + 1], mn = fmaxf(G + m, mp); ca[j] = __expf(G + m - mn); cb[j] = __expf(mp - mn); m = mn;
            if (part == 0 && F.tid == 0) MCK[bh * 8 + j + 1] = mn; }
#pragma unroll
        for (int q = 0; q < 2; ++q) { const size_t piece = (size_t)part * 1024 + q * 512 + F.tid;
            float c[8] = {0.f, 0.f, 0.f, 0.f, 0.f, 0.f, 0.f, 0.f};
            v4u uu[7];
#pragma unroll
            for (int j = 0; j < 7; ++j) uu[j] = *(const v4u*)(UK + ((size_t)(bh * 8 + j) * 65536) + piece * 8);
#pragma unroll
            for (int j = 0; j < 7; ++j) { const v4u u = uu[j];
                c[0] = ca[j] * c[0] + cb[j] * pg8::bf_lo(u.x); c[1] = ca[j] * c[1] + cb[j] * pg8::bf_hi(u.x); c[2] = ca[j] * c[2] + cb[j] * pg8::bf_lo(u.y); c[3] = ca[j] * c[3] + cb[j] * pg8::bf_hi(u.y);
                c[4] = ca[j] * c[4] + cb[j] * pg8::bf_lo(u.z); c[5] = ca[j] * c[5] + cb[j] * pg8::bf_hi(u.z); c[6] = ca[j] * c[6] + cb[j] * pg8::bf_lo(u.w); c[7] = ca[j] * c[7] + cb[j] * pg8::bf_hi(u.w);
                v4u o; o.x = pg8::cvt_pk_bf16(c[0], c[1]); o.y = pg8::cvt_pk_bf16(c[2], c[3]); o.z = pg8::cvt_pk_bf16(c[4], c[5]); o.w = pg8::cvt_pk_bf16(c[6], c[7]);
                *(v4u*)(CK + ((size_t)(bh * 8 + j + 1) * 65536) + piece * 8) = o; } }
        if (part == 0 && F.tid < 256) { float nn = 0.f;
#pragma unroll
            for (int j = 0; j < 7; ++j) { nn = ca[j] * nn + cb[j] * UN[(size_t)(bh * 8 + j) * 256 + F.tid]; NCK[(size_t)(bh * 8 + j + 1) * 256 + F.tid] = nn; } }
    }
}

#define ML_LANES() int ln__ = F.lane, td__ = F.tid; asm volatile("" : "+v"(ln__), "+v"(td__)); const int lane = ln__, tid = td__, l15 = lane & 15, kq = lane >> 4, l31 = lane & 31, hi = lane >> 5, ss = tid >> 3, cq = tid & 7; (void)l15; (void)kq; (void)l31; (void)hi; (void)ss; (void)cq
constexpr int OU_QS = 0, OU_KS = OU_QS + 64 * ML_PQ, OU_VS = OU_KS + 64 * 512,
               OU_ST = OU_VS + 64 * ML_PK2, OU_NV = OU_ST + 64 * ML_PS, OU_GT = OU_NV + 1024, OU_RS = OU_GT + 2 * ML_TBL, OU_HT = OU_RS + 2 * 1024, OU_CW = OU_HT + 64 * ML_PQ, OU_END = OU_CW + 4096;
static_assert(OU_END <= LDSCTL_OFF && UP_END <= LDSCTL_OFF, "mLSTM LDS maps");
__device__ __forceinline__ void mlstm_out_phase(Frame& F, const Args& a, const int nostore = 0) {
    const bf16* MQ = (const bf16*)(a.ws + WS_MQ); const bf16* KC = (const bf16*)(a.ws + WS_KC); bf16* VH = (bf16*)(a.ws + WS_MV); const bf16* OG = (const bf16*)(a.ws + WS_OG);
    const float* IG = (const float*)(a.ws + WS_IG); const float* LF = (const float*)(a.ws + WS_LF);
    const bf16* CK = (const bf16*)(a.ws + WS_Q) + (size_t)32 * 8 * 65536; const float* NCK = (const float*)(a.ws + WS_NCK); const float* MCK = (const float*)(a.ws + WS_MCK);
    LAS unsigned char* L = F.lds;
    const int w = F.wave, ti = w >> 1, sh = (w ^ (w >> 2)) & 1;
    for (int uid = F.vcu; uid < BATCH * MH * 8; uid += F.G) {
        int t__ = F.tid; asm volatile("" : "+v"(t__)); const int tid = t__, lane = tid & 63, l15 = lane & 15, kq = lane >> 4, l31 = lane & 31, hi = lane >> 5; (void)l15; (void)kq;
        const int bh = uid >> 3, j = uid & 7, b = bh >> 2, h = bh & 3;
        const size_t rowb = (size_t)b * SEQ + (size_t)j * 512; const int colh = h * 256;
        const float* ig = IG + (size_t)bh * SEQ + j * 512; const float* lf = LF + (size_t)bh * SEQ + j * 512;
        const int ss = tid >> 3, cq = tid & 7;
        float m_run = (j > 0) ? MCK[bh * 8 + j] : 0.f, lf_n = 0.f, ig_n = 0.f;
        __syncthreads();
        unsigned Cp[8][8];
        { const bf16* ck = CK + ((size_t)(bh * 8 + j) * 256 + 32 * w + l31) * 256 + 4 * hi;
#pragma unroll
            for (int i = 0; i < 8; ++i)
#pragma unroll
                for (int g = 0; g < 4; ++g) { v2u x = (v2u){0u, 0u}; if (j > 0) x = *(const v2u*)(ck + 32 * i + 8 * g); Cp[i][2 * g] = x.x; Cp[i][2 * g + 1] = x.y; } }
        if (tid < 256) ((LAS float*)(L + OU_NV))[tid] = (j > 0) ? NCK[(size_t)(bh * 8 + j) * 256 + tid] : 0.f;
        if (tid < 512) ((LAS float*)(L + OU_RS))[tid] = 0.f;
#define OU_GLOAD(cc) do { if (w == 0) { lf_n = lf[(cc) * 64 + lane]; ig_n = ig[(cc) * 64 + lane]; } } while (0)
        v4u rq[7], rqc[4], rk[4], rv[4];
#define OU_LOAD(cc) do { int tl_ = F.tid; asm volatile("" : "+v"(tl_)); unsigned oq_ = (unsigned)((((cc) * 64 + 4 * (tl_ >> 5)) * 1024 + colh + 8 * (tl_ & 31)) * 2); asm volatile("" : "+v"(oq_)); const char* q_ = (const char*)(MQ + rowb * 1024) + oq_; \
            _Pragma("unroll") for (int r = 0; r < 7; ++r) { rq[r] = (v4u){0u, 0u, 0u, 0u}; if (r >= 3 || j > 0 || (cc) > 0 || (tl_ >> 5) > 0) rq[r] = *(const v4u*)(q_ + (r - 3) * 2048); } \
            unsigned o_ = (unsigned)((((cc) * 64 + (tl_ >> 3)) * 1024 + colh + 8 * (tl_ & 7)) * 2); asm volatile("" : "+v"(o_));     \
            const char* k_ = (const char*)(KC + rowb * 1024) + o_; const char* v_ = (const char*)(VH + rowb * 1024) + o_; \
            _Pragma("unroll") for (int i = 0; i < 4; ++i) { rk[i] = *(const v4u*)(k_ + 128 * i); rv[i] = *(const v4u*)(v_ + 128 * i); } } while (0)
#define OU_SILU(v) ((v) * pg8::sigmoidf_(v))
#define OU_QCONV() do { int t_ = F.tid; asm volatile("" : "+v"(t_)); const int c8_ = t_ & 31; \
            _Pragma("unroll") for (int hf = 0; hf < 2; ++hf) { f32x4 wt[4], sm[4]; \
                _Pragma("unroll") for (int t = 0; t < 4; ++t) { wt[t] = *(const LAS f32x4*)(L + OU_CW + (t * 256 + 8 * c8_ + 4 * hf) * 4); sm[t] = (f32x4){0.f, 0.f, 0.f, 0.f}; } \
                _Pragma("unroll") for (int row = 0; row < 7; ++row) { const unsigned xa = hf ? rq[row].z : rq[row].x, xb = hf ? rq[row].w : rq[row].y; \
                    const f32x4 xv = (f32x4){pg8::bf_lo(xa), pg8::bf_hi(xa), pg8::bf_lo(xb), pg8::bf_hi(xb)}; \
                    _Pragma("unroll") for (int t = 0; t < 4; ++t) { const int r = row - t; if (r >= 0 && r < 4) sm[r] += wt[t] * xv; } } \
                _Pragma("unroll") for (int r = 0; r < 4; ++r) { const unsigned pa = pg8::cvt_pk_bf16(OU_SILU(sm[r][0]), OU_SILU(sm[r][1])), pb = pg8::cvt_pk_bf16(OU_SILU(sm[r][2]), OU_SILU(sm[r][3])); \
                    if (hf) { rqc[r].z = pa; rqc[r].w = pb; } else { rqc[r].x = pa; rqc[r].y = pb; } } \
                __builtin_amdgcn_sched_barrier(0); } } while (0)
#define OU_STAGE() do { int ts_ = F.tid; asm volatile("" : "+v"(ts_)); const int ss_ = ts_ >> 3, cq_ = ts_ & 7, rg_ = ts_ >> 5, c8_ = ts_ & 31; \
            _Pragma("unroll") for (int r = 0; r < 4; ++r) *(LAS v4u*)(L + OU_QS + (4 * rg_ + r) * ML_PQ + 16 * c8_) = rqc[r]; \
            _Pragma("unroll") for (int i = 0; i < 4; ++i) { *(LAS v4u*)(L + OU_KS + ss_ * 512 + 16 * ((((cq_ + 8 * i) >> 2) ^ (ss_ & 3)) << 2 | ((cq_ + 8 * i) & 3))) = rk[i]; *(LAS v4u*)(L + OU_VS + ss_ * ML_PK2 + 16 * (cq_ + 8 * i)) = rv[i]; } } while (0)
        { ((LAS float*)(L + OU_CW))[tid] = a.conv_q[(tid >> 8) * 1024 + colh + (tid & 255)]; ((LAS float*)(L + OU_CW))[tid + 512] = a.conv_q[((tid >> 8) + 2) * 1024 + colh + (tid & 255)]; }
        OU_GLOAD(0); if (w == 0) { LAS float* T0 = (LAS float*)(L + OU_GT); ML_GATES_T(T0); } OU_GLOAD(1);
        OU_LOAD(0);
        __syncthreads();
        OU_QCONV(); OU_STAGE();
        __syncthreads();
#pragma unroll 1
        for (int cc = 0; cc < 8; ++cc) {
            const int tb = cc & 1; const LAS float* T = (const LAS float*)(L + OU_GT + tb * ML_TBL); LAS float* RS = (LAS float*)(L + OU_RS + tb * 1024);
            if (cc + 1 < 8) OU_LOAD(cc + 1);
            if (w == 0 && cc + 1 < 8) { LAS float* T1 = (LAS float*)(L + OU_GT + (tb ^ 1) * ML_TBL); ML_GATES_T(T1); if (cc + 2 < 8) OU_GLOAD(cc + 2); }
            {
                ML_LANES();
                f32x4 aS0 = {0.f, 0.f, 0.f, 0.f}, aS1 = aS0; float qn = 0.f;
#pragma unroll 2
                for (int kk = 0; kk < 8; ++kk) {
                    const bf16x8 qf = *(const LAS bf16x8*)(L + OU_QS + (16 * ti + l15) * ML_PQ + (32 * kk + 8 * kq) * 2);
                    const bf16x8 k0 = *(const LAS bf16x8*)(L + OU_KS + (32 * sh + l15) * 512 + ((kk ^ (l15 & 3)) << 6) + kq * 16);
                    const bf16x8 k1 = *(const LAS bf16x8*)(L + OU_KS + (32 * sh + 16 + l15) * 512 + ((kk ^ (l15 & 3)) << 6) + kq * 16);
                    aS0 = __builtin_amdgcn_mfma_f32_16x16x32_bf16(qf, k0, aS0, 0, 0, 0);
                    aS1 = __builtin_amdgcn_mfma_f32_16x16x32_bf16(qf, k1, aS1, 0, 0, 0);
                    if (sh == 0) { const f32x4 n0 = *(const LAS f32x4*)(L + OU_NV + (32 * kk + 8 * kq) * 4), n1 = *(const LAS f32x4*)(L + OU_NV + (32 * kk + 8 * kq + 4) * 4);
                        const v4u qw = __builtin_bit_cast(v4u, qf);
                        qn += pg8::bf_lo(qw.x) * n0[0] + pg8::bf_hi(qw.x) * n0[1] + pg8::bf_lo(qw.y) * n0[2] + pg8::bf_hi(qw.y) * n0[3] + pg8::bf_lo(qw.z) * n1[0] + pg8::bf_hi(qw.z) * n1[1] + pg8::bf_lo(qw.w) * n1[2] + pg8::bf_hi(qw.w) * n1[3]; }
                }
                if (sh == 0) { qn = xor32_sum(xor16_sum(qn)); if (kq == 0) RS[64 + 16 * ti + l15] = qn; }
                const float us0 = T[32 * sh + l15], us1 = T[32 * sh + 16 + l15];
                float rs[4];
#pragma unroll
                for (int r = 0; r < 4; ++r) { const int t = 16 * ti + 4 * kq + r; const float gt = T[64 + t];
                    const int s0 = 32 * sh + l15, s1 = s0 + 16;
                    const float d0 = (s0 <= t) ? aS0[r] * __expf(us0 - gt) : 0.f, d1 = (s1 <= t) ? aS1[r] * __expf(us1 - gt) : 0.f;
                    const unsigned pk = pg8::cvt_pk_bf16(d0, d1);
                    *(LAS unsigned short*)(L + OU_ST + t * ML_PS + s0 * 2) = (unsigned short)(pk & 0xffffu); *(LAS unsigned short*)(L + OU_ST + t * ML_PS + s1 * 2) = (unsigned short)(pk >> 16);
                    rs[r] = pg8::bf_lo(pk) + pg8::bf_hi(pk); }
#pragma unroll
                for (int r = 0; r < 4; ++r) { const float v = row16_sum(rs[r]); if (l15 == 0) atomicAdd((float*)(RS + 16 * ti + 4 * kq + r), v); }
            }
            if (cc + 1 < 8) OU_QCONV();
            __syncthreads();
            v4u ogr[4];
            { unsigned o_ = (unsigned)(((cc * 64 + (F.tid >> 5)) * 1024 + colh + 8 * (F.tid & 31)) * 2); asm volatile("" : "+v"(o_)); const char* g_ = (const char*)(OG + rowb * 1024) + o_;
#pragma unroll
                for (int i = 0; i < 4; ++i) ogr[i] = *(const v4u*)(g_ + (size_t)i * 16 * 2048); }
            { ML_LANES();
#pragma unroll 1
            for (int tt = 0; tt < 2; ++tt) {
                f32x16 aH = {}, aI = {};
#pragma unroll
                for (int kk = 0; kk < 4; ++kk) {
                    const int srow = 16 * kk + 8 * hi + ((lane & 15) >> 2);
                    const LAS unsigned char* vp = L + OU_VS + srow * ML_PK2 + (32 * w + 16 * ((lane >> 4) & 1) + 4 * (lane & 3)) * 2;
                    const s16x4 va = lds_tr(vp), vb = lds_tr(vp + 4 * ML_PK2);
                    const bf16x8 vfk = (bf16x8){va[0], va[1], va[2], va[3], vb[0], vb[1], vb[2], vb[3]};
                    const bf16x8 sf = *(const LAS bf16x8*)(L + OU_ST + (32 * tt + l31) * ML_PS + (16 * kk + 8 * hi) * 2);
                    aH = __builtin_amdgcn_mfma_f32_32x32x16_bf16(sf, vfk, aH, 0, 0, 0);
                }
#pragma unroll
                for (int i = 0; i < 8; ++i)
#pragma unroll
                    for (int s = 0; s < 2; ++s) { const v4u cw = (v4u){Cp[i][4 * s + 0], Cp[i][4 * s + 1], Cp[i][4 * s + 2], Cp[i][4 * s + 3]};
                        const bf16x8 cb = __builtin_bit_cast(bf16x8, cw);
                        const LAS unsigned char* qp = L + OU_QS + (32 * tt + l31) * ML_PQ + (32 * i + 16 * s + 4 * hi) * 2;
                        const s16x4 q0 = *(const LAS s16x4*)qp, q1 = *(const LAS s16x4*)(qp + 16);
                        const bf16x8 qf = (bf16x8){q0[0], q0[1], q0[2], q0[3], q1[0], q1[1], q1[2], q1[3]};
                        aI = __builtin_amdgcn_mfma_f32_32x32x16_bf16(qf, cb, aI, 0, 0, 0); }
#pragma unroll
                for (int g = 0; g < 4; ++g) { const int t0 = 32 * tt + 8 * g + 4 * hi;
                    const f32x4 wi = *(const LAS f32x4*)(T + 192 + t0), cl = *(const LAS f32x4*)(T + 256 + t0), rsum = *(const LAS f32x4*)(RS + t0), qnv = *(const LAS f32x4*)(RS + 64 + t0);
#pragma unroll
                    for (int e = 0; e < 4; ++e) { const float num = aH[4 * g + e] + wi[e] * aI[4 * g + e], den = rsum[e] + wi[e] * qnv[e];
                        const float hv = num * __builtin_amdgcn_rcpf(fmaxf(fabsf(den), cl[e]));
                        *(LAS unsigned short*)(L + OU_HT + (t0 + e) * ML_PQ + (32 * w + l31) * 2) = (unsigned short)(pg8::cvt_pk_bf16(hv, 0.f) & 0xffffu); } }
            }
            float nnew = 0.f;
            if (cc < 7) {
                const float decay = T[320];
                bf16x8 vw[4];
#pragma unroll
                for (int kk = 0; kk < 4; ++kk) { const f32x4 w0 = *(const LAS f32x4*)(T + 128 + 16 * kk + 8 * hi), w1 = *(const LAS f32x4*)(T + 128 + 16 * kk + 8 * hi + 4);
                    const LAS unsigned char* vp = L + OU_VS + (16 * kk + 8 * hi + ((lane & 15) >> 2)) * ML_PK2 + (32 * w + 16 * ((lane >> 4) & 1) + 4 * (lane & 3)) * 2; const s16x4 va = lds_tr(vp), vb = lds_tr(vp + 4 * ML_PK2);
                    const v4u x = __builtin_bit_cast(v4u, (bf16x8){va[0], va[1], va[2], va[3], vb[0], vb[1], vb[2], vb[3]}); v4u y;
                    y.x = pg8::cvt_pk_bf16(pg8::bf_lo(x.x) * w0[0], pg8::bf_hi(x.x) * w0[1]); y.y = pg8::cvt_pk_bf16(pg8::bf_lo(x.y) * w0[2], pg8::bf_hi(x.y) * w0[3]);
                    y.z = pg8::cvt_pk_bf16(pg8::bf_lo(x.z) * w1[0], pg8::bf_hi(x.z) * w1[1]); y.w = pg8::cvt_pk_bf16(pg8::bf_lo(x.w) * w1[2], pg8::bf_hi(x.w) * w1[3]); vw[kk] = __builtin_bit_cast(bf16x8, y); }
                float nsum = 0.f;
                const LAS unsigned char* kbase[4];
#pragma unroll
                for (int bq = 0; bq < 4; ++bq) kbase[bq] = L + OU_KS + (8 * hi + ((lane & 15) >> 2)) * 512 + ((bq ^ ((lane & 15) >> 2)) << 6) + (16 * ((lane >> 4) & 1) + 4 * (lane & 3)) * 2;
#pragma unroll
                for (int i = 0; i < 8; ++i) {
                    f32x16 ct;
#pragma unroll
                    for (int q = 0; q < 8; ++q) { ct[2 * q] = pg8::bf_lo(Cp[i][q]) * decay; ct[2 * q + 1] = pg8::bf_hi(Cp[i][q]) * decay; }
#pragma unroll
                    for (int kk = 0; kk < 4; ++kk) {
                        const int srow = 16 * kk + 8 * hi + ((lane & 15) >> 2);
                        const LAS unsigned char* kp = kbase[i & 3] + (16 * kk) * 512 + 256 * (i >> 2);
                        const s16x4 ka = lds_tr(kp), kb = lds_tr(kp + 4 * 512);
                        const bf16x8 kf = (bf16x8){ka[0], ka[1], ka[2], ka[3], kb[0], kb[1], kb[2], kb[3]};
                        ct = __builtin_amdgcn_mfma_f32_32x32x16_bf16(kf, vw[kk], ct, 0, 0, 0);
                        if (i == w) { const f32x4 w0 = *(const LAS f32x4*)(T + 128 + 16 * kk + 8 * hi), w1 = *(const LAS f32x4*)(T + 128 + 16 * kk + 8 * hi + 4); const v4u kw = __builtin_bit_cast(v4u, kf);
                            nsum += pg8::bf_lo(kw.x) * w0[0] + pg8::bf_hi(kw.x) * w0[1] + pg8::bf_lo(kw.y) * w0[2] + pg8::bf_hi(kw.y) * w0[3] + pg8::bf_lo(kw.z) * w1[0] + pg8::bf_hi(kw.z) * w1[1] + pg8::bf_lo(kw.w) * w1[2] + pg8::bf_hi(kw.w) * w1[3]; }
                    }
#pragma unroll
                    for (int q = 0; q < 8; ++q) Cp[i][q] = pg8::cvt_pk_bf16(ct[2 * q], ct[2 * q + 1]);
                }
                nsum = xor32_sum(nsum);
                nnew = decay * ((const LAS float*)(L + OU_NV))[32 * w + l31] + nsum;
            }
            __syncthreads();
            if (hi == 0) ((LAS float*)(L + OU_NV))[32 * w + l31] = nnew;
            }
            { ML_LANES();
#pragma unroll
            for (int i = 0; i < 4; ++i) { const int id = tid + 512 * i, t = id >> 5, c8 = id & 31;
                const v4u hx = *(const LAS v4u*)(L + OU_HT + t * ML_PQ + c8 * 16);
                float s2 = (pg8::bf_lo(hx.x) * pg8::bf_lo(hx.x) + pg8::bf_hi(hx.x) * pg8::bf_hi(hx.x)) + (pg8::bf_lo(hx.y) * pg8::bf_lo(hx.y) + pg8::bf_hi(hx.y) * pg8::bf_hi(hx.y))
                         + (pg8::bf_lo(hx.z) * pg8::bf_lo(hx.z) + pg8::bf_hi(hx.z) * pg8::bf_hi(hx.z)) + (pg8::bf_lo(hx.w) * pg8::bf_lo(hx.w) + pg8::bf_hi(hx.w) * pg8::bf_hi(hx.w));
                s2 = xor16_sum(row16_sum(s2));
                const float rsq = __builtin_amdgcn_rsqf(s2 * (1.f / 256.f) + EPS);
                const size_t o = (rowb + (size_t)cc * 64 + t) * 1024 + colh + c8 * 8;
                const v4u g = ogr[i]; const f32x4 m0 = *(const f32x4*)(a.m_norm_w + colh + c8 * 8) * rsq, m1 = *(const f32x4*)(a.m_norm_w + colh + c8 * 8 + 4) * rsq; v4u ov;
                ov.x = pg8::cvt_pk_bf16(pg8::bf_lo(hx.x) * m0[0] * pg8::bf_lo(g.x), pg8::bf_hi(hx.x) * m0[1] * pg8::bf_hi(g.x)); ov.y = pg8::cvt_pk_bf16(pg8::bf_lo(hx.y) * m0[2] * pg8::bf_lo(g.y), pg8::bf_hi(hx.y) * m0[3] * pg8::bf_hi(g.y));
                ov.z = pg8::cvt_pk_bf16(pg8::bf_lo(hx.z) * m1[0] * pg8::bf_lo(g.z), pg8::bf_hi(hx.z) * m1[1] * pg8::bf_hi(g.z)); ov.w = pg8::cvt_pk_bf16(pg8::bf_lo(hx.w) * m1[2] * pg8::bf_lo(g.w), pg8::bf_hi(hx.w) * m1[3] * pg8::bf_hi(g.w));
                asm volatile("" :: "v"(ov.x), "v"(ov.y), "v"(ov.z), "v"(ov.w)); if (!nostore) *(v4u*)(VH + o) = ov; }
            if (tid < 256) ((LAS float*)(L + OU_RS + (tb ^ 1) * 1024))[tid] = 0.f;
            if (cc + 1 < 8) OU_STAGE();
            }
            __syncthreads();
        }
#undef OU_GLOAD
#undef OU_LOAD
#undef OU_STAGE
#undef OU_QCONV
#undef OU_SILU
    }
}
#undef ML_GATES_T

constexpr int N_PHASES = 8;
#ifndef PROBE
#define PROBE 0
#endif
__global__ void __launch_bounds__(NWAVES * 64, 2) skel_fwd(Args args) {
    extern __shared__ __attribute__((aligned(16))) unsigned char lds[];
    Frame F;
    F.lds = (LAS unsigned char*)lds;
    F.MISC = (volatile LAS unsigned*)(F.lds + MISC_OFF);
    F.tid = threadIdx.x; F.lane = F.tid & 63; F.wave = __builtin_amdgcn_readfirstlane(F.tid >> 6);
    F.G = gridDim.x; { const int bx = blockIdx.x; F.vcu = (F.G % 8 == 0) ? (bx % 8) * (F.G / 8) + bx / 8 : bx; }
    unsigned char* ws = args.ws;
    F.ctl = (gu32*)(ws + WS_CTL);
    for (int u = F.tid; u < (LDS_BYTES - LDSCTL_OFF) / 4; u += NWAVES * 64) ((LAS unsigned*)(F.lds + LDSCTL_OFF))[u] = 0u;
    __syncthreads();
    const int lo = args.ph_lo, hi = args.ph_hi;
    XcdBarrier bar; bar.bar = (unsigned*)(F.ctl + CW_BAR); bar.x = 0; bar.st = nullptr;
    if (hi - lo > 1) bar = xcd_barrier_post((unsigned*)(F.ctl + CW_BAR), F.MISC + 8);
#define IN(k) (lo <= (k) && (k) < hi)
#define BOTH(k) (IN(k) && IN((k) + 1))
#define GRID_BAR() xcd_barrier(bar)
    bf16* XN = (bf16*)(ws + WS_XN); bf16* QB = (bf16*)(ws + WS_Q); bf16* KB = (bf16*)(ws + WS_K); bf16* VB = (bf16*)(ws + WS_V); bf16* AZ = (bf16*)(ws + WS_AZ);
    bf16* MQ = (bf16*)(ws + WS_MQ); bf16* MK = (bf16*)(ws + WS_MK); bf16* MV = (bf16*)(ws + WS_MV); bf16* OG = (bf16*)(ws + WS_OG);
    bf16* GA = (bf16*)args.out; bf16* GM = (bf16*)args.out + (size_t)M * D;

    if (IN(0)) { p0_prologue(F, args); if (BOTH(0)) GRID_BAR(); }
    if (IN(1)) { p1_norm(F, args); if (PROBE == 1) p1_norm(F, args); __syncthreads(); weight_copies(F, args); if (BOTH(1)) GRID_BAR(); }
    if (IN(2)) {
        pg8::Gemm g{XN, (const bf16*)(ws + WS_WIN), D, D / 64};
        pg8::StaticOrder S; S.init(M, NPROJ, F.G, (int)blockIdx.x);
        pg8::EpiProj E{QB, KB, VB, AZ, MQ, MK, MV, OG, GA, GM, args.pos};
        pg8::gemm_phase<pg8::EpiProj, pg8::StaticOrder, true>(F.lds + RING_OFF, g, S, E);
        if (PROBE == 2) pg8::gemm_phase<pg8::EpiProj, pg8::StaticOrder, true>(F.lds + RING_OFF, g, S, E);
        if (BOTH(2)) GRID_BAR();
    }
    if (IN(3)) { attn_phase(F, args); if (PROBE == 3) attn_phase(F, args, args.pad); if (BOTH(3)) GRID_BAR(); }
    if (IN(4)) { mlstm_usum_phase(F, args); if (PROBE == 4) mlstm_usum_phase(F, args); GRID_BAR(); mlstm_combine_phase(F, args); if (BOTH(4)) GRID_BAR(); }
    if (IN(5)) { mlstm_out_phase(F, args); if (PROBE == 5) mlstm_out_phase(F, args, args.pad); if (BOTH(5)) GRID_BAR(); }
    if (IN(6)) {
        pg8::Gemm g{AZ, (const bf16*)(ws + WS_WATT), D, 2 * D / 64};
        static_assert(WS_MV - WS_AZ == (size_t)pg8::EpiMerge::DELTA_A && WS_WM - WS_WATT == (size_t)pg8::EpiMerge::DELTA_B, "segment deltas");
        pg8::StaticOrder S; S.init(M, D, F.G, (int)blockIdx.x);
        pg8::EpiMerge E{GA, GM, XN};
        pg8::gemm_phase<pg8::EpiMerge, pg8::StaticOrder, true>(F.lds + RING_OFF, g, S, E);
        if (PROBE == 6) pg8::gemm_phase<pg8::EpiMerge, pg8::StaticOrder, true>(F.lds + RING_OFF, g, S, E);
        if (BOTH(6)) GRID_BAR();
    }
    if (IN(7)) {
        pg8::Gemm g{XN, (const bf16*)(ws + WS_WOUT), D, D / 64};
        pg8::StaticOrder S; S.init(M, D, F.G, (int)blockIdx.x);
        struct BarCall { XcdBarrier b; __device__ __forceinline__ void operator()() const { xcd_barrier(b); } };
        pg8::EpiOutNorm<BarCall> E{args.x, (const float*)(ws + WS_MOD), args.b_ada, args.fnorm_w, args.out, (float*)(ws + WS_PART), BarCall{bar}};
        pg8::gemm_phase<pg8::EpiOutNorm<BarCall>, pg8::StaticOrder, true>(F.lds + RING_OFF, g, S, E);
    }
#undef IN
#undef BOTH
#undef GRID_BAR
}

extern "C" void kernel_launch(void* const* d_in, const int* in_sizes, int n_in, void* d_out, int out_size, void* d_ws, size_t ws_size, hipStream_t stream) {
    static int grid = 0;
    if (grid == 0) {
        if (n_in != 16 || in_sizes[0] != M * D || out_size != M * D || ws_size < WS_END) { fprintf(stderr, "kernel_launch: unexpected shapes (n_in %d, in0 %d, out %d, ws %zu); nothing launched\n", n_in, n_in > 0 ? in_sizes[0] : -1, out_size, ws_size); grid = -1; return; }
        int dev = 0, cus = 0, per_cu = 0;
        if (hipGetDevice(&dev) != hipSuccess || hipDeviceGetAttribute(&cus, hipDeviceAttributeMultiprocessorCount, dev) != hipSuccess) { grid = -1; return; }
        if (hipFuncSetAttribute((const void*)skel_fwd, hipFuncAttributeMaxDynamicSharedMemorySize, LDS_BYTES) != hipSuccess) { fprintf(stderr, "kernel_launch: hipFuncSetAttribute failed\n"); grid = -1; return; }
        if (hipOccupancyMaxActiveBlocksPerMultiprocessor(&per_cu, (const void*)skel_fwd, NWAVES * 64, LDS_BYTES) != hipSuccess || per_cu < 1) fprintf(stderr, "kernel_launch: note: occupancy query reports %d\n", per_cu);
        (void)hipGetLastError();
        grid = cus;
    }
    if (grid < 0) return;
    if (hipMemsetAsync((char*)d_ws + WS_CTL, 0, CTL_ZERO_BYTES, stream) != hipSuccess) return;
    Args a{};
    a.x = (const float*)d_in[0]; a.c = (const float*)d_in[1]; a.pos = (const int*)d_in[2]; a.w_ada = (const float*)d_in[3]; a.b_ada = (const float*)d_in[4]; a.norm_w = (const float*)d_in[5];
    a.w_in = (const float*)d_in[6]; a.b_if = (const float*)d_in[7]; a.sinks = (const float*)d_in[8]; a.conv_q = (const float*)d_in[9]; a.conv_k = (const float*)d_in[10]; a.m_norm_w = (const float*)d_in[11];
    a.w_att = (const float*)d_in[12]; a.w_m = (const float*)d_in[13]; a.w_out = (const float*)d_in[14]; a.fnorm_w = (const float*)d_in[15];
    a.out = (float*)d_out; a.ws = (unsigned char*)d_ws; a.pad = PROBE ? 1 : 0;
    unsigned char* ws = (unsigned char*)d_ws;
    auto run = [&](int lo, int hi, int li) { a.ph_lo = lo; a.ph_hi = hi; a.li = li; hipLaunchKernelGGL(skel_fwd, dim3(grid), dim3(NWAVES * 64), LDS_BYTES, stream, a); };
    run(0, N_PHASES, 0);
}
```

```cpp
#include <hip/hip_runtime.h>
#include <cstdio>
#include <cstdint>
template <int CTRL> __device__ __forceinline__ float dppf(float v) { return __builtin_bit_cast(float, __builtin_amdgcn_update_dpp(0, __builtin_bit_cast(int, v), CTRL, 0xf, 0xf, true)); }
template <int CTRL> __device__ __forceinline__ float dppf_id(float v, float ident) { return __builtin_bit_cast(float, __builtin_amdgcn_update_dpp(__builtin_bit_cast(int, ident), __builtin_bit_cast(int, v), CTRL, 0xf, 0xf, false)); }
__device__ __forceinline__ float row16_sum(float v) { v += dppf<0xB1>(v); v += dppf<0x4E>(v); v += dppf<0x141>(v); v += dppf<0x140>(v); return v; }
__device__ __forceinline__ float xor16_sum(float v) { float a = v, b = v; asm volatile("s_nop 1\n\tv_permlane16_swap_b32 %0, %1" : "+v"(a), "+v"(b)); return a + b; }
__device__ __forceinline__ float xor32_sum(float v) { float a = v, b = v; asm volatile("s_nop 1\n\tv_permlane32_swap_b32 %0, %1" : "+v"(a), "+v"(b)); return a + b; }
__device__ __forceinline__ float xor32_max(float v) { float a = v, b = v; asm volatile("s_nop 1\n\tv_permlane32_swap_b32 %0, %1" : "+v"(a), "+v"(b)); return fmaxf(a, b); }
__device__ __forceinline__ float wave_sum(float v) { return xor32_sum(xor16_sum(row16_sum(v))); }
__device__ __forceinline__ float lane_bcast(float v, int l) { return __builtin_bit_cast(float, __builtin_amdgcn_readlane(__builtin_bit_cast(int, v), l)); }
__device__ __forceinline__ float scan_sum64(float v, int lane) {
    v += dppf_id<0x111>(v, 0.f); v += dppf_id<0x112>(v, 0.f); v += dppf_id<0x114>(v, 0.f); v += dppf_id<0x118>(v, 0.f);
    const float t0 = lane_bcast(v, 15), t1 = lane_bcast(v, 31), t2 = lane_bcast(v, 47); const int row = lane >> 4;
    return v + (row >= 1 ? t0 : 0.f) + (row >= 2 ? t1 : 0.f) + (row >= 3 ? t2 : 0.f); }
__device__ __forceinline__ float scan_max64(float v, int lane) {
    const float NI = -__builtin_inff();
    v = fmaxf(v, dppf_id<0x111>(v, NI)); v = fmaxf(v, dppf_id<0x112>(v, NI)); v = fmaxf(v, dppf_id<0x114>(v, NI)); v = fmaxf(v, dppf_id<0x118>(v, NI));
    const float t0 = lane_bcast(v, 15), t1 = lane_bcast(v, 31), t2 = lane_bcast(v, 47); const int row = lane >> 4;
    return fmaxf(v, fmaxf(row >= 1 ? t0 : NI, fmaxf(row >= 2 ? t1 : NI, row >= 3 ? t2 : NI))); }
namespace pg8 {
#define PG8_LAS __attribute__((address_space(3)))
typedef unsigned short bf16_t;
typedef short bf16x8 __attribute__((ext_vector_type(8)));
typedef float f32x4 __attribute__((ext_vector_type(4)));
typedef unsigned u32x4 __attribute__((ext_vector_type(4)));
typedef unsigned u32x2 __attribute__((ext_vector_type(2)));
constexpr int BM = 256, BK = 64, HALF = 128, HTB = HALF * BK * 2  , STAGE_BYTES = 8 * HTB, NXCD = 8, WGM = 4;

__host__ __device__ __forceinline__ int lds_byte(int r, int c) { const int st = (r >> 4) * 2 + (c >> 5), rr = r & 15, cc = c & 31, ob = rr * 64 + cc * 2; return st * 1024 + (ob ^ (((ob >> 9) & 1) << 5)); }
__host__ __device__ __forceinline__ void stage_rc(int b, int& R, int& C) { const int st = b / 1024, sb = b % 1024, swz = sb ^ (((sb >> 9) & 1) << 5); R = (st >> 1) * 16 + swz / 64; C = (st & 1) * 32 + (swz % 64) / 2; }
__host__ __device__ __forceinline__ int perm32(int rho) { const int n = rho >> 4, i = rho & 15; return 8 * (i >> 2) + 4 * n + (i & 3); }

struct Unit { int pm, pn, seg; };
struct Gemm { const bf16_t* A; const bf16_t* Bt; int K, nt; };

struct StaticOrder {
    int nM, nN, nwg, G, c;
    __host__ __device__ void init(int M, int N, int G_, int c_) { nM = M / BM; nN = N / BM; nwg = nM * nN; G = G_; c = c_; }
    __host__ __device__ bool next(int i, Unit& u) const {
        const long L = (long)i * G + c; if (L >= nwg) return false;
        int wgid = (int)L; { const int q = nwg / NXCD, r = nwg % NXCD, xcd = wgid % NXCD, off = wgid / NXCD; wgid = (xcd < r ? xcd * (q + 1) : r * (q + 1) + (xcd - r) * q) + off; }
        const int nig = WGM * nN, gid = wgid / nig, fm = gid * WGM, gsz = (nM - fm) < WGM ? (nM - fm) : WGM;
        u.pm = fm + ((wgid % nig) % gsz); u.pn = (wgid % nig) / gsz; u.seg = 0; return true;
    }
    __device__ __forceinline__ void a_ready(const Unit&) const {}
    __device__ __forceinline__ void done(const Unit&) const {}
};
__device__ __forceinline__ unsigned cvt_pk_bf16(float lo, float hi) { unsigned r; asm volatile("v_cvt_pk_bf16_f32 %0, %1, %2" : "=v"(r) : "v"(lo), "v"(hi)); return r; }
__device__ __forceinline__ float bf_lo(unsigned w) { return __builtin_bit_cast(float, w << 16); }
__device__ __forceinline__ float bf_hi(unsigned w) { return __builtin_bit_cast(float, w & 0xffff0000u); }
__device__ __forceinline__ float sigmoidf_(float x) { return __builtin_amdgcn_rcpf(1.0f + __builtin_amdgcn_exp2f(-1.4426950408889634f * x)); }
__device__ __forceinline__ float og_(float mo, float mz) { return mz * __builtin_amdgcn_rcpf((1.0f + __builtin_amdgcn_exp2f(-1.4426950408889634f * mo)) * (1.0f + __builtin_amdgcn_exp2f(-1.4426950408889634f * mz))); }
typedef f32x4 acc_t[2][2][4][2];

struct EpiProj {
    static constexpr bool PERM = true; static constexpr int NT1 = 1 << 20; static constexpr ptrdiff_t DELTA_A = 0, DELTA_B = 0, SEG_A = 0, SEG_B = 0;
    bf16_t *Q, *Kb, *Vb, *AZ, *MQ, *MK, *MV, *OG, *GA, *GM; const int* pos;
    __device__ __forceinline__ void mid(acc_t&, const Unit&, int, int, int, int) const {}
    __device__ __forceinline__ void operator()(acc_t& acc, const Unit& u, int wr, int wc, int fr, int fq) const {
        asm volatile("" : "+v"(fr), "+v"(fq));
        const int pn = u.pn, row0 = u.pm * BM + wr * 64 + fr, cl = wc * 32 + 8 * fq;
        if (pn < 5) {
            const int i0 = 16 * (wc & 1) + 4 * fq;
            float cf[4];
#pragma unroll
            for (int e = 0; e < 4; ++e) cf[e] = __builtin_amdgcn_exp2f(-(float)(i0 + e) * (13.287712379549449f / 32.0f)) * 0.15915494309189535f;
            const float sc = (pn < 4) ? 0.125f * 1.4426950408889634f : 1.0f;
            bf16_t* base = (pn < 4) ? Q + (size_t)pn * BM : Kb; const int ld = (pn < 4) ? 1024 : 256;
#pragma unroll
            for (int ai = 0; ai < 2; ++ai)
#pragma unroll
                for (int m = 0; m < 4; ++m) { const int row = row0 + ai * HALF + m * 16; const float p = (float)pos[row];
                    float cs[4], sn[4];
#pragma unroll
                    for (int e = 0; e < 4; ++e) { const float rev = __builtin_amdgcn_fractf(p * cf[e]); sn[e] = __builtin_amdgcn_sinf(rev) * sc; cs[e] = __builtin_amdgcn_cosf(rev) * sc; }
#pragma unroll
                    for (int bj = 0; bj < 2; ++bj) { const f32x4 v0 = acc[ai][bj][m][0], v1 = acc[ai][bj][m][1]; u32x4 w;
                        w.x = cvt_pk_bf16(v0[0] * cs[0] - v0[1] * sn[0], v0[1] * cs[0] + v0[0] * sn[0]);
                        w.y = cvt_pk_bf16(v0[2] * cs[1] - v0[3] * sn[1], v0[3] * cs[1] + v0[2] * sn[1]);
                        w.z = cvt_pk_bf16(v1[0] * cs[2] - v1[1] * sn[2], v1[1] * cs[2] + v1[0] * sn[2]);
                        w.w = cvt_pk_bf16(v1[2] * cs[3] - v1[3] * sn[3], v1[3] * cs[3] + v1[2] * sn[3]);
                        __builtin_nontemporal_store(w, (u32x4*)(base + (size_t)row * ld + bj * HALF + cl)); } }
        } else if (pn >= 22 && pn < 30) {
            bf16_t* base = OG + (size_t)(pn - 22) * 128 + (cl >> 1);
#pragma unroll
            for (int ai = 0; ai < 2; ++ai)
#pragma unroll
                for (int m = 0; m < 4; ++m) { const int row = row0 + ai * HALF + m * 16;
#pragma unroll
                    for (int bj = 0; bj < 2; ++bj) { const f32x4 v0 = acc[ai][bj][m][0], v1 = acc[ai][bj][m][1]; u32x2 w;
                        w.x = cvt_pk_bf16(og_(v0[0], v0[1]), og_(v0[2], v0[3]));
                        w.y = cvt_pk_bf16(og_(v1[0], v1[1]), og_(v1[2], v1[3]));
                        __builtin_nontemporal_store(w, (u32x2*)(base + (size_t)row * 1024 + bj * 64)); } }
        } else {
            int act; bf16_t* base; int ld = 1024;
            if (pn == 5) { act = 0; base = Vb; ld = 256; }
            else if (pn < 10) { act = 1; base = AZ + (size_t)(pn - 6) * BM; }
            else if (pn < 14) { act = 0; base = MQ + (size_t)(pn - 10) * BM; }
            else if (pn < 18) { act = 0; base = MK + (size_t)(pn - 14) * BM; }
            else if (pn < 22) { act = 0; base = MV + (size_t)(pn - 18) * BM; }
            else if (pn < 34) { act = 2; base = GA + (size_t)(pn - 30) * BM; }
            else { act = 2; base = GM + (size_t)(pn - 34) * BM; }
#pragma unroll
            for (int ai = 0; ai < 2; ++ai)
#pragma unroll
                for (int m = 0; m < 4; ++m) { const int row = row0 + ai * HALF + m * 16;
#pragma unroll
                    for (int bj = 0; bj < 2; ++bj) { f32x4 v0 = acc[ai][bj][m][0], v1 = acc[ai][bj][m][1];
                        if (act) {
#pragma unroll
                            for (int e = 0; e < 4; ++e) { const float s0 = sigmoidf_(v0[e]), s1 = sigmoidf_(v1[e]); v0[e] = (act == 1) ? v0[e] * s0 : s0; v1[e] = (act == 1) ? v1[e] * s1 : s1; } }
                        u32x4 w; w.x = cvt_pk_bf16(v0[0], v0[1]); w.y = cvt_pk_bf16(v0[2], v0[3]); w.z = cvt_pk_bf16(v1[0], v1[1]); w.w = cvt_pk_bf16(v1[2], v1[3]);
                        __builtin_nontemporal_store(w, (u32x4*)(base + (size_t)row * ld + bj * HALF + cl)); } }
        }
    }
};

struct EpiMerge {
    static constexpr bool PERM = true; static constexpr int NT1 = 16; static constexpr ptrdiff_t DELTA_A = (ptrdiff_t)192 << 20, DELTA_B = (ptrdiff_t)2 << 20, SEG_A = 0, SEG_B = 0;
    const bf16_t *GA, *GM; bf16_t* OUT;
    __device__ __forceinline__ void mid(acc_t& acc, const Unit& u, int wr, int wc, int fr, int fq) const {
        asm volatile("" : "+v"(fr), "+v"(fq));
        const int row0 = u.pm * BM + wr * 64 + fr, col0 = u.pn * BM + wc * 32 + 8 * fq;
#pragma unroll
        for (int ai = 0; ai < 2; ++ai)
#pragma unroll
            for (int m = 0; m < 4; ++m)
#pragma unroll
                for (int bj = 0; bj < 2; ++bj) { const size_t o = (size_t)(row0 + ai * HALF + m * 16) * 1024 + col0 + bj * HALF;
                    const u32x4 a = *(const u32x4*)(GA + o), b = *(const u32x4*)(GM + o);
                    f32x4 r0, r1;
                    r0[0] = bf_lo(a.x) * __builtin_amdgcn_rcpf(fmaxf(bf_lo(b.x), 1e-30f)); r0[1] = bf_hi(a.x) * __builtin_amdgcn_rcpf(fmaxf(bf_hi(b.x), 1e-30f));
                    r0[2] = bf_lo(a.y) * __builtin_amdgcn_rcpf(fmaxf(bf_lo(b.y), 1e-30f)); r0[3] = bf_hi(a.y) * __builtin_amdgcn_rcpf(fmaxf(bf_hi(b.y), 1e-30f));
                    r1[0] = bf_lo(a.z) * __builtin_amdgcn_rcpf(fmaxf(bf_lo(b.z), 1e-30f)); r1[1] = bf_hi(a.z) * __builtin_amdgcn_rcpf(fmaxf(bf_hi(b.z), 1e-30f));
                    r1[2] = bf_lo(a.w) * __builtin_amdgcn_rcpf(fmaxf(bf_lo(b.w), 1e-30f)); r1[3] = bf_hi(a.w) * __builtin_amdgcn_rcpf(fmaxf(bf_hi(b.w), 1e-30f));
                    acc[ai][bj][m][0] *= r0; acc[ai][bj][m][1] *= r1; if (m == 3 && bj == 1) asm volatile("" ::: "memory"); }
    }
    __device__ __forceinline__ void operator()(acc_t& acc, const Unit& u, int wr, int wc, int fr, int fq) const {
        asm volatile("" : "+v"(fr), "+v"(fq));
        const int row0 = u.pm * BM + wr * 64 + fr, col0 = u.pn * BM + wc * 32 + 8 * fq;
#pragma unroll
        for (int ai = 0; ai < 2; ++ai)
#pragma unroll
            for (int m = 0; m < 4; ++m)
#pragma unroll
                for (int bj = 0; bj < 2; ++bj) { const size_t o = (size_t)(row0 + ai * HALF + m * 16) * 1024 + col0 + bj * HALF;
                    const u32x4 b = *(const u32x4*)(GM + o); const f32x4 v0 = acc[ai][bj][m][0], v1 = acc[ai][bj][m][1]; u32x4 w;
                    w.x = cvt_pk_bf16(v0[0] * bf_lo(b.x), v0[1] * bf_hi(b.x)); w.y = cvt_pk_bf16(v0[2] * bf_lo(b.y), v0[3] * bf_hi(b.y));
                    w.z = cvt_pk_bf16(v1[0] * bf_lo(b.z), v1[1] * bf_hi(b.z)); w.w = cvt_pk_bf16(v1[2] * bf_lo(b.w), v1[3] * bf_hi(b.w));
                    *(u32x4*)(OUT + o) = w; if (m == 3 && bj == 1) asm volatile("" ::: "memory"); }
    }
};

template <class Bar> struct EpiOutNorm {
    static constexpr bool PERM = true; static constexpr int NT1 = 1 << 20; static constexpr ptrdiff_t DELTA_A = 0, DELTA_B = 0, SEG_A = 0, SEG_B = 0;
    const float* X; const float* modacc; const float* b_ada; const float* fw; float* OUT; float* part; Bar bar;
    __device__ __forceinline__ void mid(acc_t&, const Unit&, int, int, int, int) const {}
    __device__ __forceinline__ void operator()(acc_t& acc, const Unit& u, int wr, int wc, int fr, int fq) const {
        asm volatile("" : "+v"(fr), "+v"(fq));
        const int row0 = u.pm * BM + wr * 64 + fr, col0 = u.pn * BM + wc * 32 + 8 * fq, b = (u.pm * BM) >> 12;
        {
            f32x4 gt[2][2];
#pragma unroll
            for (int bj = 0; bj < 2; ++bj)
#pragma unroll
                for (int n = 0; n < 2; ++n) gt[bj][n] = *(const f32x4*)(modacc + b * 3072 + 2048 + col0 + bj * HALF + 4 * n) + *(const f32x4*)(b_ada + 2048 + col0 + bj * HALF + 4 * n);
#pragma unroll
            for (int ai = 0; ai < 2; ++ai)
#pragma unroll
                for (int m = 0; m < 4; ++m) { const int row = row0 + ai * HALF + m * 16; float ss = 0.f;
#pragma unroll
                    for (int bj = 0; bj < 2; ++bj)
#pragma unroll
                        for (int n = 0; n < 2; ++n) { const size_t o = (size_t)row * 1024 + col0 + bj * HALF + 4 * n;
                            const f32x4 xv = *(const f32x4*)(X + o); const f32x4 y = xv + gt[bj][n] * acc[ai][bj][m][n];
                            acc[ai][bj][m][n] = y; ss += (y[0] * y[0] + y[1] * y[1]) + (y[2] * y[2] + y[3] * y[3]); }
                    ss = xor32_sum(xor16_sum(ss));
                    if (fq == 0) part[(size_t)row * 16 + u.pn * 4 + wc] = ss; if (m & 1) asm volatile("" ::: "memory"); }
        }
        bar();
        asm volatile("" : "+v"(fr), "+v"(fq));
        {
            const int row0b = u.pm * BM + wr * 64 + fr, col0b = u.pn * BM + wc * 32 + 8 * fq;
            f32x4 fv[2][2];
#pragma unroll
            for (int bj = 0; bj < 2; ++bj)
#pragma unroll
                for (int n = 0; n < 2; ++n) fv[bj][n] = *(const f32x4*)(fw + col0b + bj * HALF + 4 * n);
#pragma unroll
            for (int ai = 0; ai < 2; ++ai)
#pragma unroll
                for (int m = 0; m < 4; ++m) { const int row = row0b + ai * HALF + m * 16; const f32x4* pp = (const f32x4*)(part + (size_t)row * 16);
                    const f32x4 p0 = pp[0], p1 = pp[1], p2 = pp[2], p3 = pp[3];
                    const float s = ((p0[0] + p0[1]) + (p0[2] + p0[3])) + ((p1[0] + p1[1]) + (p1[2] + p1[3])) + ((p2[0] + p2[1]) + (p2[2] + p2[3])) + ((p3[0] + p3[1]) + (p3[2] + p3[3]));
                    const float rstd = 1.0f / sqrtf(s * (1.f / 1024.f) + 1e-6f);
#pragma unroll
                    for (int bj = 0; bj < 2; ++bj)
#pragma unroll
                        for (int n = 0; n < 2; ++n) *(f32x4*)(OUT + (size_t)row * 1024 + col0b + bj * HALF + 4 * n) = acc[ai][bj][m][n] * rstd * fv[bj][n];
                    if (m == 3) asm volatile("" ::: "memory"); }
        }
    }
};

template <class Epi, class Sched, bool ALIGN_EPI = true>
__device__ __forceinline__ void gemm_phase(PG8_LAS unsigned char* lds, const Gemm g, const Sched& S, const Epi& E) {
    const int tid = threadIdx.x, wid = __builtin_amdgcn_readfirstlane(tid >> 6), lane = tid & 63, wr = wid >> 2, wc = wid & 3, fr = lane & 15, fq = lane >> 4;
    const int K = g.K, nt = g.nt; constexpr int nt1 = Epi::NT1;
    unsigned voffA[2], voffB[2];
#pragma unroll
    for (int i = 0; i < 2; ++i) { int R, C; stage_rc(tid * 16 + i * 8192, R, C); const int Rb = Epi::PERM ? ((R & ~31) + perm32(R & 31)) : R;
        voffA[i] = (unsigned)(R * K + C) * 2u; voffB[i] = (unsigned)(Rb * K + C) * 2u; }
    const size_t kstep = (size_t)(BK * 2);
    const size_t hstep = (size_t)HALF * K * 2;
    const size_t tstep = 2 * hstep;
    const unsigned ldsw = (unsigned)wid * 1024u;
    const int aoff = lds_byte(wr * 64 + fr, fq * 8), boff = lds_byte(wc * 32 + fr, fq * 8);
#define PG8_SA(b, h) (((b) * 2 + (h)) * HTB)
#define PG8_SB(b, h) ((4 + (b) * 2 + (h)) * HTB)
#define PG8_STAGE(bufoff, gbase, voff) do { _Pragma("unroll") for (int _i = 0; _i < 2; ++_i) \
        __builtin_amdgcn_global_load_lds((const unsigned*)((const char*)(gbase) + (voff)[_i]), (PG8_LAS unsigned*)(lds + (bufoff) + ldsw + _i * 8192), 16, 0, 0); } while (0)
#define PG8_LDA(dst, b, h) do { _Pragma("unroll") for (int m = 0; m < 4; ++m) _Pragma("unroll") for (int k = 0; k < 2; ++k) dst[m][k] = *(const PG8_LAS bf16x8*)(lds + PG8_SA(b, h) + aoff + m * 2048 + k * 1024); } while (0)
#define PG8_LDB(dst, b, h) do { _Pragma("unroll") for (int n = 0; n < 2; ++n) _Pragma("unroll") for (int k = 0; k < 2; ++k) dst[n][k] = *(const PG8_LAS bf16x8*)(lds + PG8_SB(b, h) + boff + n * 2048 + k * 1024); } while (0)
#define PG8_MMA(ai, bj, At, Bt) do { __builtin_amdgcn_s_setprio(1); _Pragma("unroll") for (int m = 0; m < 4; ++m) _Pragma("unroll") for (int n = 0; n < 2; ++n) _Pragma("unroll") for (int k = 0; k < 2; ++k) \
        acc[ai][bj][m][n] = __builtin_amdgcn_mfma_f32_16x16x32_bf16(Bt[n][k], At[m][k], acc[ai][bj][m][n], 0, 0, 0); __builtin_amdgcn_s_setprio(0); } while (0)
#define PG8_WAIT_V(n) asm volatile("s_waitcnt vmcnt(" #n ")" ::: "memory")
#define PG8_WAIT_L(n) asm volatile("s_waitcnt lgkmcnt(" #n ")" ::: "memory")
#define PG8_BAR __builtin_amdgcn_s_barrier()
#define PG8_SCHED __builtin_amdgcn_sched_barrier(0)
#define PG8_TP(c0, dl, tt) ((c0) + ((nt1 >= (1 << 20) || (tt) < nt1) ? (ptrdiff_t)(tt) * (ptrdiff_t)kstep : (ptrdiff_t)(dl) + (ptrdiff_t)((tt) - nt1) * (ptrdiff_t)kstep))
    Unit cur, nxt; int ui = 0;
    if (!S.next(0, cur)) return;
    f32x4 acc[2][2][4][2];
#pragma unroll
    for (int a = 0; a < 2; ++a)
#pragma unroll
        for (int b = 0; b < 2; ++b)
#pragma unroll
            for (int m = 0; m < 4; ++m)
#pragma unroll
                for (int n = 0; n < 2; ++n) acc[a][b][m][n] = (f32x4){0.f, 0.f, 0.f, 0.f};
    bf16x8 At[4][2], B0[2][2], B1[2][2];
    const char* cA = (const char*)g.A + (size_t)cur.pm * tstep + (ptrdiff_t)cur.seg * Epi::SEG_A; const char* cB = (const char*)g.Bt + (size_t)cur.pn * tstep + (ptrdiff_t)cur.seg * Epi::SEG_B;
    S.a_ready(cur);
    {
        PG8_STAGE(PG8_SB(0, 0), cB, voffB); PG8_STAGE(PG8_SB(0, 1), cB + hstep, voffB); PG8_STAGE(PG8_SA(0, 0), cA, voffA); PG8_STAGE(PG8_SA(0, 1), cA + hstep, voffA);
        if (wr == 1) PG8_BAR;
        PG8_WAIT_V(2); PG8_BAR;
        PG8_STAGE(PG8_SB(1, 0), cB + kstep, voffB); PG8_STAGE(PG8_SA(1, 0), cA + kstep, voffA); PG8_STAGE(PG8_SB(1, 1), cB + hstep + kstep, voffB);
        PG8_WAIT_V(6); PG8_BAR;
    }
    for (;;) {
        const bool has_next = S.next(ui + 1, nxt);
        const char* nA = has_next ? (const char*)g.A + (size_t)nxt.pm * tstep + (ptrdiff_t)nxt.seg * Epi::SEG_A : cA; const char* nB = has_next ? (const char*)g.Bt + (size_t)nxt.pn * tstep + (ptrdiff_t)nxt.seg * Epi::SEG_B : cB;
        for (int t = 0; t < nt; t += 2) {
            const bool last = (t == nt - 2);
            if constexpr (nt1 < (1 << 20)) { if (t == nt1) E.mid(acc, cur, wr, wc, fr, fq); }
            const char* a1 = PG8_TP(cA, Epi::DELTA_A, t + 1);
            const char* a2 = last ? nA : PG8_TP(cA, Epi::DELTA_A, t + 2); const char* b2 = last ? nB : PG8_TP(cB, Epi::DELTA_B, t + 2);
            const char* a3 = last ? nA + kstep : PG8_TP(cA, Epi::DELTA_A, t + 3); const char* b3 = last ? nB + kstep : PG8_TP(cB, Epi::DELTA_B, t + 3);
            if (last && has_next) S.a_ready(nxt);
            PG8_LDB(B0, 0, 0); PG8_LDB(B1, 0, 1); PG8_SCHED; PG8_LDA(At, 0, 0); PG8_STAGE(PG8_SA(1, 1), a1 + hstep, voffA);
            PG8_WAIT_V(8); PG8_WAIT_L(0); PG8_BAR; PG8_MMA(0, 0, At, B0); PG8_MMA(0, 1, At, B1); PG8_BAR; PG8_SCHED;
            PG8_LDA(At, 0, 1); PG8_STAGE(PG8_SB(0, 0), b2, voffB); PG8_STAGE(PG8_SB(0, 1), b2 + hstep, voffB); PG8_STAGE(PG8_SA(0, 0), a2, voffA);
            PG8_WAIT_V(8); PG8_WAIT_L(0); PG8_BAR; PG8_MMA(1, 0, At, B0); PG8_MMA(1, 1, At, B1); PG8_BAR; PG8_SCHED;
            PG8_LDB(B0, 1, 0); PG8_LDB(B1, 1, 1); PG8_SCHED; PG8_LDA(At, 1, 0); PG8_STAGE(PG8_SA(0, 1), a2 + hstep, voffA);
            PG8_WAIT_V(8); PG8_WAIT_L(0); PG8_BAR; PG8_MMA(0, 0, At, B0); PG8_MMA(0, 1, At, B1); PG8_BAR; PG8_SCHED;
            PG8_LDA(At, 1, 1); PG8_STAGE(PG8_SB(1, 0), b3, voffB); PG8_STAGE(PG8_SB(1, 1), b3 + hstep, voffB); PG8_STAGE(PG8_SA(1, 0), a3, voffA);
            PG8_WAIT_V(8); PG8_WAIT_L(0); PG8_BAR; PG8_MMA(1, 0, At, B0); PG8_MMA(1, 1, At, B1); PG8_BAR; PG8_SCHED;
        }
        if constexpr (ALIGN_EPI) { if (wr == 0) PG8_BAR; }
        E(acc, cur, wr, wc, fr, fq); S.done(cur);
        if (!has_next) break;
#pragma unroll
        for (int a = 0; a < 2; ++a)
#pragma unroll
            for (int b = 0; b < 2; ++b)
#pragma unroll
                for (int m = 0; m < 4; ++m)
#pragma unroll
                    for (int n = 0; n < 2; ++n) acc[a][b][m][n] = (f32x4){0.f, 0.f, 0.f, 0.f};
        cur = nxt; cA = nA; cB = nB; ++ui;
        if constexpr (ALIGN_EPI) { if (wr == 1) PG8_BAR; }
    }
    PG8_WAIT_V(0);
    if constexpr (!ALIGN_EPI) { if (wr == 0) PG8_BAR; }
    PG8_BAR;
#undef PG8_SA
#undef PG8_SB
#undef PG8_STAGE
#undef PG8_LDA
#undef PG8_LDB
#undef PG8_MMA
#undef PG8_WAIT_V
#undef PG8_WAIT_L
#undef PG8_BAR
#undef PG8_SCHED
#undef PG8_TP
}
}

constexpr int BATCH = 8, SEQ = 4096, D = 1024, M = BATCH * SEQ;
constexpr int IN_WIDTH = 9736, NPROJ = 9728;
constexpr int COL_MI = 7680;
constexpr int AH = 16, AKV = 4, AHD = 64, WINDOW = 128;
constexpr int MH = 4, MHD = 256;
constexpr float EPS = 1e-6f;
constexpr int NWAVES = 8;

constexpr size_t MiB = 1u << 20;
constexpr size_t WS_CTL = 0, CTL_ZERO_BYTES = 1 * MiB;
constexpr size_t WS_MOD = 512 * 1024;
constexpr size_t WS_WIN = 1 * MiB;
constexpr size_t WS_NCK = 1 * MiB, WS_MCK = 2 * MiB, WS_UN = 3 * MiB, WS_UST = 4 * MiB;
constexpr size_t WS_PART = 10 * MiB;
constexpr size_t WS_WATT = 20 * MiB, WS_WM = 22 * MiB, WS_WOUT = 24 * MiB;
constexpr size_t WS_IG = 26 * MiB, WS_LF = WS_IG + 512 * 1024;
constexpr size_t WS_K = 27 * MiB, WS_V = 43 * MiB;
constexpr size_t WS_XN = 60 * MiB;
constexpr size_t WS_Q = 124 * MiB;
constexpr size_t WS_AZ = 188 * MiB;
constexpr size_t WS_MQ = 252 * MiB, WS_MK = 316 * MiB;
constexpr size_t WS_MV = 380 * MiB;
constexpr size_t WS_KC = WS_XN;
constexpr size_t WS_OG = 444 * MiB;
constexpr size_t WS_HALO = 508 * MiB;
constexpr size_t WS_END = 511 * MiB;
constexpr int CW_BAR = 4096;

constexpr int RING_OFF = 0, RING_BYTES = 131072;
constexpr int LDS_BYTES = 163840;
constexpr int LDSCTL_OFF = LDS_BYTES - 1024, MISC_OFF = LDSCTL_OFF + 320;

#define GAS __attribute__((address_space(1)))
#define LAS __attribute__((address_space(3)))
typedef unsigned short bf16;
typedef unsigned v4u __attribute__((ext_vector_type(4)));
typedef unsigned v2u __attribute__((ext_vector_type(2)));
typedef float f32x4 __attribute__((ext_vector_type(4)));
typedef short bf16x8 __attribute__((ext_vector_type(8)));
typedef GAS unsigned gu32;
#define RLX_AGENT __ATOMIC_RELAXED, __HIP_MEMORY_SCOPE_AGENT
#define LDS_WAIT() asm volatile("s_waitcnt lgkmcnt(0)" ::: "memory")
#define VM_WAIT() asm volatile("s_waitcnt vmcnt(0)" ::: "memory")
__device__ __forceinline__ unsigned f2bf(float f) { unsigned u = __builtin_bit_cast(unsigned, f); return (u + 0x7fffu + ((u >> 16) & 1u)) >> 16; }
__device__ __forceinline__ unsigned pk2(float lo, float hi) { return f2bf(lo) | (f2bf(hi) << 16); }
__device__ __forceinline__ float bf2f(bf16 v) { return __builtin_bit_cast(float, (unsigned)v << 16); }

#define XB_TMO      128
#define XB_XCNT(j)  (256  + 64 * (j))
#define XB_XSUB(j)  (1280 + 64 * (j))
#define XB_XGEN(j)  (2304 + 64 * (j))
#define XB_TOP      3328
#define XB_TOPGEN   3392
#define XCD_BAR_WORDS 3456
#define XB_SPIN_CAP (1u << 18)

__device__ __forceinline__ unsigned xb_ld(unsigned* p)              { return __hip_atomic_load(p, __ATOMIC_RELAXED, __HIP_MEMORY_SCOPE_AGENT); }
__device__ __forceinline__ unsigned xb_add(unsigned* p, unsigned v) { return __hip_atomic_fetch_add(p, v, __ATOMIC_RELAXED, __HIP_MEMORY_SCOPE_AGENT); }
__device__ __forceinline__ unsigned xb_xcc_id() { return (unsigned)__builtin_amdgcn_s_getreg((3 << 11) | 20) & 0xFu; }
#define XB_SPIN(cond, bar) do { unsigned _sp = 0; while (cond) { __builtin_amdgcn_s_sleep(1); \
    if ((++_sp & 255u) == 0u) { if (xb_ld(&(bar)[XB_TMO])) break; if (_sp > XB_SPIN_CAP) { atomicAdd(&(bar)[XB_TMO], 1u); break; } } } } while (0)

struct XcdBarrier {
    unsigned* bar; unsigned x;
    volatile LAS unsigned* st;
};
__device__ __forceinline__ XcdBarrier xcd_barrier_post(unsigned* bar, volatile LAS unsigned* st) {
    XcdBarrier b; b.bar = bar; b.x = xb_xcc_id(); b.st = st;
    if (threadIdx.x == 0) (void)xb_add(&bar[XB_XCNT(b.x)], 1u);
    return b;
}
__device__ __forceinline__ void xcd_barrier_complete(unsigned* bar, unsigned x, unsigned& nloc, unsigned& nx) {
    const unsigned G = gridDim.x * gridDim.y * gridDim.z;
    unsigned sum, cnt, mine, sp = 0u;
    for (;;) {
        sum = 0u; cnt = 0u; mine = 0u;
#pragma unroll
        for (unsigned j = 0; j < 16; ++j) { const unsigned c = xb_ld(&bar[XB_XCNT(j)]); sum += c; cnt += (c > 0u) ? 1u : 0u; mine = (j == x) ? c : mine; }
        if (sum == G) break;
        __builtin_amdgcn_s_sleep(1);
        if ((++sp & 255u) == 0u) { if (xb_ld(&bar[XB_TMO])) break; if (sp > XB_SPIN_CAP) { atomicAdd(&bar[XB_TMO], 1u); break; } }
    }
    nloc = mine > 0u ? mine : 1u; nx = cnt > 0u ? cnt : 1u;
}
__device__ __forceinline__ void xcd_barrier(const XcdBarrier& b) {
    asm volatile("s_waitcnt vmcnt(0)" ::: "memory");
    __syncthreads();
    if (threadIdx.x == 0) {
        unsigned* bar = b.bar;
        __builtin_amdgcn_s_waitcnt(0);
        unsigned nloc = b.st[0], nx = b.st[1];
        if (nloc == 0u) { xcd_barrier_complete(bar, b.x, nloc, nx); b.st[0] = nloc; b.st[1] = nx; }
        const unsigned old = xb_add(&bar[XB_XSUB(b.x)], 1u);
        const unsigned gen = old / nloc;
        if (old + 1u == (gen + 1u) * nloc) {
            __builtin_amdgcn_fence(__ATOMIC_RELEASE, "agent");
            asm volatile("s_waitcnt vmcnt(0)" ::: "memory");
            const unsigned og = xb_add(&bar[XB_TOP], 1u);
            const unsigned tg = og / nx;
            if (og + 1u == (tg + 1u) * nx) xb_add(&bar[XB_TOPGEN], 1u);
            else XB_SPIN(xb_ld(&bar[XB_TOPGEN]) == tg, bar);
            __builtin_amdgcn_fence(__ATOMIC_ACQUIRE, "agent");
            xb_add(&bar[XB_XGEN(b.x)], 1u);
            asm volatile("s_waitcnt vmcnt(0)" ::: "memory");
        } else {
            XB_SPIN(xb_ld(&bar[XB_XGEN(b.x)]) == gen, bar);
            __builtin_amdgcn_fence(__ATOMIC_ACQUIRE, "agent");
            asm volatile("s_waitcnt vmcnt(0)" ::: "memory");
        }
    }
    __syncthreads();
}

struct Frame {
    LAS unsigned char* lds;
    volatile LAS unsigned* MISC;
    gu32* ctl;
    int tid, lane, wave;
    int vcu, G;
};

__device__ __forceinline__ int win_src_col(int n) {
    if (n < 1280) { const int hb = n & ~63, j = n & 63; return hb + (j >> 1) + 32 * (j & 1); }
    if (n < 5632) return n;
    if (n < 7680) { const int idx = n - 5632; return ((idx & 1) ? 6656 : 5632) + (idx >> 1); }
    return n + 8;
}
template <bool MAP>
__device__ __forceinline__ void p0_transpose_item(const float* W, int K, int Nsrc, int ndst, bf16* WT, LAS float* scr, int item, int lane) {
    const int nblk = ndst / 32, kb = item / nblk, nb = item % nblk, k0 = 64 * kb, n0 = 32 * nb;
    const int sc = MAP ? win_src_col(n0 + (lane & 31)) : n0 + (lane & 31);
    float v[32];
#pragma unroll
    for (int i = 0; i < 32; ++i) v[i] = W[(size_t)(k0 + 2 * i + (lane >> 5)) * Nsrc + sc];
#pragma unroll
    for (int i = 0; i < 32; ++i) scr[(2 * i + (lane >> 5)) * 33 + (lane & 31)] = v[i];
    LDS_WAIT(); asm volatile("" ::: "memory");
    const int c = lane & 7;
#pragma unroll
    for (int j = 0; j < 4; ++j) { const int n = (lane >> 3) + 8 * j; const LAS float* s = scr + (8 * c) * 33 + n;
        v4u o; o.x = pk2(s[0 * 33], s[1 * 33]); o.y = pk2(s[2 * 33], s[3 * 33]); o.z = pk2(s[4 * 33], s[5 * 33]); o.w = pk2(s[6 * 33], s[7 * 33]);
        *(GAS v4u*)(WT + (size_t)(n0 + n) * K + k0 + 8 * c) = o; }
    LDS_WAIT(); asm volatile("" ::: "memory");
}

struct Args {
    const float* x; const float* c; const int* pos; const float* w_ada; const float* b_ada; const float* norm_w; const float* w_in; const float* b_if;
    const float* sinks; const float* conv_q; const float* conv_k; const float* m_norm_w; const float* w_att; const float* w_m; const float* w_out; const float* fnorm_w;
    float* out; unsigned char* ws; int ph_lo, ph_hi, li, pad;
};

__device__ __forceinline__ void p0_prologue(Frame& F, const Args& a) {
    LAS float* scr = (LAS float*)(F.lds + RING_OFF + F.wave * 16384);
    const int gw = F.vcu * NWAVES + F.wave, NGW = F.G * NWAVES;
    float* mod = (float*)(a.ws + WS_MOD);
    constexpr int I_ADA = 48 * 32;
    for (int r = gw; r < I_ADA; r += NGW) {
        const int cg = r >> 5, ks = r & 31, n = cg * 64 + F.lane, k0 = ks * 32;
#pragma unroll
        for (int j = 0; j < 4; ++j) { const int idx = F.lane + 64 * j, b = idx >> 5, kk = idx & 31; const float cv = a.c[b * D + k0 + kk]; scr[idx] = cv / (1.0f + __expf(-cv)); }
        LDS_WAIT(); asm volatile("" ::: "memory");
        float s[8] = {0.f, 0.f, 0.f, 0.f, 0.f, 0.f, 0.f, 0.f};
#pragma unroll 8
        for (int kk = 0; kk < 32; ++kk) { const float w = a.w_ada[(size_t)(k0 + kk) * 3072 + n];
#pragma unroll
            for (int b = 0; b < 8; ++b) s[b] += scr[b * 32 + kk] * w; }
#pragma unroll
        for (int b = 0; b < 8; ++b) atomicAdd(mod + b * 3072 + n, s[b]);
        LDS_WAIT(); asm volatile("" ::: "memory");
    }
}
__device__ __forceinline__ void weight_copies(Frame& F, const Args& a) {
    LAS float* scr = (LAS float*)(F.lds + RING_OFF + F.wave * 16384);
    const int gw = F.vcu * NWAVES + F.wave, NGW = F.G * NWAVES;
    bf16* WIN = (bf16*)(a.ws + WS_WIN); bf16* WATT = (bf16*)(a.ws + WS_WATT); bf16* WM = (bf16*)(a.ws + WS_WM); bf16* WOUT = (bf16*)(a.ws + WS_WOUT);
    constexpr int I_IN = (D / 64) * (NPROJ / 32), I_SQ = (D / 64) * (D / 32);
    constexpr int NITEMS = I_IN + 3 * I_SQ;
    for (int it = NGW - 1 - gw; it < NITEMS; it += NGW) {
        int r = it;
        if (r < I_IN) { p0_transpose_item<true>(a.w_in, D, IN_WIDTH, NPROJ, WIN, scr, r, F.lane); continue; } r -= I_IN;
        if (r < I_SQ) { p0_transpose_item<false>(a.w_att, D, D, D, WATT, scr, r, F.lane); continue; } r -= I_SQ;
        if (r < I_SQ) { p0_transpose_item<false>(a.w_m, D, D, D, WM, scr, r, F.lane); continue; } r -= I_SQ;
        p0_transpose_item<false>(a.w_out, D, D, D, WOUT, scr, r, F.lane);
    }
}

typedef float p1f2 __attribute__((ext_vector_type(2)));
__device__ __forceinline__ void p1_norm(Frame& F, const Args& a) {
    LAS float* wg = (LAS float*)(F.lds + RING_OFF);
    for (int k = F.tid; k < D; k += NWAVES * 64) { const f32x4* s = (const f32x4*)(a.w_in + (size_t)k * IN_WIDTH + COL_MI); const int j = k >> 8, ln = (k & 255) >> 2, e = k & 3;
        *(LAS f32x4*)(wg + (((j * 4 + e) * 2 + 0) * 64 + ln) * 4) = s[0]; *(LAS f32x4*)(wg + (((j * 4 + e) * 2 + 1) * 64 + ln) * 4) = s[1]; }
    const float* mod = (const float*)(a.ws + WS_MOD);
    LAS float* tca = wg + 8192; LAS float* tcc = tca + 8192;
    for (int i = F.tid; i < BATCH * 256; i += NWAVES * 64) { const int b = i >> 8, k = (i & 255) * 4;
        const f32x4 nw = *(const f32x4*)(a.norm_w + k);
        const f32x4 sh = *(const f32x4*)(mod + b * 3072 + k) + *(const f32x4*)(a.b_ada + k);
        const f32x4 sc = *(const f32x4*)(mod + b * 3072 + 1024 + k) + *(const f32x4*)(a.b_ada + 1024 + k);
        *(LAS f32x4*)(tca + b * 1024 + k) = nw * (sc + 1.0f); *(LAS f32x4*)(tcc + b * 1024 + k) = sh; }
    __syncthreads();
    bf16* XN = (bf16*)(a.ws + WS_XN); float* IG = (float*)(a.ws + WS_IG); float* LF = (float*)(a.ws + WS_LF);
    const int gw = F.vcu * NWAVES + F.wave, NGW = F.G * NWAVES;
    constexpr int GR = 2;
    {
        const int NG = M / GR;
        f32x4 vbuf[GR][4], vbuf2[GR][4];
#pragma unroll
        for (int q = 0; q < GR; ++q)
#pragma unroll
            for (int j = 0; j < 4; ++j) { vbuf[q][j] = (f32x4){0.f, 0.f, 0.f, 0.f}; vbuf2[q][j] = vbuf[q][j]; }
        if (gw < NG) {
#pragma unroll
            for (int q = 0; q < GR; ++q) { const GAS f32x4* xr = (const GAS f32x4*)(a.x + (size_t)(gw * GR + q) * D) + F.lane;
#pragma unroll
                for (int j = 0; j < 4; ++j) vbuf[q][j] = __builtin_nontemporal_load(xr + 64 * j); } }
        if (gw + NGW < NG) {
#pragma unroll
            for (int q = 0; q < GR; ++q) { const GAS f32x4* xr = (const GAS f32x4*)(a.x + (size_t)((gw + NGW) * GR + q) * D) + F.lane;
#pragma unroll
                for (int j = 0; j < 4; ++j) vbuf2[q][j] = __builtin_nontemporal_load(xr + 64 * j); } }
#pragma unroll 1
        for (int grp = gw; grp < NG; grp += NGW) {
            int rowg = grp * GR; asm volatile("" : "+s"(rowg));
            const int b = rowg >> 12;
            f32x4 vcur[GR][4];
#pragma unroll
            for (int q = 0; q < GR; ++q)
#pragma unroll
                for (int j = 0; j < 4; ++j) { vcur[q][j] = vbuf[q][j]; vbuf[q][j] = vbuf2[q][j]; }
            if (grp + 2 * NGW < NG) {
#pragma unroll
                for (int q = 0; q < GR; ++q) { const GAS f32x4* xr = (const GAS f32x4*)(a.x + (size_t)((grp + 2 * NGW) * GR + q) * D) + F.lane;
#pragma unroll
                    for (int j = 0; j < 4; ++j) vbuf2[q][j] = __builtin_nontemporal_load(xr + 64 * j); } }
            float rstd[GR];
#pragma unroll
            for (int q = 0; q < GR; ++q) { float s2 = 0.f;
#pragma unroll
                for (int j = 0; j < 4; ++j) { const f32x4 v = vcur[q][j]; s2 += (v.x * v.x + v.y * v.y) + (v.z * v.z + v.w * v.w); }
                rstd[q] = __builtin_amdgcn_rsqf(wave_sum(s2) * (1.f / D) + EPS); }
            p1f2 g[GR][4];
#pragma unroll
            for (int q = 0; q < GR; ++q)
#pragma unroll
                for (int i = 0; i < 4; ++i) g[q][i] = (p1f2){0.f, 0.f};
#pragma unroll
            for (int j = 0; j < 4; ++j) { f32x4 h[GR]; const f32x4 caj = *(const LAS f32x4*)(tca + b * 1024 + 256 * j + 4 * F.lane), ccj = *(const LAS f32x4*)(tcc + b * 1024 + 256 * j + 4 * F.lane);
#pragma unroll
                for (int q = 0; q < GR; ++q) { h[q] = vcur[q][j] * rstd[q] * caj + ccj;
                    v2u o; o.x = pg8::cvt_pk_bf16(h[q].x, h[q].y); o.y = pg8::cvt_pk_bf16(h[q].z, h[q].w); ((GAS v2u*)(XN + (size_t)(rowg + q) * D) + F.lane)[64 * j] = o; }
#pragma unroll
                for (int e = 0; e < 4; ++e) { const f32x4 w0 = *(const LAS f32x4*)(wg + (((j * 4 + e) * 2 + 0) * 64 + F.lane) * 4), w1 = *(const LAS f32x4*)(wg + (((j * 4 + e) * 2 + 1) * 64 + F.lane) * 4);
                    const p1f2 wa = {w0.x, w0.y}, wb = {w0.z, w0.w}, wc = {w1.x, w1.y}, wd = {w1.z, w1.w};
#pragma unroll
                    for (int q = 0; q < GR; ++q) { const float hv = h[q][e]; g[q][0] += hv * wa; g[q][1] += hv * wb; g[q][2] += hv * wc; g[q][3] += hv * wd; } } }
#pragma unroll
            for (int q = 0; q < GR; ++q) {
                const int row = rowg + q;
                float h4[4];
#pragma unroll
                for (int i = 0; i < 4; ++i) { float aa = g[q][i >> 1][i & 1], bb = g[q][2 + (i >> 1)][i & 1]; asm volatile("s_nop 1\n\tv_permlane32_swap_b32 %0, %1" : "+v"(aa), "+v"(bb)); h4[i] = aa + bb; }
                float u0, u1;
                { float aa = h4[0], bb = h4[2]; asm volatile("s_nop 1\n\tv_permlane16_swap_b32 %0, %1" : "+v"(aa), "+v"(bb)); u0 = aa + bb; }
                { float aa = h4[1], bb = h4[3]; asm volatile("s_nop 1\n\tv_permlane16_swap_b32 %0, %1" : "+v"(aa), "+v"(bb)); u1 = aa + bb; }
                u0 += dppf<0x128>(u0); u1 += dppf<0x128>(u1);
                float val = (F.lane & 8) ? u1 : u0;
                val += dppf<0x141>(val); val += dppf<0xB1>(val); val += dppf<0x4E>(val);
                const int gi = 4 * (F.lane >> 5) + 2 * ((F.lane >> 4) & 1) + ((F.lane >> 3) & 1);
                val += a.b_if[gi];
                if ((F.lane & 7) == 0) {
                    if (gi < 4) IG[((size_t)b * MH + gi) * SEQ + (row & (SEQ - 1))] = val;
                    else LF[((size_t)b * MH + (gi - 4)) * SEQ + (row & (SEQ - 1))] = fminf(val, 0.f) - __logf(1.0f + __expf(-fabsf(val))); }
            }
        }
    }
}


typedef float f32x16 __attribute__((ext_vector_type(16)));
typedef short s16x4 __attribute__((ext_vector_type(4)));
__device__ __forceinline__ int crow(int r, int hi) { return (r & 3) + 8 * (r >> 2) + 4 * hi; }
constexpr int ATT_VT_OFF = 32768, ATT_VT_PITCH = 520;
__device__ __forceinline__ void attn_phase(Frame& F, const Args& a, const int nostore = 0) {
    const bf16* Q = (const bf16*)(a.ws + WS_Q); const bf16* K = (const bf16*)(a.ws + WS_K); const bf16* V = (const bf16*)(a.ws + WS_V); bf16* AZ = (bf16*)(a.ws + WS_AZ);
    LAS unsigned char* Ks = F.lds; LAS unsigned char* Vt = F.lds + ATT_VT_OFF;
    const int tid = F.tid, lane = F.lane, w = F.wave, q32 = lane & 31, hi = lane >> 5;
    const int kp = tid >> 2, dq = tid & 3;
    v4u kreg[4], va0, va1, vb0, vb1;
#define AT_LOAD(uid_) do { int tid = F.tid; asm volatile("" : "+v"(tid)); const int kp = tid >> 2, dq = tid & 3; const int b_ = (uid_) >> 7, kvh_ = ((uid_) >> 5) & 3, qb_ = (uid_) & 31; const long f0_ = (long)b_ * SEQ + qb_ * 128 - 128; \
        _Pragma("unroll") for (int j = 0; j < 4; ++j) { const int idx = tid + 512 * j, key = idx >> 3, c = idx & 7; kreg[j] = (v4u){0u, 0u, 0u, 0u}; \
            if (qb_ > 0 || key >= 128) kreg[j] = *(const v4u*)(K + (f0_ + key) * 256 + kvh_ * 64 + c * 8); } \
        va0 = (v4u){0u, 0u, 0u, 0u}; va1 = va0; vb0 = va0; vb1 = va0; \
        if (qb_ > 0 || kp >= 64) { const bf16* p = V + (f0_ + 2 * kp) * 256 + kvh_ * 64 + dq * 16; va0 = *(const v4u*)p; va1 = *(const v4u*)(p + 8); vb0 = *(const v4u*)(p + 256); vb1 = *(const v4u*)(p + 264); } } while (0)
    const int uid0 = F.vcu;
    if (uid0 < BATCH * AKV * 32) AT_LOAD(uid0);
    for (int uid = uid0; uid < BATCH * AKV * 32; uid += F.G) {
        const int b = uid >> 7, kvh = (uid >> 5) & 3, qblk = uid & 31;
        const int head = kvh * 4 + (w >> 1);
        bf16x8 qf[2][4]; v2u zz[2][8];
#pragma unroll
        for (int sb = 0; sb < 2; ++sb) { const long qrow = (long)b * SEQ + qblk * 128 + (w & 1) * 64 + sb * 32 + q32;
#pragma unroll
            for (int s = 0; s < 4; ++s) qf[sb][s] = *(const bf16x8*)(Q + qrow * 1024 + head * 64 + 16 * s + 8 * hi);
#pragma unroll
            for (int i = 0; i < 8; ++i) zz[sb][i] = *(const v2u*)(AZ + qrow * 1024 + head * 64 + 4 * hi + (i >> 2) * 32 + 8 * (i & 3)); }
        __syncthreads();
#pragma unroll
        for (int j = 0; j < 4; ++j) { const int idx = tid + 512 * j, key = idx >> 3, c = idx & 7; *(LAS v4u*)(Ks + key * 128 + ((c ^ (key & 7)) << 4)) = kreg[j]; }
        { LAS unsigned char* dst = Vt + (16 * dq) * ATT_VT_PITCH + kp * 4;
#define VT_W(e, x, y) *(LAS unsigned*)(dst + (e) * ATT_VT_PITCH) = ((x) & 0xffffu) | ((y) << 16); *(LAS unsigned*)(dst + ((e) + 1) * ATT_VT_PITCH) = ((x) >> 16) | ((y) & 0xffff0000u)
            VT_W(0, va0.x, vb0.x); VT_W(2, va0.y, vb0.y); VT_W(4, va0.z, vb0.z); VT_W(6, va0.w, vb0.w); VT_W(8, va1.x, vb1.x); VT_W(10, va1.y, vb1.y); VT_W(12, va1.z, vb1.z); VT_W(14, va1.w, vb1.w);
#undef VT_W
        }
        __syncthreads();
        { const int nuid = uid + F.G; if (nuid < BATCH * AKV * 32) AT_LOAD(nuid); }
        const float sink2 = a.sinks[head] * 1.4426950408889634f;
#pragma unroll
        for (int sb = 0; sb < 2; ++sb) {
            const int r0 = (w & 1) * 64 + sb * 32, kt0 = r0 >> 5, rq = r0 + q32;
            const long qrow = (long)b * SEQ + qblk * 128 + rq;
            f32x16 p[5];
#pragma unroll
            for (int kt = 0; kt < 5; ++kt) { const int key = 32 * (kt0 + kt) + q32; f32x16 acc = {};
#pragma unroll
                for (int s = 0; s < 4; ++s) { const bf16x8 kf = *(const LAS bf16x8*)(Ks + key * 128 + (((2 * s + hi) ^ (key & 7)) << 4)); acc = __builtin_amdgcn_mfma_f32_32x32x16_bf16(kf, qf[sb][s], acc, 0, 0, 0); }
                p[kt] = acc; }
            float mx = sink2;
#pragma unroll
            for (int r = 0; r < 16; ++r) { p[0][r] = (crow(r, hi) > q32) ? p[0][r] : -INFINITY; p[4][r] = (crow(r, hi) <= q32) ? p[4][r] : -INFINITY; }
            if (qblk == 0) {
#pragma unroll
                for (int kt = 0; kt < 4; ++kt) if (kt0 + kt < 4) {
#pragma unroll
                    for (int r = 0; r < 16; ++r) p[kt][r] = -INFINITY; } }
#pragma unroll
            for (int kt = 0; kt < 5; ++kt)
#pragma unroll
                for (int r = 0; r < 16; ++r) mx = fmaxf(mx, p[kt][r]);
            mx = xor32_max(mx);
            float l = 0.f;
#pragma unroll
            for (int kt = 0; kt < 5; ++kt)
#pragma unroll
                for (int r = 0; r < 16; ++r) { const float e = __builtin_amdgcn_exp2f(p[kt][r] - mx); p[kt][r] = e; l += e; }
            l = xor32_sum(l) + __builtin_amdgcn_exp2f(sink2 - mx);
            f32x16 o[2] = {f32x16{}, f32x16{}};
#pragma unroll
            for (int kt = 0; kt < 5; ++kt)
#pragma unroll
                for (int s = 0; s < 2; ++s) { v4u pw; pw.x = pg8::cvt_pk_bf16(p[kt][8 * s + 0], p[kt][8 * s + 1]); pw.y = pg8::cvt_pk_bf16(p[kt][8 * s + 2], p[kt][8 * s + 3]);
                    pw.z = pg8::cvt_pk_bf16(p[kt][8 * s + 4], p[kt][8 * s + 5]); pw.w = pg8::cvt_pk_bf16(p[kt][8 * s + 6], p[kt][8 * s + 7]);
                    const bf16x8 pb = __builtin_bit_cast(bf16x8, pw); const int kb = 32 * (kt0 + kt) + 16 * s + 4 * hi;
#pragma unroll
                    for (int dt = 0; dt < 2; ++dt) { const LAS unsigned char* vp = Vt + (dt * 32 + q32) * ATT_VT_PITCH + kb * 2;
                        const s16x4 v0 = *(const LAS s16x4*)vp, v1 = *(const LAS s16x4*)(vp + 16);
                        const bf16x8 vf = (bf16x8){v0[0], v0[1], v0[2], v0[3], v1[0], v1[1], v1[2], v1[3]};
                        o[dt] = __builtin_amdgcn_mfma_f32_32x32x16_bf16(vf, pb, o[dt], 0, 0, 0); } }
            const float rl = 1.0f / l; bf16* ap = AZ + qrow * 1024 + head * 64 + 4 * hi;
#pragma unroll
            for (int dt = 0; dt < 2; ++dt)
#pragma unroll
                for (int g = 0; g < 4; ++g) { bf16* pp = ap + dt * 32 + 8 * g; const v2u z = zz[sb][dt * 4 + g]; v2u ov;
                    ov.x = pg8::cvt_pk_bf16(o[dt][4 * g + 0] * rl * pg8::bf_lo(z.x), o[dt][4 * g + 1] * rl * pg8::bf_hi(z.x));
                    ov.y = pg8::cvt_pk_bf16(o[dt][4 * g + 2] * rl * pg8::bf_lo(z.y), o[dt][4 * g + 3] * rl * pg8::bf_hi(z.y));
                    asm volatile("" :: "v"(ov.x), "v"(ov.y)); if (!nostore) *(v2u*)pp = ov; }
        }
    }
#undef AT_LOAD
    __syncthreads();
}


constexpr int ML_PQ = 528, ML_PK2 = 576, ML_PS = 144, ML_PV = 80;
typedef short v4i16_t __attribute__((ext_vector_type(4)));
typedef __bf16 bf16x2_t __attribute__((ext_vector_type(2)));
__device__ __forceinline__ float dot2bf(unsigned a, unsigned b, float c) { return __builtin_amdgcn_fdot2_f32_bf16(__builtin_bit_cast(bf16x2_t, a), __builtin_bit_cast(bf16x2_t, b), c, false); }
__device__ __forceinline__ s16x4 lds_tr(const LAS unsigned char* p) { return __builtin_bit_cast(s16x4, __builtin_amdgcn_ds_read_tr16_b64_v4i16((LAS v4i16_t*)p)); }
constexpr int ML_TBL = 1536;
#define ML_GATES_T(T) do { const float bc = scan_sum64(lf_n, lane), u = ig_n - bc, pm = scan_max64(u, lane); \
            const float g = fmaxf(m_run, pm), g63 = lane_bcast(g, 63), bl = lane_bcast(bc, 63); \
            (T)[lane] = u; (T)[64 + lane] = g; { const float wv_ = __expf(u - g63); (T)[128 + lane] = wv_; ((LAS unsigned short*)((T) + 336))[lane] = (unsigned short)(pg8::cvt_pk_bf16(wv_, 0.f) & 0xffffu); } (T)[192 + lane] = __expf(m_run - g); (T)[256 + lane] = __expf(-(bc + g)); if (lane == 0) (T)[320] = __expf(m_run - g63); \
            m_run = bl + g63; } while (0)

constexpr int UP_K = 0, UP_V = UP_K + 2 * 64 * ML_PK2, UP_W = UP_V + 2 * 64 * ML_PK2, UP_WB = UP_W + 2048, UP_RED = UP_WB + 1024, UP_CW = UP_RED + 128, UP_END = UP_CW + 4096;
__device__ __forceinline__ void mlstm_usum_phase(Frame& F, const Args& a) {
    const bf16* MK = (const bf16*)(a.ws + WS_MK); bf16* KCO = (bf16*)(a.ws + WS_KC); const bf16* VH = (const bf16*)(a.ws + WS_MV);
    const float* IG = (const float*)(a.ws + WS_IG); const float* LF = (const float*)(a.ws + WS_LF);
    bf16* UK = (bf16*)(a.ws + WS_Q); float* UN = (float*)(a.ws + WS_UN); float* ST = (float*)(a.ws + WS_UST);
    LAS unsigned char* L = F.lds;
    const int w = F.wave;
    for (int uid = F.vcu; uid < BATCH * MH * 8; uid += F.G) {
        int t__ = F.tid; asm volatile("" : "+v"(t__)); const int tid = t__, lane = tid & 63, l31 = lane & 31, hi = lane >> 5;
        const int bh = uid >> 3, j = uid & 7, b = bh >> 2, h = bh & 3;
        const size_t rowb = (size_t)b * SEQ + (size_t)j * 512; const int colh = h * 256;
        v4u rk[7], rv[4];
#define UP_LOAD(c) do { int t_ = F.tid; asm volatile("" : "+v"(t_)); const int ss = t_ >> 3, cq = t_ & 7, c8 = t_ & 31, rg = t_ >> 5; (void)ss; (void)cq; (void)c8; (void)rg; unsigned o_ = (unsigned)((((c) * 64 + 4 * rg) * 1024 + colh + 8 * c8) * 2); asm volatile("" : "+v"(o_)); const char* k_ = (const char*)(MK + rowb * 1024) + o_; \
            _Pragma("unroll") for (int r = 0; r < 7; ++r) { rk[r] = (v4u){0u, 0u, 0u, 0u}; if (r >= 3 || j > 0 || (c) > 0 || rg > 0) rk[r] = *(const v4u*)(k_ + (r - 3) * 2048); } \
            unsigned ov_ = (unsigned)((((c) * 64 + ss) * 1024 + colh + 8 * cq) * 2); asm volatile("" : "+v"(ov_)); const char* v_ = (const char*)(VH + rowb * 1024) + ov_; \
            _Pragma("unroll") for (int i = 0; i < 4; ++i) rv[i] = __builtin_nontemporal_load((const v4u*)(v_ + 128 * i)); } while (0)
#define UP_LOADK(c) do { int t_ = F.tid; asm volatile("" : "+v"(t_)); const int c8 = t_ & 31, rg = t_ >> 5; unsigned o_ = (unsigned)((((c) * 64 + 4 * rg) * 1024 + colh + 8 * c8) * 2); asm volatile("" : "+v"(o_)); const char* k_ = (const char*)(MK + rowb * 1024) + o_; \
            _Pragma("unroll") for (int r = 0; r < 7; ++r) { rk[r] = (v4u){0u, 0u, 0u, 0u}; if (r >= 3 || j > 0 || (c) > 0 || rg > 0) rk[r] = *(const v4u*)(k_ + (r - 3) * 2048); } } while (0)
#define UP_SILU16(v) ((v) * pg8::sigmoidf_(v) * 0.0625f)
#define UP_CONV(kc) do { int t_ = F.tid; asm volatile("" : "+v"(t_)); const int c8 = t_ & 31; \
            _Pragma("unroll") for (int hf = 0; hf < 2; ++hf) {                  \
                f32x4 wt[4], sm[4]; \
                _Pragma("unroll") for (int t = 0; t < 4; ++t) { wt[t] = *(const LAS f32x4*)(L + UP_CW + (t * 256 + 8 * c8 + 4 * hf) * 4); sm[t] = (f32x4){0.f, 0.f, 0.f, 0.f}; } \
                _Pragma("unroll") for (int row = 0; row < 7; ++row) { const unsigned xa = hf ? rk[row].z : rk[row].x, xb = hf ? rk[row].w : rk[row].y; \
                    const f32x4 xv = (f32x4){pg8::bf_lo(xa), pg8::bf_hi(xa), pg8::bf_lo(xb), pg8::bf_hi(xb)}; \
                    _Pragma("unroll") for (int t = 0; t < 4; ++t) { const int r = row - t; if (r >= 0 && r < 4) sm[r] += wt[t] * xv; } } \
                _Pragma("unroll") for (int r = 0; r < 4; ++r) { const unsigned pa = pg8::cvt_pk_bf16(UP_SILU16(sm[r][0]), UP_SILU16(sm[r][1])), pb = pg8::cvt_pk_bf16(UP_SILU16(sm[r][2]), UP_SILU16(sm[r][3])); \
                    if (hf) { kc[r].z = pa; kc[r].w = pb; } else { kc[r].x = pa; kc[r].y = pb; } } \
                __builtin_amdgcn_sched_barrier(0); } } while (0)
#define UP_KOUT(kc, c) do { int t_ = F.tid; asm volatile("" : "+v"(t_)); const int ss = t_ >> 3, cq = t_ & 7, c8 = t_ & 31, rg = t_ >> 5; (void)ss; (void)cq; (void)c8; (void)rg; unsigned o_ = (unsigned)((((c) * 64 + 4 * rg) * 1024 + colh + 8 * c8) * 2); asm volatile("" : "+v"(o_)); char* k_ = (char*)(KCO + rowb * 1024) + o_; \
            _Pragma("unroll") for (int r = 0; r < 4; ++r) *(v4u*)(k_ + r * 2048) = kc[r]; } while (0)
        __syncthreads();
        { ((LAS float*)(L + UP_CW))[tid] = a.conv_k[(tid >> 8) * 1024 + colh + (tid & 255)]; ((LAS float*)(L + UP_CW))[tid + 512] = a.conv_k[((tid >> 8) + 2) * 1024 + colh + (tid & 255)]; }
        if (j == 7) {
            __syncthreads();
#pragma unroll 1
            for (int c = 0; c < 8; ++c) { UP_LOADK(c); v4u kc[4]; UP_CONV(kc); UP_KOUT(kc, c); }
            continue;
        }
#define UP_STAGE(bu, c) do { v4u kc[4]; UP_CONV(kc); UP_KOUT(kc, c); int t_ = F.tid; asm volatile("" : "+v"(t_)); const int ss = t_ >> 3, cq = t_ & 7, c8 = t_ & 31, rg = t_ >> 5; (void)ss; (void)cq; (void)c8; (void)rg; \
            _Pragma("unroll") for (int r = 0; r < 4; ++r) *(LAS v4u*)(L + UP_K + (bu) * 64 * ML_PK2 + (4 * rg + r) * ML_PK2 + 16 * c8) = kc[r]; \
            const float ws_ = ((const LAS float*)(L + UP_W))[(c) * 64 + ss]; \
            _Pragma("unroll") for (int i = 0; i < 4; ++i) { v4u x; \
                x.x = pg8::cvt_pk_bf16(pg8::bf_lo(rv[i].x) * ws_, pg8::bf_hi(rv[i].x) * ws_); x.y = pg8::cvt_pk_bf16(pg8::bf_lo(rv[i].y) * ws_, pg8::bf_hi(rv[i].y) * ws_); \
                x.z = pg8::cvt_pk_bf16(pg8::bf_lo(rv[i].z) * ws_, pg8::bf_hi(rv[i].z) * ws_); x.w = pg8::cvt_pk_bf16(pg8::bf_lo(rv[i].w) * ws_, pg8::bf_hi(rv[i].w) * ws_); \
                *(LAS v4u*)(L + UP_V + (bu) * 64 * ML_PK2 + ss * ML_PK2 + 16 * (cq + 8 * i)) = x; } } while (0)
        UP_LOAD(0);
        {
            const float lfv = LF[(size_t)bh * SEQ + j * 512 + tid], igv = IG[(size_t)bh * SEQ + j * 512 + tid];
            const float bc = scan_sum64(lfv, lane), tot = lane_bcast(bc, 63);
            LAS float* RED = (LAS float*)(L + UP_RED);
            if (lane == 0) RED[w] = tot;
            __syncthreads();
            float later = 0.f, gtot = 0.f;
#pragma unroll
            for (int c = 0; c < 8; ++c) { const float tc = RED[c]; gtot += tc; later += (c > w) ? tc : 0.f; }
            const float ls = (tot - bc) + later + igv;
            float mx = ls; mx = fmaxf(mx, dppf_id<0x111>(mx, -__builtin_inff())); mx = fmaxf(mx, dppf_id<0x112>(mx, -__builtin_inff())); mx = fmaxf(mx, dppf_id<0x114>(mx, -__builtin_inff())); mx = fmaxf(mx, dppf_id<0x118>(mx, -__builtin_inff()));
            const float wmax = fmaxf(fmaxf(lane_bcast(mx, 15), lane_bcast(mx, 31)), fmaxf(lane_bcast(mx, 47), lane_bcast(mx, 63)));
            if (lane == 0) RED[8 + w] = wmax;
            __syncthreads();
            float mp = RED[8];
#pragma unroll
            for (int c = 1; c < 8; ++c) mp = fmaxf(mp, RED[8 + c]);
            const float wv = __expf(ls - mp);
            ((LAS float*)(L + UP_W))[tid] = wv; ((LAS unsigned short*)(L + UP_WB))[tid] = (unsigned short)(pg8::cvt_pk_bf16(wv, 0.f) & 0xffffu);
            if (tid == 0) { ST[(bh * 8 + j) * 2] = gtot; ST[(bh * 8 + j) * 2 + 1] = mp; }
        }
        __syncthreads();
        UP_STAGE(0, 0); UP_LOAD(1);
        __syncthreads();
        f32x16 acc[8];
#pragma unroll
        for (int i = 0; i < 8; ++i) acc[i] = f32x16{};
        float nacc = 0.f;
#pragma unroll 1
        for (int c = 0; c < 8; ++c) {
            const int bu = c & 1;
            { int ln__ = F.lane; asm volatile("" : "+v"(ln__)); const int lane = ln__, hi = lane >> 5;
            float nsum = 0.f;
#pragma unroll
            for (int kk = 0; kk < 4; ++kk) {
                const LAS unsigned char* vp = L + UP_V + bu * 64 * ML_PK2 + (16 * kk + 8 * hi + ((lane & 15) >> 2)) * ML_PK2 + (32 * w + 16 * ((lane >> 4) & 1) + 4 * (lane & 3)) * 2;
                const s16x4 va = lds_tr(vp), vb = lds_tr(vp + 4 * ML_PK2); const bf16x8 vf = (bf16x8){va[0], va[1], va[2], va[3], vb[0], vb[1], vb[2], vb[3]};
#pragma unroll
                for (int i = 0; i < 8; ++i) { const LAS unsigned char* kp = L + UP_K + bu * 64 * ML_PK2 + (16 * kk + 8 * hi + ((lane & 15) >> 2)) * ML_PK2 + (32 * i + 16 * ((lane >> 4) & 1) + 4 * (lane & 3)) * 2;
                    const s16x4 ka = lds_tr(kp), kb = lds_tr(kp + 4 * ML_PK2); const bf16x8 kf = (bf16x8){ka[0], ka[1], ka[2], ka[3], kb[0], kb[1], kb[2], kb[3]};
                    acc[i] = __builtin_amdgcn_mfma_f32_32x32x16_bf16(kf, vf, acc[i], 0, 0, 0); }
                { const LAS unsigned char* kp = L + UP_K + bu * 64 * ML_PK2 + (16 * kk + 8 * hi + ((lane & 15) >> 2)) * ML_PK2 + (32 * w + 16 * ((lane >> 4) & 1) + 4 * (lane & 3)) * 2;
                    const s16x4 ka = lds_tr(kp), kb = lds_tr(kp + 4 * ML_PK2); const v4u kw = __builtin_bit_cast(v4u, (bf16x8){ka[0], ka[1], ka[2], ka[3], kb[0], kb[1], kb[2], kb[3]}), wq = *(const LAS v4u*)((const LAS unsigned short*)(L + UP_WB) + c * 64 + 16 * kk + 8 * hi);
                    nsum = dot2bf(kw.x, wq.x, nsum); nsum = dot2bf(kw.y, wq.y, nsum); nsum = dot2bf(kw.z, wq.z, nsum); nsum = dot2bf(kw.w, wq.w, nsum); } }
            nacc += xor32_sum(nsum); }
            if (c + 1 < 8) { UP_STAGE(bu ^ 1, c + 1); if (c + 2 < 8) UP_LOAD(c + 2); }
            __syncthreads();
        }
#undef UP_LOAD
#undef UP_LOADK
#undef UP_CONV
#undef UP_SILU16
#undef UP_KOUT
#undef UP_STAGE
        { bf16* up = UK + ((size_t)(bh * 8 + j) * 256 + 32 * w + l31) * 256 + 4 * hi;
#pragma unroll
            for (int i = 0; i < 8; ++i)
#pragma unroll
                for (int g = 0; g < 4; ++g) { v2u x; x.x = pg8::cvt_pk_bf16(acc[i][4 * g + 0], acc[i][4 * g + 1]); x.y = pg8::cvt_pk_bf16(acc[i][4 * g + 2], acc[i][4 * g + 3]); *(v2u*)(up + 32 * i + 8 * g) = x; }
            if (hi == 0) UN[(size_t)(bh * 8 + j) * 256 + 32 * w + l31] = nacc; }
    }
}

__device__ __forceinline__ void mlstm_combine_phase(Frame& F, const Args& a) {
    const bf16* UK = (const bf16*)(a.ws + WS_Q); const float* UN = (const float*)(a.ws + WS_UN); const float* ST = (const float*)(a.ws + WS_UST);
    bf16* CK = (bf16*)(a.ws + WS_Q) + (size_t)32 * 8 * 65536; float* NCK = (float*)(a.ws + WS_NCK); float* MCK = (float*)(a.ws + WS_MCK);
    for (int blk = F.vcu; blk < 32 * 8; blk += F.G) {
        const int bh = blk >> 3, part = blk & 7;
        float ca[7], cb[7], m = 0.f;
#pragma unroll
        for (int j = 0; j < 7; ++j) { const float G = ST[(bh * 8 + j) * 2], mp = ST[(bh * 8 + j) * 2 + 1], mn = fmaxf(G + m, mp); ca[j] = __expf(G + m - mn); cb[j] = __expf(mp - mn); m = mn;
            if (part == 0 && F.tid == 0) MCK[bh * 8 + j + 1] = mn; }
#pragma unroll
        for (int q = 0; q < 2; ++q) { const size_t piece = (size_t)part * 1024 + q * 512 + F.tid;
            float c[8] = {0.f, 0.f, 0.f, 0.f, 0.f, 0.f, 0.f, 0.f};
            v4u uu[7];
#pragma unroll
            for (int j = 0; j < 7; ++j) uu[j] = __builtin_nontemporal_load((const v4u*)(UK + ((size_t)(bh * 8 + j) * 65536) + piece * 8));
#pragma unroll
            for (int j = 0; j < 7; ++j) { const v4u u = uu[j];
                c[0] = ca[j] * c[0] + cb[j] * pg8::bf_lo(u.x); c[1] = ca[j] * c[1] + cb[j] * pg8::bf_hi(u.x); c[2] = ca[j] * c[2] + cb[j] * pg8::bf_lo(u.y); c[3] = ca[j] * c[3] + cb[j] * pg8::bf_hi(u.y);
                c[4] = ca[j] * c[4] + cb[j] * pg8::bf_lo(u.z); c[5] = ca[j] * c[5] + cb[j] * pg8::bf_hi(u.z); c[6] = ca[j] * c[6] + cb[j] * pg8::bf_lo(u.w); c[7] = ca[j] * c[7] + cb[j] * pg8::bf_hi(u.w);
                v4u o; o.x = pg8::cvt_pk_bf16(c[0], c[1]); o.y = pg8::cvt_pk_bf16(c[2], c[3]); o.z = pg8::cvt_pk_bf16(c[4], c[5]); o.w = pg8::cvt_pk_bf16(c[6], c[7]);
                *(v4u*)(CK + ((size_t)(bh * 8 + j + 1) * 65536) + piece * 8) = o; } }
        if (part == 0 && F.tid < 256) { float nn = 0.f;
#pragma unroll
            for (int j = 0; j < 7; ++j) { nn = ca[j] * nn + cb[j] * UN[(size_t)(bh * 8 + j) * 256 + F.tid]; NCK[(size_t)(bh * 8 + j + 1) * 256 + F.tid] = nn; } }
    }
}

#define ML_LANES() int ln__ = F.lane, td__ = F.tid; asm volatile("" : "+v"(ln__), "+v"(td__)); const int lane = ln__, tid = td__, l15 = lane & 15, kq = lane >> 4, l31 = lane & 31, hi = lane >> 5, ss = tid >> 3, cq = tid & 7; (void)l15; (void)kq; (void)l31; (void)hi; (void)ss; (void)cq
constexpr int OU_QS = 0, OU_KS = OU_QS + 64 * ML_PQ, OU_VS = OU_KS + 64 * 512,
               OU_ST = OU_VS + 64 * ML_PK2, OU_NV = OU_ST + 64 * ML_PS, OU_GT = OU_NV + 1024, OU_RS = OU_GT + 2 * ML_TBL, OU_HT = OU_RS + 2 * 1024, OU_CW = OU_HT + 64 * ML_PQ, OU_END = OU_CW + 4096;
static_assert(OU_END <= LDSCTL_OFF && UP_END <= LDSCTL_OFF, "mLSTM LDS maps");
__device__ __forceinline__ void mlstm_out_phase(Frame& F, const Args& a, const int nostore = 0) {
    const bf16* MQ = (const bf16*)(a.ws + WS_MQ); const bf16* KC = (const bf16*)(a.ws + WS_KC); bf16* VH = (bf16*)(a.ws + WS_MV); const bf16* OG = (const bf16*)(a.ws + WS_OG);
    const float* IG = (const float*)(a.ws + WS_IG); const float* LF = (const float*)(a.ws + WS_LF);
    const bf16* CK = (const bf16*)(a.ws + WS_Q) + (size_t)32 * 8 * 65536; const float* NCK = (const float*)(a.ws + WS_NCK); const float* MCK = (const float*)(a.ws + WS_MCK);
    LAS unsigned char* L = F.lds;
    const int w = F.wave, ti = w >> 1, sh = (w ^ (w >> 2)) & 1;
    for (int uid = F.vcu; uid < BATCH * MH * 8; uid += F.G) {
        int t__ = F.tid; asm volatile("" : "+v"(t__)); const int tid = t__, lane = tid & 63, l15 = lane & 15, kq = lane >> 4, l31 = lane & 31, hi = lane >> 5; (void)l15; (void)kq;
        const int bh = uid >> 3, j = uid & 7, b = bh >> 2, h = bh & 3;
        const size_t rowb = (size_t)b * SEQ + (size_t)j * 512; const int colh = h * 256;
        const float* ig = IG + (size_t)bh * SEQ + j * 512; const float* lf = LF + (size_t)bh * SEQ + j * 512;
        const int ss = tid >> 3, cq = tid & 7;
        float m_run = (j > 0) ? MCK[bh * 8 + j] : 0.f, lf_n = 0.f, ig_n = 0.f;
        __syncthreads();
        unsigned Cp[8][8];
        { const bf16* ck = CK + ((size_t)(bh * 8 + j) * 256 + 32 * w + l31) * 256 + 4 * hi;
#pragma unroll
            for (int i = 0; i < 8; ++i)
#pragma unroll
                for (int g = 0; g < 4; ++g) { v2u x = (v2u){0u, 0u}; if (j > 0) x = *(const v2u*)(ck + 32 * i + 8 * g); Cp[i][2 * g] = x.x; Cp[i][2 * g + 1] = x.y; } }
        if (tid < 256) ((LAS float*)(L + OU_NV))[tid] = (j > 0) ? NCK[(size_t)(bh * 8 + j) * 256 + tid] : 0.f;
        if (tid < 512) ((LAS float*)(L + OU_RS))[tid] = 0.f;
#define OU_GLOAD(cc) do { if (w == 0) { lf_n = lf[(cc) * 64 + lane]; ig_n = ig[(cc) * 64 + lane]; } } while (0)
        v4u rq[7], rqc[4], rk[4], rv[4];
#define OU_LOAD(cc) do { int tl_ = F.tid; asm volatile("" : "+v"(tl_)); unsigned oq_ = (unsigned)((((cc) * 64 + 4 * (tl_ >> 5)) * 1024 + colh + 8 * (tl_ & 31)) * 2); asm volatile("" : "+v"(oq_)); const char* q_ = (const char*)(MQ + rowb * 1024) + oq_; \
            _Pragma("unroll") for (int r = 0; r < 7; ++r) { rq[r] = (v4u){0u, 0u, 0u, 0u}; if (r >= 3 || j > 0 || (cc) > 0 || (tl_ >> 5) > 0) rq[r] = *(const v4u*)(q_ + (r - 3) * 2048); } \
            unsigned o_ = (unsigned)((((cc) * 64 + (tl_ >> 3)) * 1024 + colh + 8 * (tl_ & 7)) * 2); asm volatile("" : "+v"(o_));     \
            const char* k_ = (const char*)(KC + rowb * 1024) + o_; const char* v_ = (const char*)(VH + rowb * 1024) + o_; \
            _Pragma("unroll") for (int i = 0; i < 4; ++i) { rk[i] = __builtin_nontemporal_load((const v4u*)(k_ + 128 * i)); rv[i] = __builtin_nontemporal_load((const v4u*)(v_ + 128 * i)); } } while (0)
#define OU_SILU(v) ((v) * pg8::sigmoidf_(v))
#define OU_QCONV() do { int t_ = F.tid; asm volatile("" : "+v"(t_)); const int c8_ = t_ & 31; \
            _Pragma("unroll") for (int hf = 0; hf < 2; ++hf) { f32x4 wt[4], sm[4]; \
                _Pragma("unroll") for (int t = 0; t < 4; ++t) { wt[t] = *(const LAS f32x4*)(L + OU_CW + (t * 256 + 8 * c8_ + 4 * hf) * 4); sm[t] = (f32x4){0.f, 0.f, 0.f, 0.f}; } \
                _Pragma("unroll") for (int row = 0; row < 7; ++row) { const unsigned xa = hf ? rq[row].z : rq[row].x, xb = hf ? rq[row].w : rq[row].y; \
                    const f32x4 xv = (f32x4){pg8::bf_lo(xa), pg8::bf_hi(xa), pg8::bf_lo(xb), pg8::bf_hi(xb)}; \
                    _Pragma("unroll") for (int t = 0; t < 4; ++t) { const int r = row - t; if (r >= 0 && r < 4) sm[r] += wt[t] * xv; } } \
                _Pragma("unroll") for (int r = 0; r < 4; ++r) { const unsigned pa = pg8::cvt_pk_bf16(OU_SILU(sm[r][0]), OU_SILU(sm[r][1])), pb = pg8::cvt_pk_bf16(OU_SILU(sm[r][2]), OU_SILU(sm[r][3])); \
                    if (hf) { rqc[r].z = pa; rqc[r].w = pb; } else { rqc[r].x = pa; rqc[r].y = pb; } } \
                __builtin_amdgcn_sched_barrier(0); } } while (0)
#define OU_STAGE() do { int ts_ = F.tid; asm volatile("" : "+v"(ts_)); const int ss_ = ts_ >> 3, cq_ = ts_ & 7, rg_ = ts_ >> 5, c8_ = ts_ & 31; \
            _Pragma("unroll") for (int r = 0; r < 4; ++r) *(LAS v4u*)(L + OU_QS + (4 * rg_ + r) * ML_PQ + 16 * c8_) = rqc[r]; \
            _Pragma("unroll") for (int i = 0; i < 4; ++i) { *(LAS v4u*)(L + OU_KS + ss_ * 512 + 16 * ((((cq_ + 8 * i) >> 2) ^ (ss_ & 3)) << 2 | ((cq_ + 8 * i) & 3))) = rk[i]; *(LAS v4u*)(L + OU_VS + ss_ * ML_PK2 + 16 * (cq_ + 8 * i)) = rv[i]; } } while (0)
        { ((LAS float*)(L + OU_CW))[tid] = a.conv_q[(tid >> 8) * 1024 + colh + (tid & 255)]; ((LAS float*)(L + OU_CW))[tid + 512] = a.conv_q[((tid >> 8) + 2) * 1024 + colh + (tid & 255)]; }
        OU_GLOAD(0); if (w == 0) { LAS float* T0 = (LAS float*)(L + OU_GT); ML_GATES_T(T0); } OU_GLOAD(1);
        OU_LOAD(0);
        __syncthreads();
        OU_QCONV(); OU_STAGE();
        __syncthreads();
#pragma unroll 1
        for (int cc = 0; cc < 8; ++cc) {
            const int tb = cc & 1; const LAS float* T = (const LAS float*)(L + OU_GT + tb * ML_TBL); LAS float* RS = (LAS float*)(L + OU_RS + tb * 1024);
            if (cc + 1 < 8) OU_LOAD(cc + 1);
            if (w == 0 && cc + 1 < 8) { LAS float* T1 = (LAS float*)(L + OU_GT + (tb ^ 1) * ML_TBL); ML_GATES_T(T1); if (cc + 2 < 8) OU_GLOAD(cc + 2); }
            {
                ML_LANES();
                f32x4 aS0 = {0.f, 0.f, 0.f, 0.f}, aS1 = aS0; float qn = 0.f;
#pragma unroll 2
                for (int kk = 0; kk < 8; ++kk) {
                    const bf16x8 qf = *(const LAS bf16x8*)(L + OU_QS + (16 * ti + l15) * ML_PQ + (32 * kk + 8 * kq) * 2);
                    const bf16x8 k0 = *(const LAS bf16x8*)(L + OU_KS + (32 * sh + l15) * 512 + ((kk ^ (l15 & 3)) << 6) + kq * 16);
                    const bf16x8 k1 = *(const LAS bf16x8*)(L + OU_KS + (32 * sh + 16 + l15) * 512 + ((kk ^ (l15 & 3)) << 6) + kq * 16);
                    aS0 = __builtin_amdgcn_mfma_f32_16x16x32_bf16(qf, k0, aS0, 0, 0, 0);
                    aS1 = __builtin_amdgcn_mfma_f32_16x16x32_bf16(qf, k1, aS1, 0, 0, 0);
                    if (sh == 0) { const f32x4 n0 = *(const LAS f32x4*)(L + OU_NV + (32 * kk + 8 * kq) * 4), n1 = *(const LAS f32x4*)(L + OU_NV + (32 * kk + 8 * kq + 4) * 4);
                        const v4u qw = __builtin_bit_cast(v4u, qf);
                        qn += pg8::bf_lo(qw.x) * n0[0] + pg8::bf_hi(qw.x) * n0[1] + pg8::bf_lo(qw.y) * n0[2] + pg8::bf_hi(qw.y) * n0[3] + pg8::bf_lo(qw.z) * n1[0] + pg8::bf_hi(qw.z) * n1[1] + pg8::bf_lo(qw.w) * n1[2] + pg8::bf_hi(qw.w) * n1[3]; }
                }
                if (sh == 0) { qn = xor32_sum(xor16_sum(qn)); if (kq == 0) RS[64 + 16 * ti + l15] = qn; }
                const float us0 = T[32 * sh + l15], us1 = T[32 * sh + 16 + l15];
                float rs[4];
#pragma unroll
                for (int r = 0; r < 4; ++r) { const int t = 16 * ti + 4 * kq + r; const float gt = T[64 + t];
                    const int s0 = 32 * sh + l15, s1 = s0 + 16;
                    const float d0 = (s0 <= t) ? aS0[r] * __expf(us0 - gt) : 0.f, d1 = (s1 <= t) ? aS1[r] * __expf(us1 - gt) : 0.f;
                    const unsigned pk = pg8::cvt_pk_bf16(d0, d1);
                    *(LAS unsigned short*)(L + OU_ST + t * ML_PS + s0 * 2) = (unsigned short)(pk & 0xffffu); *(LAS unsigned short*)(L + OU_ST + t * ML_PS + s1 * 2) = (unsigned short)(pk >> 16);
                    rs[r] = pg8::bf_lo(pk) + pg8::bf_hi(pk); }
#pragma unroll
                for (int r = 0; r < 4; ++r) { const float v = row16_sum(rs[r]); if (l15 == 0) atomicAdd((float*)(RS + 16 * ti + 4 * kq + r), v); }
            }
            if (cc + 1 < 8) OU_QCONV();
            __syncthreads();
            v4u ogr[4];
            { unsigned o_ = (unsigned)(((cc * 64 + (F.tid >> 5)) * 1024 + colh + 8 * (F.tid & 31)) * 2); asm volatile("" : "+v"(o_)); const char* g_ = (const char*)(OG + rowb * 1024) + o_;
#pragma unroll
                for (int i = 0; i < 4; ++i) ogr[i] = __builtin_nontemporal_load((const v4u*)(g_ + (size_t)i * 16 * 2048)); }
            { ML_LANES();
#pragma unroll 1
            for (int tt = 0; tt < 2; ++tt) {
                f32x16 aH = {}, aI = {};
#pragma unroll
                for (int kk = 0; kk < 4; ++kk) {
                    const int srow = 16 * kk + 8 * hi + ((lane & 15) >> 2);
                    const LAS unsigned char* vp = L + OU_VS + srow * ML_PK2 + (32 * w + 16 * ((lane >> 4) & 1) + 4 * (lane & 3)) * 2;
                    const s16x4 va = lds_tr(vp), vb = lds_tr(vp + 4 * ML_PK2);
                    const bf16x8 vfk = (bf16x8){va[0], va[1], va[2], va[3], vb[0], vb[1], vb[2], vb[3]};
                    const bf16x8 sf = *(const LAS bf16x8*)(L + OU_ST + (32 * tt + l31) * ML_PS + (16 * kk + 8 * hi) * 2);
                    aH = __builtin_amdgcn_mfma_f32_32x32x16_bf16(sf, vfk, aH, 0, 0, 0);
                }
#pragma unroll
                for (int i = 0; i < 8; ++i)
#pragma unroll
                    for (int s = 0; s < 2; ++s) { const v4u cw = (v4u){Cp[i][4 * s + 0], Cp[i][4 * s + 1], Cp[i][4 * s + 2], Cp[i][4 * s + 3]};
                        const bf16x8 cb = __builtin_bit_cast(bf16x8, cw);
                        const LAS unsigned char* qp = L + OU_QS + (32 * tt + l31) * ML_PQ + (32 * i + 16 * s + 4 * hi) * 2;
                        const s16x4 q0 = *(const LAS s16x4*)qp, q1 = *(const LAS s16x4*)(qp + 16);
                        const bf16x8 qf = (bf16x8){q0[0], q0[1], q0[2], q0[3], q1[0], q1[1], q1[2], q1[3]};
                        aI = __builtin_amdgcn_mfma_f32_32x32x16_bf16(qf, cb, aI, 0, 0, 0); }
#pragma unroll
                for (int g = 0; g < 4; ++g) { const int t0 = 32 * tt + 8 * g + 4 * hi;
                    const f32x4 wi = *(const LAS f32x4*)(T + 192 + t0), cl = *(const LAS f32x4*)(T + 256 + t0), rsum = *(const LAS f32x4*)(RS + t0), qnv = *(const LAS f32x4*)(RS + 64 + t0);
#pragma unroll
                    for (int e = 0; e < 4; ++e) { const float num = aH[4 * g + e] + wi[e] * aI[4 * g + e], den = rsum[e] + wi[e] * qnv[e];
                        const float hv = num * __builtin_amdgcn_rcpf(fmaxf(fabsf(den), cl[e]));
                        *(LAS unsigned short*)(L + OU_HT + (t0 + e) * ML_PQ + (32 * w + l31) * 2) = (unsigned short)(pg8::cvt_pk_bf16(hv, 0.f) & 0xffffu); } }
            }
            float nnew = 0.f;
            if (cc < 7) {
                const float decay = T[320];
                bf16x8 vw[4];
#pragma unroll
                for (int kk = 0; kk < 4; ++kk) { const f32x4 w0 = *(const LAS f32x4*)(T + 128 + 16 * kk + 8 * hi), w1 = *(const LAS f32x4*)(T + 128 + 16 * kk + 8 * hi + 4);
                    const LAS unsigned char* vp = L + OU_VS + (16 * kk + 8 * hi + ((lane & 15) >> 2)) * ML_PK2 + (32 * w + 16 * ((lane >> 4) & 1) + 4 * (lane & 3)) * 2; const s16x4 va = lds_tr(vp), vb = lds_tr(vp + 4 * ML_PK2);
                    const v4u x = __builtin_bit_cast(v4u, (bf16x8){va[0], va[1], va[2], va[3], vb[0], vb[1], vb[2], vb[3]}); v4u y;
                    y.x = pg8::cvt_pk_bf16(pg8::bf_lo(x.x) * w0[0], pg8::bf_hi(x.x) * w0[1]); y.y = pg8::cvt_pk_bf16(pg8::bf_lo(x.y) * w0[2], pg8::bf_hi(x.y) * w0[3]);
                    y.z = pg8::cvt_pk_bf16(pg8::bf_lo(x.z) * w1[0], pg8::bf_hi(x.z) * w1[1]); y.w = pg8::cvt_pk_bf16(pg8::bf_lo(x.w) * w1[2], pg8::bf_hi(x.w) * w1[3]); vw[kk] = __builtin_bit_cast(bf16x8, y); }
                float nsum = 0.f;
                const LAS unsigned char* kbase[4];
#pragma unroll
                for (int bq = 0; bq < 4; ++bq) kbase[bq] = L + OU_KS + (8 * hi + ((lane & 15) >> 2)) * 512 + ((bq ^ ((lane & 15) >> 2)) << 6) + (16 * ((lane >> 4) & 1) + 4 * (lane & 3)) * 2;
#pragma unroll
                for (int i = 0; i < 8; ++i) {
                    f32x16 ct;
#pragma unroll
                    for (int q = 0; q < 8; ++q) { ct[2 * q] = pg8::bf_lo(Cp[i][q]) * decay; ct[2 * q + 1] = pg8::bf_hi(Cp[i][q]) * decay; }
#pragma unroll
                    for (int kk = 0; kk < 4; ++kk) {
                        const int srow = 16 * kk + 8 * hi + ((lane & 15) >> 2);
                        const LAS unsigned char* kp = kbase[i & 3] + (16 * kk) * 512 + 256 * (i >> 2);
                        const s16x4 ka = lds_tr(kp), kb = lds_tr(kp + 4 * 512);
                        const bf16x8 kf = (bf16x8){ka[0], ka[1], ka[2], ka[3], kb[0], kb[1], kb[2], kb[3]};
                        ct = __builtin_amdgcn_mfma_f32_32x32x16_bf16(kf, vw[kk], ct, 0, 0, 0);
                        if (i == w) { const f32x4 w0 = *(const LAS f32x4*)(T + 128 + 16 * kk + 8 * hi), w1 = *(const LAS f32x4*)(T + 128 + 16 * kk + 8 * hi + 4); const v4u kw = __builtin_bit_cast(v4u, kf);
                            nsum += pg8::bf_lo(kw.x) * w0[0] + pg8::bf_hi(kw.x) * w0[1] + pg8::bf_lo(kw.y) * w0[2] + pg8::bf_hi(kw.y) * w0[3] + pg8::bf_lo(kw.z) * w1[0] + pg8::bf_hi(kw.z) * w1[1] + pg8::bf_lo(kw.w) * w1[2] + pg8::bf_hi(kw.w) * w1[3]; }
                    }
#pragma unroll
                    for (int q = 0; q < 8; ++q) Cp[i][q] = pg8::cvt_pk_bf16(ct[2 * q], ct[2 * q + 1]);
                }
                nsum = xor32_sum(nsum);
                nnew = decay * ((const LAS float*)(L + OU_NV))[32 * w + l31] + nsum;
            }
            __syncthreads();
            if (hi == 0) ((LAS float*)(L + OU_NV))[32 * w + l31] = nnew;
            }
            { ML_LANES();
#pragma unroll
            for (int i = 0; i < 4; ++i) { const int id = tid + 512 * i, t = id >> 5, c8 = id & 31;
                const v4u hx = *(const LAS v4u*)(L + OU_HT + t * ML_PQ + c8 * 16);
                float s2 = (pg8::bf_lo(hx.x) * pg8::bf_lo(hx.x) + pg8::bf_hi(hx.x) * pg8::bf_hi(hx.x)) + (pg8::bf_lo(hx.y) * pg8::bf_lo(hx.y) + pg8::bf_hi(hx.y) * pg8::bf_hi(hx.y))
                         + (pg8::bf_lo(hx.z) * pg8::bf_lo(hx.z) + pg8::bf_hi(hx.z) * pg8::bf_hi(hx.z)) + (pg8::bf_lo(hx.w) * pg8::bf_lo(hx.w) + pg8::bf_hi(hx.w) * pg8::bf_hi(hx.w));
                s2 = xor16_sum(row16_sum(s2));
                const float rsq = __builtin_amdgcn_rsqf(s2 * (1.f / 256.f) + EPS);
                const size_t o = (rowb + (size_t)cc * 64 + t) * 1024 + colh + c8 * 8;
                const v4u g = ogr[i]; const f32x4 m0 = *(const f32x4*)(a.m_norm_w + colh + c8 * 8) * rsq, m1 = *(const f32x4*)(a.m_norm_w + colh + c8 * 8 + 4) * rsq; v4u ov;
                ov.x = pg8::cvt_pk_bf16(pg8::bf_lo(hx.x) * m0[0] * pg8::bf_lo(g.x), pg8::bf_hi(hx.x) * m0[1] * pg8::bf_hi(g.x)); ov.y = pg8::cvt_pk_bf16(pg8::bf_lo(hx.y) * m0[2] * pg8::bf_lo(g.y), pg8::bf_hi(hx.y) * m0[3] * pg8::bf_hi(g.y));
                ov.z = pg8::cvt_pk_bf16(pg8::bf_lo(hx.z) * m1[0] * pg8::bf_lo(g.z), pg8::bf_hi(hx.z) * m1[1] * pg8::bf_hi(g.z)); ov.w = pg8::cvt_pk_bf16(pg8::bf_lo(hx.w) * m1[2] * pg8::bf_lo(g.w), pg8::bf_hi(hx.w) * m1[3] * pg8::bf_hi(g.w));
                asm volatile("" :: "v"(ov.x), "v"(ov.y), "v"(ov.z), "v"(ov.w)); if (!nostore) *(v4u*)(VH + o) = ov; }
            if (tid < 256) ((LAS float*)(L + OU_RS + (tb ^ 1) * 1024))[tid] = 0.f;
            if (cc + 1 < 8) OU_STAGE();
            }
            __syncthreads();
        }
#undef OU_GLOAD
#undef OU_LOAD
#undef OU_STAGE
#undef OU_QCONV
#undef OU_SILU
    }
}
#undef ML_GATES_T

constexpr int N_PHASES = 8;
#ifndef PROBE
#define PROBE 0
#endif
__global__ void __launch_bounds__(NWAVES * 64, 2) skel_fwd(Args args) {
    extern __shared__ __attribute__((aligned(16))) unsigned char lds[];
    Frame F;
    F.lds = (LAS unsigned char*)lds;
    F.MISC = (volatile LAS unsigned*)(F.lds + MISC_OFF);
    F.tid = threadIdx.x; F.lane = F.tid & 63; F.wave = __builtin_amdgcn_readfirstlane(F.tid >> 6);
    F.G = gridDim.x; { const int bx = blockIdx.x; F.vcu = (F.G % 8 == 0) ? (bx % 8) * (F.G / 8) + bx / 8 : bx; }
    unsigned char* ws = args.ws;
    F.ctl = (gu32*)(ws + WS_CTL);
    for (int u = F.tid; u < (LDS_BYTES - LDSCTL_OFF) / 4; u += NWAVES * 64) ((LAS unsigned*)(F.lds + LDSCTL_OFF))[u] = 0u;
    __syncthreads();
    const int lo = args.ph_lo, hi = args.ph_hi;
    XcdBarrier bar; bar.bar = (unsigned*)(F.ctl + CW_BAR); bar.x = 0; bar.st = nullptr;
    if (hi - lo > 1) bar = xcd_barrier_post((unsigned*)(F.ctl + CW_BAR), F.MISC + 8);
#define IN(k) (lo <= (k) && (k) < hi)
#define BOTH(k) (IN(k) && IN((k) + 1))
#define GRID_BAR() xcd_barrier(bar)
    bf16* XN = (bf16*)(ws + WS_XN); bf16* QB = (bf16*)(ws + WS_Q); bf16* KB = (bf16*)(ws + WS_K); bf16* VB = (bf16*)(ws + WS_V); bf16* AZ = (bf16*)(ws + WS_AZ);
    bf16* MQ = (bf16*)(ws + WS_MQ); bf16* MK = (bf16*)(ws + WS_MK); bf16* MV = (bf16*)(ws + WS_MV); bf16* OG = (bf16*)(ws + WS_OG);
    bf16* GA = (bf16*)args.out; bf16* GM = (bf16*)args.out + (size_t)M * D;

    if (IN(0)) { p0_prologue(F, args); if (BOTH(0)) GRID_BAR(); }
    if (IN(1)) { p1_norm(F, args); if (PROBE == 1) p1_norm(F, args); __syncthreads(); weight_copies(F, args); if (BOTH(1)) GRID_BAR(); }
    if (IN(2)) {
        pg8::Gemm g{XN, (const bf16*)(ws + WS_WIN), D, D / 64};
        pg8::StaticOrder S; S.init(M, NPROJ, F.G, (int)blockIdx.x);
        pg8::EpiProj E{QB, KB, VB, AZ, MQ, MK, MV, OG, GA, GM, args.pos};
        pg8::gemm_phase<pg8::EpiProj, pg8::StaticOrder, true>(F.lds + RING_OFF, g, S, E);
        if (PROBE == 2) pg8::gemm_phase<pg8::EpiProj, pg8::StaticOrder, true>(F.lds + RING_OFF, g, S, E);
        if (BOTH(2)) GRID_BAR();
    }
    if (IN(3)) { attn_phase(F, args); if (PROBE == 3) attn_phase(F, args, args.pad); if (BOTH(3)) GRID_BAR(); }
    if (IN(4)) { mlstm_usum_phase(F, args); if (PROBE == 4) mlstm_usum_phase(F, args); GRID_BAR(); mlstm_combine_phase(F, args); if (BOTH(4)) GRID_BAR(); }
    if (IN(5)) { mlstm_out_phase(F, args); if (PROBE == 5) mlstm_out_phase(F, args, args.pad); if (BOTH(5)) GRID_BAR(); }
    if (IN(6)) {
        pg8::Gemm g{AZ, (const bf16*)(ws + WS_WATT), D, 2 * D / 64};
        static_assert(WS_MV - WS_AZ == (size_t)pg8::EpiMerge::DELTA_A && WS_WM - WS_WATT == (size_t)pg8::EpiMerge::DELTA_B, "segment deltas");
        pg8::StaticOrder S; S.init(M, D, F.G, (int)blockIdx.x);
        pg8::EpiMerge E{GA, GM, XN};
        pg8::gemm_phase<pg8::EpiMerge, pg8::StaticOrder, true>(F.lds + RING_OFF, g, S, E);
        if (PROBE == 6) pg8::gemm_phase<pg8::EpiMerge, pg8::StaticOrder, true>(F.lds + RING_OFF, g, S, E);
        if (BOTH(6)) GRID_BAR();
    }
    if (IN(7)) {
        pg8::Gemm g{XN, (const bf16*)(ws + WS_WOUT), D, D / 64};
        pg8::StaticOrder S; S.init(M, D, F.G, (int)blockIdx.x);
        struct BarCall { XcdBarrier b; __device__ __forceinline__ void operator()() const { xcd_barrier(b); } };
        pg8::EpiOutNorm<BarCall> E{args.x, (const float*)(ws + WS_MOD), args.b_ada, args.fnorm_w, args.out, (float*)(ws + WS_PART), BarCall{bar}};
        pg8::gemm_phase<pg8::EpiOutNorm<BarCall>, pg8::StaticOrder, true>(F.lds + RING_OFF, g, S, E);
    }
#undef IN
#undef BOTH
#undef GRID_BAR
}

extern "C" void kernel_launch(void* const* d_in, const int* in_sizes, int n_in, void* d_out, int out_size, void* d_ws, size_t ws_size, hipStream_t stream) {
    static int grid = 0;
    if (grid == 0) {
        if (n_in != 16 || in_sizes[0] != M * D || out_size != M * D || ws_size < WS_END) { fprintf(stderr, "kernel_launch: unexpected shapes (n_in %d, in0 %d, out %d, ws %zu); nothing launched\n", n_in, n_in > 0 ? in_sizes[0] : -1, out_size, ws_size); grid = -1; return; }
        int dev = 0, cus = 0, per_cu = 0;
        if (hipGetDevice(&dev) != hipSuccess || hipDeviceGetAttribute(&cus, hipDeviceAttributeMultiprocessorCount, dev) != hipSuccess) { grid = -1; return; }
        if (hipFuncSetAttribute((const void*)skel_fwd, hipFuncAttributeMaxDynamicSharedMemorySize, LDS_BYTES) != hipSuccess) { fprintf(stderr, "kernel_launch: hipFuncSetAttribute failed\n"); grid = -1; return; }
        if (hipOccupancyMaxActiveBlocksPerMultiprocessor(&per_cu, (const void*)skel_fwd, NWAVES * 64, LDS_BYTES) != hipSuccess || per_cu < 1) fprintf(stderr, "kernel_launch: note: occupancy query reports %d\n", per_cu);
        (void)hipGetLastError();
        grid = cus;
    }
    if (grid < 0) return;
    if (hipMemsetAsync((char*)d_ws + WS_CTL, 0, CTL_ZERO_BYTES, stream) != hipSuccess) return;
    Args a{};
    a.x = (const float*)d_in[0]; a.c = (const float*)d_in[1]; a.pos = (const int*)d_in[2]; a.w_ada = (const float*)d_in[3]; a.b_ada = (const float*)d_in[4]; a.norm_w = (const float*)d_in[5];
    a.w_in = (const float*)d_in[6]; a.b_if = (const float*)d_in[7]; a.sinks = (const float*)d_in[8]; a.conv_q = (const float*)d_in[9]; a.conv_k = (const float*)d_in[10]; a.m_norm_w = (const float*)d_in[11];
    a.w_att = (const float*)d_in[12]; a.w_m = (const float*)d_in[13]; a.w_out = (const float*)d_in[14]; a.fnorm_w = (const float*)d_in[15];
    a.out = (float*)d_out; a.ws = (unsigned char*)d_ws; a.pad = PROBE ? 1 : 0;
    unsigned char* ws = (unsigned char*)d_ws;
    auto run = [&](int lo, int hi, int li) { a.ph_lo = lo; a.ph_hi = hi; a.li = li; hipLaunchKernelGGL(skel_fwd, dim3(grid), dim3(NWAVES * 64), LDS_BYTES, stream, a); };
    run(0, N_PHASES, 0);
}
```

```cpp
#include <hip/hip_runtime.h>
#include <cstdio>
#include <cstdint>
template <int CTRL> __device__ __forceinline__ float dppf(float v) { return __builtin_bit_cast(float, __builtin_amdgcn_update_dpp(0, __builtin_bit_cast(int, v), CTRL, 0xf, 0xf, true)); }
template <int CTRL> __device__ __forceinline__ float dppf_id(float v, float ident) { return __builtin_bit_cast(float, __builtin_amdgcn_update_dpp(__builtin_bit_cast(int, ident), __builtin_bit_cast(int, v), CTRL, 0xf, 0xf, false)); }
__device__ __forceinline__ float row16_sum(float v) { v += dppf<0xB1>(v); v += dppf<0x4E>(v); v += dppf<0x141>(v); v += dppf<0x140>(v); return v; }
__device__ __forceinline__ float xor16_sum(float v) { float a = v, b = v; asm volatile("s_nop 1\n\tv_permlane16_swap_b32 %0, %1" : "+v"(a), "+v"(b)); return a + b; }
__device__ __forceinline__ float xor32_sum(float v) { float a = v, b = v; asm volatile("s_nop 1\n\tv_permlane32_swap_b32 %0, %1" : "+v"(a), "+v"(b)); return a + b; }
__device__ __forceinline__ float xor32_max(float v) { float a = v, b = v; asm volatile("s_nop 1\n\tv_permlane32_swap_b32 %0, %1" : "+v"(a), "+v"(b)); return fmaxf(a, b); }
__device__ __forceinline__ float wave_sum(float v) { return xor32_sum(xor16_sum(row16_sum(v))); }
__device__ __forceinline__ float lane_bcast(float v, int l) { return __builtin_bit_cast(float, __builtin_amdgcn_readlane(__builtin_bit_cast(int, v), l)); }
__device__ __forceinline__ float scan_sum64(float v, int lane) {
    v += dppf_id<0x111>(v, 0.f); v += dppf_id<0x112>(v, 0.f); v += dppf_id<0x114>(v, 0.f); v += dppf_id<0x118>(v, 0.f);
    const float t0 = lane_bcast(v, 15), t1 = lane_bcast(v, 31), t2 = lane_bcast(v, 47); const int row = lane >> 4;
    return v + (row >= 1 ? t0 : 0.f) + (row >= 2 ? t1 : 0.f) + (row >= 3 ? t2 : 0.f); }
__device__ __forceinline__ float scan_max64(float v, int lane) {
    const float NI = -__builtin_inff();
    v = fmaxf(v, dppf_id<0x111>(v, NI)); v = fmaxf(v, dppf_id<0x112>(v, NI)); v = fmaxf(v, dppf_id<0x114>(v, NI)); v = fmaxf(v, dppf_id<0x118>(v, NI));
    const float t0 = lane_bcast(v, 15), t1 = lane_bcast(v, 31), t2 = lane_bcast(v, 47); const int row = lane >> 4;
    return fmaxf(v, fmaxf(row >= 1 ? t0 : NI, fmaxf(row >= 2 ? t1 : NI, row >= 3 ? t2 : NI))); }
namespace pg8 {
#define PG8_LAS __attribute__((address_space(3)))
typedef unsigned short bf16_t;
typedef short bf16x8 __attribute__((ext_vector_type(8)));
typedef float f32x4 __attribute__((ext_vector_type(4)));
typedef unsigned u32x4 __attribute__((ext_vector_type(4)));
typedef unsigned u32x2 __attribute__((ext_vector_type(2)));
constexpr int BM = 256, BK = 64, HALF = 128, HTB = HALF * BK * 2  , STAGE_BYTES = 8 * HTB, NXCD = 8, WGM = 4;

__host__ __device__ __forceinline__ int lds_byte(int r, int c) { const int st = (r >> 4) * 2 + (c >> 5), rr = r & 15, cc = c & 31, ob = rr * 64 + cc * 2; return st * 1024 + (ob ^ (((ob >> 9) & 1) << 5)); }
__host__ __device__ __forceinline__ void stage_rc(int b, int& R, int& C) { const int st = b / 1024, sb = b % 1024, swz = sb ^ (((sb >> 9) & 1) << 5); R = (st >> 1) * 16 + swz / 64; C = (st & 1) * 32 + (swz % 64) / 2; }
__host__ __device__ __forceinline__ int perm32(int rho) { const int n = rho >> 4, i = rho & 15; return 8 * (i >> 2) + 4 * n + (i & 3); }

struct Unit { int pm, pn, seg; };
struct Gemm { const bf16_t* A; const bf16_t* Bt; int K, nt; };

struct StaticOrder {
    int nM, nN, nwg, G, c;
    __host__ __device__ void init(int M, int N, int G_, int c_) { nM = M / BM; nN = N / BM; nwg = nM * nN; G = G_; c = c_; }
    __host__ __device__ bool next(int i, Unit& u) const {
        const long L = (long)i * G + c; if (L >= nwg) return false;
        int wgid = (int)L; { const int q = nwg / NXCD, r = nwg % NXCD, xcd = wgid % NXCD, off = wgid / NXCD; wgid = (xcd < r ? xcd * (q + 1) : r * (q + 1) + (xcd - r) * q) + off; }
        const int nig = WGM * nN, gid = wgid / nig, fm = gid * WGM, gsz = (nM - fm) < WGM ? (nM - fm) : WGM;
        u.pm = fm + ((wgid % nig) % gsz); u.pn = (wgid % nig) / gsz; u.seg = 0; return true;
    }
    __device__ __forceinline__ void a_ready(const Unit&) const {}
    __device__ __forceinline__ void done(const Unit&) const {}
};
typedef float cvt_f2_t __attribute__((ext_vector_type(2))); typedef __bf16 cvt_b2_t __attribute__((ext_vector_type(2)));
__device__ __forceinline__ unsigned cvt_pk_bf16(float lo, float hi) { return __builtin_bit_cast(unsigned, __builtin_convertvector((cvt_f2_t){lo, hi}, cvt_b2_t)); }
__device__ __forceinline__ float bf_lo(unsigned w) { return __builtin_bit_cast(float, w << 16); }
__device__ __forceinline__ float bf_hi(unsigned w) { return __builtin_bit_cast(float, w & 0xffff0000u); }
__device__ __forceinline__ float sigmoidf_(float x) { return __builtin_amdgcn_rcpf(1.0f + __builtin_amdgcn_exp2f(-1.4426950408889634f * x)); }
__device__ __forceinline__ float og_(float mo, float mz) { return mz * __builtin_amdgcn_rcpf((1.0f + __builtin_amdgcn_exp2f(-1.4426950408889634f * mo)) * (1.0f + __builtin_amdgcn_exp2f(-1.4426950408889634f * mz))); }
typedef f32x4 acc_t[2][2][4][2];

struct EpiProj {
    static constexpr bool PERM = true; static constexpr int NT1 = 1 << 20; static constexpr ptrdiff_t DELTA_A = 0, DELTA_B = 0, SEG_A = 0, SEG_B = 0;
    bf16_t *Q, *Kb, *Vb, *AZ, *MQ, *MK, *MV, *OG, *GA, *GM; const int* pos;
    __device__ __forceinline__ void mid(acc_t&, const Unit&, int, int, int, int) const {}
    __device__ __forceinline__ void operator()(acc_t& acc, const Unit& u, int wr, int wc, int fr, int fq) const {
        asm volatile("" : "+v"(fr), "+v"(fq));
        const int pn = u.pn, row0 = u.pm * BM + wr * 64 + fr, cl = wc * 32 + 8 * fq;
        if (pn < 5) {
            const int i0 = 16 * (wc & 1) + 4 * fq;
            float cf[4];
#pragma unroll
            for (int e = 0; e < 4; ++e) cf[e] = __builtin_amdgcn_exp2f(-(float)(i0 + e) * (13.287712379549449f / 32.0f)) * 0.15915494309189535f;
            const float sc = (pn < 4) ? 0.125f * 1.4426950408889634f : 1.0f;
            bf16_t* base = (pn < 4) ? Q + (size_t)pn * BM : Kb; const int ld = (pn < 4) ? 1024 : 256;
#pragma unroll
            for (int ai = 0; ai < 2; ++ai)
#pragma unroll
                for (int m = 0; m < 4; ++m) { const int row = row0 + ai * HALF + m * 16; const float p = (float)pos[row];
                    float cs[4], sn[4];
#pragma unroll
                    for (int e = 0; e < 4; ++e) { const float rev = __builtin_amdgcn_fractf(p * cf[e]); sn[e] = __builtin_amdgcn_sinf(rev) * sc; cs[e] = __builtin_amdgcn_cosf(rev) * sc; }
#pragma unroll
                    for (int bj = 0; bj < 2; ++bj) { const f32x4 v0 = acc[ai][bj][m][0], v1 = acc[ai][bj][m][1]; u32x4 w;
                        w.x = cvt_pk_bf16(v0[0] * cs[0] - v0[1] * sn[0], v0[1] * cs[0] + v0[0] * sn[0]);
                        w.y = cvt_pk_bf16(v0[2] * cs[1] - v0[3] * sn[1], v0[3] * cs[1] + v0[2] * sn[1]);
                        w.z = cvt_pk_bf16(v1[0] * cs[2] - v1[1] * sn[2], v1[1] * cs[2] + v1[0] * sn[2]);
                        w.w = cvt_pk_bf16(v1[2] * cs[3] - v1[3] * sn[3], v1[3] * cs[3] + v1[2] * sn[3]);
                        __builtin_nontemporal_store(w, (u32x4*)(base + (size_t)row * ld + bj * HALF + cl)); } }
        } else if (pn >= 22 && pn < 30) {
            bf16_t* base = OG + (size_t)(pn - 22) * 128 + (cl >> 1);
#pragma unroll
            for (int ai = 0; ai < 2; ++ai)
#pragma unroll
                for (int m = 0; m < 4; ++m) { const int row = row0 + ai * HALF + m * 16;
#pragma unroll
                    for (int bj = 0; bj < 2; ++bj) { const f32x4 v0 = acc[ai][bj][m][0], v1 = acc[ai][bj][m][1]; u32x2 w;
                        w.x = cvt_pk_bf16(og_(v0[0], v0[1]), og_(v0[2], v0[3]));
                        w.y = cvt_pk_bf16(og_(v1[0], v1[1]), og_(v1[2], v1[3]));
                        __builtin_nontemporal_store(w, (u32x2*)(base + (size_t)row * 1024 + bj * 64)); } }
        } else {
            int act; bf16_t* base; int ld = 1024;
            if (pn == 5) { act = 0; base = Vb; ld = 256; }
            else if (pn < 10) { act = 1; base = AZ + (size_t)(pn - 6) * BM; }
            else if (pn < 14) { act = 0; base = MQ + (size_t)(pn - 10) * BM; }
            else if (pn < 18) { act = 0; base = MK + (size_t)(pn - 14) * BM; }
            else if (pn < 22) { act = 0; base = MV + (size_t)(pn - 18) * BM; }
            else if (pn < 34) { act = 2; base = GA + (size_t)(pn - 30) * BM; }
            else { act = 2; base = GM + (size_t)(pn - 34) * BM; }
#pragma unroll
            for (int ai = 0; ai < 2; ++ai)
#pragma unroll
                for (int m = 0; m < 4; ++m) { const int row = row0 + ai * HALF + m * 16;
#pragma unroll
                    for (int bj = 0; bj < 2; ++bj) { f32x4 v0 = acc[ai][bj][m][0], v1 = acc[ai][bj][m][1];
                        if (act) {
#pragma unroll
                            for (int e = 0; e < 4; ++e) { const float s0 = sigmoidf_(v0[e]), s1 = sigmoidf_(v1[e]); v0[e] = (act == 1) ? v0[e] * s0 : s0; v1[e] = (act == 1) ? v1[e] * s1 : s1; } }
                        u32x4 w; w.x = cvt_pk_bf16(v0[0], v0[1]); w.y = cvt_pk_bf16(v0[2], v0[3]); w.z = cvt_pk_bf16(v1[0], v1[1]); w.w = cvt_pk_bf16(v1[2], v1[3]);
                        __builtin_nontemporal_store(w, (u32x4*)(base + (size_t)row * ld + bj * HALF + cl)); } }
        }
    }
};

struct EpiMerge {
    static constexpr bool PERM = true; static constexpr int NT1 = 16; static constexpr ptrdiff_t DELTA_A = (ptrdiff_t)192 << 20, DELTA_B = (ptrdiff_t)2 << 20, SEG_A = 0, SEG_B = 0;
    const bf16_t *GA, *GM; bf16_t* OUT;
    __device__ __forceinline__ void mid(acc_t& acc, const Unit& u, int wr, int wc, int fr, int fq) const {
        asm volatile("" : "+v"(fr), "+v"(fq));
        const int row0 = u.pm * BM + wr * 64 + fr, col0 = u.pn * BM + wc * 32 + 8 * fq;
#pragma unroll
        for (int ai = 0; ai < 2; ++ai)
#pragma unroll
            for (int m = 0; m < 4; ++m)
#pragma unroll
                for (int bj = 0; bj < 2; ++bj) { const size_t o = (size_t)(row0 + ai * HALF + m * 16) * 1024 + col0 + bj * HALF;
                    const u32x4 a = *(const u32x4*)(GA + o), b = *(const u32x4*)(GM + o);
                    f32x4 r0, r1;
                    r0[0] = bf_lo(a.x) * __builtin_amdgcn_rcpf(fmaxf(bf_lo(b.x), 1e-30f)); r0[1] = bf_hi(a.x) * __builtin_amdgcn_rcpf(fmaxf(bf_hi(b.x), 1e-30f));
                    r0[2] = bf_lo(a.y) * __builtin_amdgcn_rcpf(fmaxf(bf_lo(b.y), 1e-30f)); r0[3] = bf_hi(a.y) * __builtin_amdgcn_rcpf(fmaxf(bf_hi(b.y), 1e-30f));
                    r1[0] = bf_lo(a.z) * __builtin_amdgcn_rcpf(fmaxf(bf_lo(b.z), 1e-30f)); r1[1] = bf_hi(a.z) * __builtin_amdgcn_rcpf(fmaxf(bf_hi(b.z), 1e-30f));
                    r1[2] = bf_lo(a.w) * __builtin_amdgcn_rcpf(fmaxf(bf_lo(b.w), 1e-30f)); r1[3] = bf_hi(a.w) * __builtin_amdgcn_rcpf(fmaxf(bf_hi(b.w), 1e-30f));
                    acc[ai][bj][m][0] *= r0; acc[ai][bj][m][1] *= r1; }
    }
    __device__ __forceinline__ void operator()(acc_t& acc, const Unit& u, int wr, int wc, int fr, int fq) const {
        asm volatile("" : "+v"(fr), "+v"(fq));
        const int row0 = u.pm * BM + wr * 64 + fr, col0 = u.pn * BM + wc * 32 + 8 * fq;
#pragma unroll
        for (int ai = 0; ai < 2; ++ai)
#pragma unroll
            for (int m = 0; m < 4; ++m)
#pragma unroll
                for (int bj = 0; bj < 2; ++bj) { const size_t o = (size_t)(row0 + ai * HALF + m * 16) * 1024 + col0 + bj * HALF;
                    const u32x4 b = *(const u32x4*)(GM + o); const f32x4 v0 = acc[ai][bj][m][0], v1 = acc[ai][bj][m][1]; u32x4 w;
                    w.x = cvt_pk_bf16(v0[0] * bf_lo(b.x), v0[1] * bf_hi(b.x)); w.y = cvt_pk_bf16(v0[2] * bf_lo(b.y), v0[3] * bf_hi(b.y));
                    w.z = cvt_pk_bf16(v1[0] * bf_lo(b.z), v1[1] * bf_hi(b.z)); w.w = cvt_pk_bf16(v1[2] * bf_lo(b.w), v1[3] * bf_hi(b.w));
                    *(u32x4*)(OUT + o) = w; }
    }
};

template <class Bar> struct EpiOutNorm {
    static constexpr bool PERM = true; static constexpr int NT1 = 1 << 20; static constexpr ptrdiff_t DELTA_A = 0, DELTA_B = 0, SEG_A = 0, SEG_B = 0;
    const float* X; const float* modacc; const float* b_ada; const float* fw; float* OUT; float* part; Bar bar;
    __device__ __forceinline__ void mid(acc_t&, const Unit&, int, int, int, int) const {}
    __device__ __forceinline__ void operator()(acc_t& acc, const Unit& u, int wr, int wc, int fr, int fq) const {
        asm volatile("" : "+v"(fr), "+v"(fq));
        const int row0 = u.pm * BM + wr * 64 + fr, col0 = u.pn * BM + wc * 32 + 8 * fq, b = (u.pm * BM) >> 12;
        {
            f32x4 gt[2][2];
#pragma unroll
            for (int bj = 0; bj < 2; ++bj)
#pragma unroll
                for (int n = 0; n < 2; ++n) gt[bj][n] = *(const f32x4*)(modacc + b * 3072 + 2048 + col0 + bj * HALF + 4 * n) + *(const f32x4*)(b_ada + 2048 + col0 + bj * HALF + 4 * n);
#pragma unroll
            for (int ai = 0; ai < 2; ++ai)
#pragma unroll
                for (int m = 0; m < 4; ++m) { const int row = row0 + ai * HALF + m * 16; float ss = 0.f;
#pragma unroll
                    for (int bj = 0; bj < 2; ++bj)
#pragma unroll
                        for (int n = 0; n < 2; ++n) { const size_t o = (size_t)row * 1024 + col0 + bj * HALF + 4 * n;
                            const f32x4 xv = *(const f32x4*)(X + o); const f32x4 y = xv + gt[bj][n] * acc[ai][bj][m][n];
                            acc[ai][bj][m][n] = y; ss += (y[0] * y[0] + y[1] * y[1]) + (y[2] * y[2] + y[3] * y[3]); }
                    ss = xor32_sum(xor16_sum(ss));
                    if (fq == 0) (void)__hip_atomic_fetch_add(part + row, ss, __ATOMIC_RELAXED, __HIP_MEMORY_SCOPE_AGENT); if (m & 1) asm volatile("" ::: "memory"); }
        }
        bar(u.pm);
        asm volatile("" : "+v"(fr), "+v"(fq));
        {
            const int row0b = u.pm * BM + wr * 64 + fr, col0b = u.pn * BM + wc * 32 + 8 * fq;
            f32x4 fv[2][2];
#pragma unroll
            for (int bj = 0; bj < 2; ++bj)
#pragma unroll
                for (int n = 0; n < 2; ++n) fv[bj][n] = *(const f32x4*)(fw + col0b + bj * HALF + 4 * n);
#pragma unroll
            for (int ai = 0; ai < 2; ++ai)
#pragma unroll
                for (int m = 0; m < 4; ++m) { const int row = row0b + ai * HALF + m * 16;
                    const float s = __hip_atomic_load(part + row, __ATOMIC_RELAXED, __HIP_MEMORY_SCOPE_AGENT);
                    const float rstd = 1.0f / sqrtf(s * (1.f / 1024.f) + 1e-6f);
#pragma unroll
                    for (int bj = 0; bj < 2; ++bj)
#pragma unroll
                        for (int n = 0; n < 2; ++n) *(f32x4*)(OUT + (size_t)row * 1024 + col0b + bj * HALF + 4 * n) = acc[ai][bj][m][n] * rstd * fv[bj][n];
                    if (m == 3) asm volatile("" ::: "memory"); }
        }
    }
};

template <class Epi, class Sched, bool ALIGN_EPI = true>
__device__ __forceinline__ void gemm_phase(PG8_LAS unsigned char* lds, const Gemm g, const Sched& S, const Epi& E) {
    const int tid = threadIdx.x, wid = __builtin_amdgcn_readfirstlane(tid >> 6), lane = tid & 63, wr = wid >> 2, wc = wid & 3, fr = lane & 15, fq = lane >> 4;
    const int K = g.K, nt = g.nt; constexpr int nt1 = Epi::NT1;
    unsigned voffA[2], voffB[2];
#pragma unroll
    for (int i = 0; i < 2; ++i) { int R, C; stage_rc(tid * 16 + i * 8192, R, C); const int Rb = Epi::PERM ? ((R & ~31) + perm32(R & 31)) : R;
        voffA[i] = (unsigned)(R * K + C) * 2u; voffB[i] = (unsigned)(Rb * K + C) * 2u; }
    const size_t kstep = (size_t)(BK * 2);
    const size_t hstep = (size_t)HALF * K * 2;
    const size_t tstep = 2 * hstep;
    const unsigned ldsw = (unsigned)wid * 1024u;
    const int aoff = lds_byte(wr * 64 + fr, fq * 8), boff = lds_byte(wc * 32 + fr, fq * 8);
#define PG8_SA(b, h) (((b) * 2 + (h)) * HTB)
#define PG8_SB(b, h) ((4 + (b) * 2 + (h)) * HTB)
#define PG8_STAGE(bufoff, gbase, voff) do { _Pragma("unroll") for (int _i = 0; _i < 2; ++_i) \
        __builtin_amdgcn_global_load_lds((const unsigned*)((const char*)(gbase) + (voff)[_i]), (PG8_LAS unsigned*)(lds + (bufoff) + ldsw + _i * 8192), 16, 0, 0); } while (0)
#define PG8_LDA(dst, b, h) do { _Pragma("unroll") for (int m = 0; m < 4; ++m) _Pragma("unroll") for (int k = 0; k < 2; ++k) dst[m][k] = *(const PG8_LAS bf16x8*)(lds + PG8_SA(b, h) + aoff + m * 2048 + k * 1024); } while (0)
#define PG8_LDB(dst, b, h) do { _Pragma("unroll") for (int n = 0; n < 2; ++n) _Pragma("unroll") for (int k = 0; k < 2; ++k) dst[n][k] = *(const PG8_LAS bf16x8*)(lds + PG8_SB(b, h) + boff + n * 2048 + k * 1024); } while (0)
#define PG8_MMA(ai, bj, At, Bt) do { __builtin_amdgcn_s_setprio(1); _Pragma("unroll") for (int m = 0; m < 4; ++m) _Pragma("unroll") for (int n = 0; n < 2; ++n) _Pragma("unroll") for (int k = 0; k < 2; ++k) \
        acc[ai][bj][m][n] = __builtin_amdgcn_mfma_f32_16x16x32_bf16(Bt[n][k], At[m][k], acc[ai][bj][m][n], 0, 0, 0); __builtin_amdgcn_s_setprio(0); } while (0)
#define PG8_WAIT_V(n) asm volatile("s_waitcnt vmcnt(" #n ")" ::: "memory")
#define PG8_WAIT_L(n) asm volatile("s_waitcnt lgkmcnt(" #n ")" ::: "memory")
#define PG8_BAR __builtin_amdgcn_s_barrier()
#define PG8_SCHED __builtin_amdgcn_sched_barrier(0)
#define PG8_TP(c0, dl, tt) ((c0) + ((nt1 >= (1 << 20) || (tt) < nt1) ? (ptrdiff_t)(tt) * (ptrdiff_t)kstep : (ptrdiff_t)(dl) + (ptrdiff_t)((tt) - nt1) * (ptrdiff_t)kstep))
    Unit cur, nxt; int ui = 0;
    if (!S.next(0, cur)) return;
    f32x4 acc[2][2][4][2];
#pragma unroll
    for (int a = 0; a < 2; ++a)
#pragma unroll
        for (int b = 0; b < 2; ++b)
#pragma unroll
            for (int m = 0; m < 4; ++m)
#pragma unroll
                for (int n = 0; n < 2; ++n) acc[a][b][m][n] = (f32x4){0.f, 0.f, 0.f, 0.f};
    bf16x8 At[4][2], B0[2][2], B1[2][2];
    const char* cA = (const char*)g.A + (size_t)cur.pm * tstep + (ptrdiff_t)cur.seg * Epi::SEG_A; const char* cB = (const char*)g.Bt + (size_t)cur.pn * tstep + (ptrdiff_t)cur.seg * Epi::SEG_B;
    S.a_ready(cur);
    {
        PG8_STAGE(PG8_SB(0, 0), cB, voffB); PG8_STAGE(PG8_SB(0, 1), cB + hstep, voffB); PG8_STAGE(PG8_SA(0, 0), cA, voffA); PG8_STAGE(PG8_SA(0, 1), cA + hstep, voffA);
        if (wr == 1) PG8_BAR;
        PG8_WAIT_V(2); PG8_BAR;
        PG8_STAGE(PG8_SB(1, 0), cB + kstep, voffB); PG8_STAGE(PG8_SA(1, 0), cA + kstep, voffA); PG8_STAGE(PG8_SB(1, 1), cB + hstep + kstep, voffB);
        PG8_WAIT_V(6); PG8_BAR;
    }
    for (;;) {
        const bool has_next = S.next(ui + 1, nxt);
        const char* nA = has_next ? (const char*)g.A + (size_t)nxt.pm * tstep + (ptrdiff_t)nxt.seg * Epi::SEG_A : cA; const char* nB = has_next ? (const char*)g.Bt + (size_t)nxt.pn * tstep + (ptrdiff_t)nxt.seg * Epi::SEG_B : cB;
        for (int t = 0; t < nt; t += 2) {
            const bool last = (t == nt - 2);
            if constexpr (nt1 < (1 << 20)) { if (t == nt1) E.mid(acc, cur, wr, wc, fr, fq); }
            const char* a1 = PG8_TP(cA, Epi::DELTA_A, t + 1);
            const char* a2 = last ? nA : PG8_TP(cA, Epi::DELTA_A, t + 2); const char* b2 = last ? nB : PG8_TP(cB, Epi::DELTA_B, t + 2);
            const char* a3 = last ? nA + kstep : PG8_TP(cA, Epi::DELTA_A, t + 3); const char* b3 = last ? nB + kstep : PG8_TP(cB, Epi::DELTA_B, t + 3);
            if (last && has_next) S.a_ready(nxt);
            PG8_LDB(B0, 0, 0); PG8_LDB(B1, 0, 1); PG8_SCHED; PG8_LDA(At, 0, 0); PG8_STAGE(PG8_SA(1, 1), a1 + hstep, voffA);
            PG8_WAIT_V(8); PG8_WAIT_L(0); PG8_BAR; PG8_MMA(0, 0, At, B0); PG8_MMA(0, 1, At, B1); PG8_BAR; PG8_SCHED;
            PG8_LDA(At, 0, 1); PG8_STAGE(PG8_SB(0, 0), b2, voffB); PG8_STAGE(PG8_SB(0, 1), b2 + hstep, voffB); PG8_STAGE(PG8_SA(0, 0), a2, voffA);
            PG8_WAIT_V(8); PG8_WAIT_L(0); PG8_BAR; PG8_MMA(1, 0, At, B0); PG8_MMA(1, 1, At, B1); PG8_BAR; PG8_SCHED;
            PG8_LDB(B0, 1, 0); PG8_LDB(B1, 1, 1); PG8_SCHED; PG8_LDA(At, 1, 0); PG8_STAGE(PG8_SA(0, 1), a2 + hstep, voffA);
            PG8_WAIT_V(8); PG8_WAIT_L(0); PG8_BAR; PG8_MMA(0, 0, At, B0); PG8_MMA(0, 1, At, B1); PG8_BAR; PG8_SCHED;
            PG8_LDA(At, 1, 1); PG8_STAGE(PG8_SB(1, 0), b3, voffB); PG8_STAGE(PG8_SB(1, 1), b3 + hstep, voffB); PG8_STAGE(PG8_SA(1, 0), a3, voffA);
            PG8_WAIT_V(8); PG8_WAIT_L(0); PG8_BAR; PG8_MMA(1, 0, At, B0); PG8_MMA(1, 1, At, B1); PG8_BAR; PG8_SCHED;
        }
        if constexpr (ALIGN_EPI) { if (wr == 0) PG8_BAR; }
        E(acc, cur, wr, wc, fr, fq); S.done(cur);
        if (!has_next) break;
#pragma unroll
        for (int a = 0; a < 2; ++a)
#pragma unroll
            for (int b = 0; b < 2; ++b)
#pragma unroll
                for (int m = 0; m < 4; ++m)
#pragma unroll
                    for (int n = 0; n < 2; ++n) acc[a][b][m][n] = (f32x4){0.f, 0.f, 0.f, 0.f};
        cur = nxt; cA = nA; cB = nB; ++ui;
        if constexpr (ALIGN_EPI) { if (wr == 1) PG8_BAR; }
    }
    PG8_WAIT_V(0);
    if constexpr (!ALIGN_EPI) { if (wr == 0) PG8_BAR; }
    PG8_BAR;
#undef PG8_SA
#undef PG8_SB
#undef PG8_STAGE
#undef PG8_LDA
#undef PG8_LDB
#undef PG8_MMA
#undef PG8_WAIT_V
#undef PG8_WAIT_L
#undef PG8_BAR
#undef PG8_SCHED
#undef PG8_TP
}
}

constexpr int BATCH = 8, SEQ = 4096, D = 1024, M = BATCH * SEQ;
constexpr int IN_WIDTH = 9736, NPROJ = 9728;
constexpr int COL_MI = 7680;
constexpr int AH = 16, AKV = 4, AHD = 64, WINDOW = 128;
constexpr int MH = 4, MHD = 256;
constexpr float EPS = 1e-6f;
constexpr int NWAVES = 8;

constexpr size_t MiB = 1u << 20;
constexpr size_t WS_CTL = 0, CTL_ZERO_BYTES = 1 * MiB;
constexpr size_t WS_MOD = 512 * 1024;
constexpr size_t WS_WIN = 1 * MiB;
constexpr size_t WS_NCK = 1 * MiB, WS_MCK = 2 * MiB, WS_UN = 3 * MiB, WS_UST = 4 * MiB;
constexpr size_t WS_PART = 10 * MiB;
constexpr size_t WS_WATT = 20 * MiB, WS_WM = 22 * MiB, WS_WOUT = 24 * MiB;
constexpr size_t WS_IG = 26 * MiB, WS_LF = WS_IG + 512 * 1024;
constexpr size_t WS_K = 27 * MiB, WS_V = 43 * MiB;
constexpr size_t WS_XN = 60 * MiB;
constexpr size_t WS_Q = 124 * MiB;
constexpr size_t WS_AZ = 188 * MiB;
constexpr size_t WS_MQ = 252 * MiB, WS_MK = 316 * MiB;
constexpr size_t WS_MV = 380 * MiB;
constexpr size_t WS_KC = WS_XN;
constexpr size_t WS_OG = 444 * MiB;
constexpr size_t WS_HALO = 508 * MiB;
constexpr size_t WS_END = 511 * MiB;
constexpr size_t WS_RSUM = 64 * 1024;
constexpr size_t WS_PCNT = 192 * 1024;
constexpr int CW_BAR = 4096;

constexpr int RING_OFF = 0, RING_BYTES = 131072;
constexpr int LDS_BYTES = 163840;
constexpr int LDSCTL_OFF = LDS_BYTES - 1024, MISC_OFF = LDSCTL_OFF + 320;

#define GAS __attribute__((address_space(1)))
#define LAS __attribute__((address_space(3)))
typedef unsigned short bf16;
typedef unsigned v4u __attribute__((ext_vector_type(4)));
typedef unsigned v2u __attribute__((ext_vector_type(2)));
typedef float f32x4 __attribute__((ext_vector_type(4)));
typedef short bf16x8 __attribute__((ext_vector_type(8)));
typedef GAS unsigned gu32;
#define RLX_AGENT __ATOMIC_RELAXED, __HIP_MEMORY_SCOPE_AGENT
#define LDS_WAIT() asm volatile("s_waitcnt lgkmcnt(0)" ::: "memory")
#define VM_WAIT() asm volatile("s_waitcnt vmcnt(0)" ::: "memory")
__device__ __forceinline__ unsigned f2bf(float f) { unsigned u = __builtin_bit_cast(unsigned, f); return (u + 0x7fffu + ((u >> 16) & 1u)) >> 16; }
__device__ __forceinline__ unsigned pk2(float lo, float hi) { return f2bf(lo) | (f2bf(hi) << 16); }
__device__ __forceinline__ float bf2f(bf16 v) { return __builtin_bit_cast(float, (unsigned)v << 16); }

#define XB_TMO      128
#define XB_XCNT(j)  (256  + 64 * (j))
#define XB_XSUB(j)  (1280 + 64 * (j))
#define XB_XGEN(j)  (2304 + 64 * (j))
#define XB_TOP      3328
#define XB_TOPGEN   3392
#define XCD_BAR_WORDS 3456
#define XB_SPIN_CAP (1u << 18)

__device__ __forceinline__ unsigned xb_ld(unsigned* p)              { return __hip_atomic_load(p, __ATOMIC_RELAXED, __HIP_MEMORY_SCOPE_AGENT); }
__device__ __forceinline__ unsigned xb_add(unsigned* p, unsigned v) { return __hip_atomic_fetch_add(p, v, __ATOMIC_RELAXED, __HIP_MEMORY_SCOPE_AGENT); }
__device__ __forceinline__ unsigned xb_xcc_id() { return (unsigned)__builtin_amdgcn_s_getreg((3 << 11) | 20) & 0xFu; }
#define XB_SPIN(cond, bar) do { unsigned _sp = 0; while (cond) { __builtin_amdgcn_s_sleep(1); \
    if ((++_sp & 255u) == 0u) { if (xb_ld(&(bar)[XB_TMO])) break; if (_sp > XB_SPIN_CAP) { atomicAdd(&(bar)[XB_TMO], 1u); break; } } } } while (0)

struct XcdBarrier {
    unsigned* bar; unsigned x;
    volatile LAS unsigned* st;
};
__device__ __forceinline__ XcdBarrier xcd_barrier_post(unsigned* bar, volatile LAS unsigned* st) {
    XcdBarrier b; b.bar = bar; b.x = xb_xcc_id(); b.st = st;
    if (threadIdx.x == 0) (void)xb_add(&bar[XB_XCNT(b.x)], 1u);
    return b;
}
__device__ __forceinline__ void xcd_barrier_complete(unsigned* bar, unsigned x, unsigned& nloc, unsigned& nx) {
    const unsigned G = gridDim.x * gridDim.y * gridDim.z;
    unsigned sum, cnt, mine, sp = 0u;
    for (;;) {
        sum = 0u; cnt = 0u; mine = 0u;
#pragma unroll
        for (unsigned j = 0; j < 16; ++j) { const unsigned c = xb_ld(&bar[XB_XCNT(j)]); sum += c; cnt += (c > 0u) ? 1u : 0u; mine = (j == x) ? c : mine; }
        if (sum == G) break;
        __builtin_amdgcn_s_sleep(1);
        if ((++sp & 255u) == 0u) { if (xb_ld(&bar[XB_TMO])) break; if (sp > XB_SPIN_CAP) { atomicAdd(&bar[XB_TMO], 1u); break; } }
    }
    nloc = mine > 0u ? mine : 1u; nx = cnt > 0u ? cnt : 1u;
}
__device__ __forceinline__ void xcd_barrier(const XcdBarrier& b) {
    asm volatile("s_waitcnt vmcnt(0)" ::: "memory");
    __syncthreads();
    if (threadIdx.x == 0) {
        unsigned* bar = b.bar;
        __builtin_amdgcn_s_waitcnt(0);
        unsigned nloc = b.st[0], nx = b.st[1];
        if (nloc == 0u) { xcd_barrier_complete(bar, b.x, nloc, nx); b.st[0] = nloc; b.st[1] = nx; }
        const unsigned old = xb_add(&bar[XB_XSUB(b.x)], 1u);
        const unsigned gen = old / nloc;
        if (old + 1u == (gen + 1u) * nloc) {
            __builtin_amdgcn_fence(__ATOMIC_RELEASE, "agent");
            asm volatile("s_waitcnt vmcnt(0)" ::: "memory");
            const unsigned og = xb_add(&bar[XB_TOP], 1u);
            const unsigned tg = og / nx;
            if (og + 1u == (tg + 1u) * nx) xb_add(&bar[XB_TOPGEN], 1u);
            else XB_SPIN(xb_ld(&bar[XB_TOPGEN]) == tg, bar);
            __builtin_amdgcn_fence(__ATOMIC_ACQUIRE, "agent");
            xb_add(&bar[XB_XGEN(b.x)], 1u);
            asm volatile("s_waitcnt vmcnt(0)" ::: "memory");
        } else {
            XB_SPIN(xb_ld(&bar[XB_XGEN(b.x)]) == gen, bar);
            __builtin_amdgcn_fence(__ATOMIC_ACQUIRE, "agent");
            asm volatile("s_waitcnt vmcnt(0)" ::: "memory");
        }
    }
    __syncthreads();
}

__device__ __forceinline__ void xcd_rendezvous(const XcdBarrier& b) {
    asm volatile("s_waitcnt vmcnt(0)" ::: "memory");
    __syncthreads();
    if (threadIdx.x == 0) {
        unsigned* bar = b.bar;
        __builtin_amdgcn_s_waitcnt(0);
        unsigned nloc = b.st[0], nx = b.st[1];
        if (nloc == 0u) { xcd_barrier_complete(bar, b.x, nloc, nx); b.st[0] = nloc; b.st[1] = nx; }
        const unsigned old = xb_add(&bar[XB_XSUB(b.x)], 1u);
        const unsigned gen = old / nloc;
        if (old + 1u == (gen + 1u) * nloc) {
            const unsigned og = xb_add(&bar[XB_TOP], 1u);
            const unsigned tg = og / nx;
            if (og + 1u == (tg + 1u) * nx) xb_add(&bar[XB_TOPGEN], 1u);
            else XB_SPIN(xb_ld(&bar[XB_TOPGEN]) == tg, bar);
            xb_add(&bar[XB_XGEN(b.x)], 1u);
            asm volatile("s_waitcnt vmcnt(0)" ::: "memory");
        } else {
            XB_SPIN(xb_ld(&bar[XB_XGEN(b.x)]) == gen, bar);
        }
    }
    __syncthreads();
}

struct Frame {
    LAS unsigned char* lds;
    volatile LAS unsigned* MISC;
    gu32* ctl;
    int tid, lane, wave;
    int vcu, G;
};

__device__ __forceinline__ int win_src_col(int n) {
    if (n < 1280) { const int hb = n & ~63, j = n & 63; return hb + (j >> 1) + 32 * (j & 1); }
    if (n < 5632) return n;
    if (n < 7680) { const int idx = n - 5632; return ((idx & 1) ? 6656 : 5632) + (idx >> 1); }
    return n + 8;
}
template <bool MAP>
__device__ __forceinline__ void p0_transpose_item(const float* W, int K, int Nsrc, int ndst, bf16* WT, LAS float* scr, int item, int lane) {
    const int nblk = ndst / 32, kb = item / nblk, nb = item % nblk, k0 = 64 * kb, n0 = 32 * nb;
    const int sc = MAP ? win_src_col(n0 + (lane & 31)) : n0 + (lane & 31);
    float v[32];
#pragma unroll
    for (int i = 0; i < 32; ++i) v[i] = W[(size_t)(k0 + 2 * i + (lane >> 5)) * Nsrc + sc];
#pragma unroll
    for (int i = 0; i < 32; ++i) scr[(2 * i + (lane >> 5)) * 33 + (lane & 31)] = v[i];
    LDS_WAIT(); asm volatile("" ::: "memory");
    const int c = lane & 7;
#pragma unroll
    for (int j = 0; j < 4; ++j) { const int n = (lane >> 3) + 8 * j; const LAS float* s = scr + (8 * c) * 33 + n;
        v4u o; o.x = pk2(s[0 * 33], s[1 * 33]); o.y = pk2(s[2 * 33], s[3 * 33]); o.z = pk2(s[4 * 33], s[5 * 33]); o.w = pk2(s[6 * 33], s[7 * 33]);
        *(GAS v4u*)(WT + (size_t)(n0 + n) * K + k0 + 8 * c) = o; }
    LDS_WAIT(); asm volatile("" ::: "memory");
}

struct Args {
    const float* x; const float* c; const int* pos; const float* w_ada; const float* b_ada; const float* norm_w; const float* w_in; const float* b_if;
    const float* sinks; const float* conv_q; const float* conv_k; const float* m_norm_w; const float* w_att; const float* w_m; const float* w_out; const float* fnorm_w;
    float* out; unsigned char* ws; int ph_lo, ph_hi, li, pad;
};

__device__ __forceinline__ void p0_prologue(Frame& F, const Args& a) {
    LAS float* scr = (LAS float*)(F.lds + RING_OFF + F.wave * 16384);
    const int gw = F.vcu * NWAVES + F.wave, NGW = F.G * NWAVES;
    float* mod = (float*)(a.ws + WS_MOD);
    constexpr int I_ADA = 48 * 32;
    for (int r = gw; r < I_ADA; r += NGW) {
        const int cg = r >> 5, ks = r & 31, n = cg * 64 + F.lane, k0 = ks * 32;
#pragma unroll
        for (int j = 0; j < 4; ++j) { const int idx = F.lane + 64 * j, b = idx >> 5, kk = idx & 31; const float cv = a.c[b * D + k0 + kk]; scr[idx] = cv / (1.0f + __expf(-cv)); }
        LDS_WAIT(); asm volatile("" ::: "memory");
        float s[8] = {0.f, 0.f, 0.f, 0.f, 0.f, 0.f, 0.f, 0.f};
#pragma unroll 8
        for (int kk = 0; kk < 32; ++kk) { const float w = a.w_ada[(size_t)(k0 + kk) * 3072 + n];
#pragma unroll
            for (int b = 0; b < 8; ++b) s[b] += scr[b * 32 + kk] * w; }
#pragma unroll
        for (int b = 0; b < 8; ++b) atomicAdd(mod + b * 3072 + n, s[b]);
        LDS_WAIT(); asm volatile("" ::: "memory");
    }
}
__device__ __forceinline__ void weight_copies(Frame& F, const Args& a) {
    LAS float* scr = (LAS float*)(F.lds + RING_OFF + F.wave * 16384);
    const int gw = F.vcu * NWAVES + F.wave, NGW = F.G * NWAVES;
    bf16* WIN = (bf16*)(a.ws + WS_WIN); bf16* WATT = (bf16*)(a.ws + WS_WATT); bf16* WM = (bf16*)(a.ws + WS_WM); bf16* WOUT = (bf16*)(a.ws + WS_WOUT);
    constexpr int I_IN = (D / 64) * (NPROJ / 32), I_SQ = (D / 64) * (D / 32);
    constexpr int NITEMS = I_IN + 3 * I_SQ;
    for (int it = NGW - 1 - gw; it < NITEMS; it += NGW) {
        int r = it;
        if (r < I_IN) { p0_transpose_item<true>(a.w_in, D, IN_WIDTH, NPROJ, WIN, scr, r, F.lane); continue; } r -= I_IN;
        if (r < I_SQ) { p0_transpose_item<false>(a.w_att, D, D, D, WATT, scr, r, F.lane); continue; } r -= I_SQ;
        if (r < I_SQ) { p0_transpose_item<false>(a.w_m, D, D, D, WM, scr, r, F.lane); continue; } r -= I_SQ;
        p0_transpose_item<false>(a.w_out, D, D, D, WOUT, scr, r, F.lane);
    }
}

typedef float p1f2 __attribute__((ext_vector_type(2)));
__device__ __forceinline__ void p1_norm(Frame& F, const Args& a) {
    LAS float* wg = (LAS float*)(F.lds + RING_OFF);
    for (int k = F.tid; k < D; k += NWAVES * 64) { const f32x4* s = (const f32x4*)(a.w_in + (size_t)k * IN_WIDTH + COL_MI); const int j = k >> 8, ln = (k & 255) >> 2, e = k & 3;
        *(LAS f32x4*)(wg + (((j * 4 + e) * 2 + 0) * 64 + ln) * 4) = s[0]; *(LAS f32x4*)(wg + (((j * 4 + e) * 2 + 1) * 64 + ln) * 4) = s[1]; }
    const float* mod = (const float*)(a.ws + WS_MOD);
    LAS float* tca = wg + 8192; LAS float* tcc = tca + 8192;
    for (int i = F.tid; i < BATCH * 256; i += NWAVES * 64) { const int b = i >> 8, k = (i & 255) * 4;
        const f32x4 nw = *(const f32x4*)(a.norm_w + k);
        const f32x4 sh = *(const f32x4*)(mod + b * 3072 + k) + *(const f32x4*)(a.b_ada + k);
        const f32x4 sc = *(const f32x4*)(mod + b * 3072 + 1024 + k) + *(const f32x4*)(a.b_ada + 1024 + k);
        *(LAS f32x4*)(tca + b * 1024 + k) = nw * (sc + 1.0f); *(LAS f32x4*)(tcc + b * 1024 + k) = sh; }
    __syncthreads();
    bf16* XN = (bf16*)(a.ws + WS_XN); float* IG = (float*)(a.ws + WS_IG); float* LF = (float*)(a.ws + WS_LF);
    const int gw = F.vcu * NWAVES + F.wave, NGW = F.G * NWAVES;
    constexpr int GR = 2;
    {
        const int NG = M / GR;
        f32x4 vbuf[GR][4], vbuf2[GR][4];
#pragma unroll
        for (int q = 0; q < GR; ++q)
#pragma unroll
            for (int j = 0; j < 4; ++j) { vbuf[q][j] = (f32x4){0.f, 0.f, 0.f, 0.f}; vbuf2[q][j] = vbuf[q][j]; }
        if (gw < NG) {
#pragma unroll
            for (int q = 0; q < GR; ++q) { const GAS f32x4* xr = (const GAS f32x4*)(a.x + (size_t)(gw * GR + q) * D) + F.lane;
#pragma unroll
                for (int j = 0; j < 4; ++j) vbuf[q][j] = __builtin_nontemporal_load(xr + 64 * j); } }
        if (gw + NGW < NG) {
#pragma unroll
            for (int q = 0; q < GR; ++q) { const GAS f32x4* xr = (const GAS f32x4*)(a.x + (size_t)((gw + NGW) * GR + q) * D) + F.lane;
#pragma unroll
                for (int j = 0; j < 4; ++j) vbuf2[q][j] = __builtin_nontemporal_load(xr + 64 * j); } }
#pragma unroll 1
        for (int grp = gw; grp < NG; grp += NGW) {
            int rowg = grp * GR; asm volatile("" : "+s"(rowg));
            const int b = rowg >> 12;
            f32x4 vcur[GR][4];
#pragma unroll
            for (int q = 0; q < GR; ++q)
#pragma unroll
                for (int j = 0; j < 4; ++j) { vcur[q][j] = vbuf[q][j]; vbuf[q][j] = vbuf2[q][j]; }
            if (grp + 2 * NGW < NG) {
#pragma unroll
                for (int q = 0; q < GR; ++q) { const GAS f32x4* xr = (const GAS f32x4*)(a.x + (size_t)((grp + 2 * NGW) * GR + q) * D) + F.lane;
#pragma unroll
                    for (int j = 0; j < 4; ++j) vbuf2[q][j] = __builtin_nontemporal_load(xr + 64 * j); } }
            float rstd[GR];
#pragma unroll
            for (int q = 0; q < GR; ++q) { float s2 = 0.f;
#pragma unroll
                for (int j = 0; j < 4; ++j) { const f32x4 v = vcur[q][j]; s2 += (v.x * v.x + v.y * v.y) + (v.z * v.z + v.w * v.w); }
                rstd[q] = __builtin_amdgcn_rsqf(wave_sum(s2) * (1.f / D) + EPS); }
            p1f2 g[GR][4];
#pragma unroll
            for (int q = 0; q < GR; ++q)
#pragma unroll
                for (int i = 0; i < 4; ++i) g[q][i] = (p1f2){0.f, 0.f};
#pragma unroll
            for (int j = 0; j < 4; ++j) { f32x4 h[GR]; const f32x4 caj = *(const LAS f32x4*)(tca + b * 1024 + 256 * j + 4 * F.lane), ccj = *(const LAS f32x4*)(tcc + b * 1024 + 256 * j + 4 * F.lane);
#pragma unroll
                for (int q = 0; q < GR; ++q) { h[q] = vcur[q][j] * rstd[q] * caj + ccj;
                    v2u o; o.x = pg8::cvt_pk_bf16(h[q].x, h[q].y); o.y = pg8::cvt_pk_bf16(h[q].z, h[q].w); ((GAS v2u*)(XN + (size_t)(rowg + q) * D) + F.lane)[64 * j] = o; }
#pragma unroll
                for (int e = 0; e < 4; ++e) { const f32x4 w0 = *(const LAS f32x4*)(wg + (((j * 4 + e) * 2 + 0) * 64 + F.lane) * 4), w1 = *(const LAS f32x4*)(wg + (((j * 4 + e) * 2 + 1) * 64 + F.lane) * 4);
                    const p1f2 wa = {w0.x, w0.y}, wb = {w0.z, w0.w}, wc = {w1.x, w1.y}, wd = {w1.z, w1.w};
#pragma unroll
                    for (int q = 0; q < GR; ++q) { const float hv = h[q][e]; g[q][0] += hv * wa; g[q][1] += hv * wb; g[q][2] += hv * wc; g[q][3] += hv * wd; } } }
#pragma unroll
            for (int q = 0; q < GR; ++q) {
                const int row = rowg + q;
                float h4[4];
#pragma unroll
                for (int i = 0; i < 4; ++i) { float aa = g[q][i >> 1][i & 1], bb = g[q][2 + (i >> 1)][i & 1]; asm volatile("s_nop 1\n\tv_permlane32_swap_b32 %0, %1" : "+v"(aa), "+v"(bb)); h4[i] = aa + bb; }
                float u0, u1;
                { float aa = h4[0], bb = h4[2]; asm volatile("s_nop 1\n\tv_permlane16_swap_b32 %0, %1" : "+v"(aa), "+v"(bb)); u0 = aa + bb; }
                { float aa = h4[1], bb = h4[3]; asm volatile("s_nop 1\n\tv_permlane16_swap_b32 %0, %1" : "+v"(aa), "+v"(bb)); u1 = aa + bb; }
                u0 += dppf<0x128>(u0); u1 += dppf<0x128>(u1);
                float val = (F.lane & 8) ? u1 : u0;
                val += dppf<0x141>(val); val += dppf<0xB1>(val); val += dppf<0x4E>(val);
                const int gi = 4 * (F.lane >> 5) + 2 * ((F.lane >> 4) & 1) + ((F.lane >> 3) & 1);
                val += a.b_if[gi];
                if ((F.lane & 7) == 0) {
                    if (gi < 4) IG[((size_t)b * MH + gi) * SEQ + (row & (SEQ - 1))] = val;
                    else LF[((size_t)b * MH + (gi - 4)) * SEQ + (row & (SEQ - 1))] = fminf(val, 0.f) - __logf(1.0f + __expf(-fabsf(val))); }
            }
        }
    }
}


typedef float f32x16 __attribute__((ext_vector_type(16)));
typedef short s16x4 __attribute__((ext_vector_type(4)));
__device__ __forceinline__ int crow(int r, int hi) { return (r & 3) + 8 * (r >> 2) + 4 * hi; }
constexpr int ATT_VT_OFF = 32768, ATT_VT_PITCH = 520;
__device__ __forceinline__ void attn_phase(Frame& F, const Args& a, const int nostore = 0) {
    const bf16* Q = (const bf16*)(a.ws + WS_Q); const bf16* K = (const bf16*)(a.ws + WS_K); const bf16* V = (const bf16*)(a.ws + WS_V); bf16* AZ = (bf16*)(a.ws + WS_AZ);
    constexpr int ATT_BUF = ATT_VT_OFF + 64 * ATT_VT_PITCH;
    static_assert(2 * ATT_BUF <= LDSCTL_OFF, "attention LDS");
    const int tid = F.tid, lane = F.lane, w = F.wave, q32 = lane & 31, hi = lane >> 5;
    const int kp = tid >> 2, dq = tid & 3;
    v4u kreg[4], va0, va1, vb0, vb1;
#define AT_LOAD(uid_) do { int tid = F.tid; asm volatile("" : "+v"(tid)); const int kp = tid >> 2, dq = tid & 3; const int b_ = (uid_) >> 7, kvh_ = ((uid_) >> 5) & 3, qb_ = (uid_) & 31; const long f0_ = (long)b_ * SEQ + qb_ * 128 - 128; \
        _Pragma("unroll") for (int j = 0; j < 4; ++j) { const int idx = tid + 512 * j, key = idx >> 3, c = idx & 7; kreg[j] = (v4u){0u, 0u, 0u, 0u}; \
            if (qb_ > 0 || key >= 128) kreg[j] = *(const v4u*)(K + (f0_ + key) * 256 + kvh_ * 64 + c * 8); } \
        va0 = (v4u){0u, 0u, 0u, 0u}; va1 = va0; vb0 = va0; vb1 = va0; \
        if (qb_ > 0 || kp >= 64) { const bf16* p = V + (f0_ + 2 * kp) * 256 + kvh_ * 64 + dq * 16; va0 = *(const v4u*)p; va1 = *(const v4u*)(p + 8); vb0 = *(const v4u*)(p + 256); vb1 = *(const v4u*)(p + 264); } } while (0)
    bf16x8 qn[4];
#define AT_QLOAD(uid_) do { const int b_ = (uid_) >> 7, kvh_ = ((uid_) >> 5) & 3, qb_ = (uid_) & 31; int ln_ = F.lane; asm volatile("" : "+v"(ln_)); \
        const long qrow_ = (long)b_ * SEQ + qb_ * 128 + (w & 1) * 64 + (ln_ & 31); \
        _Pragma("unroll") for (int s = 0; s < 4; ++s) qn[s] = *(const bf16x8*)(Q + qrow_ * 1024 + (kvh_ * 4 + (w >> 1)) * 64 + 16 * s + 8 * (ln_ >> 5)); } while (0)
#define AT_STAGE(par_) do { LAS unsigned char* Ks_ = F.lds + (par_) * ATT_BUF; LAS unsigned char* Vt_ = Ks_ + ATT_VT_OFF; int ts_ = F.tid; asm volatile("" : "+v"(ts_)); const int kp_ = ts_ >> 2, dq_ = ts_ & 3; \
        _Pragma("unroll") for (int j = 0; j < 4; ++j) { const int idx = ts_ + 512 * j, key = idx >> 3, c = idx & 7; *(LAS v4u*)(Ks_ + key * 128 + ((c ^ (key & 7)) << 4)) = kreg[j]; } \
        LAS unsigned char* dst = Vt_ + (16 * dq_) * ATT_VT_PITCH + kp_ * 4; \
        AT_VTW(0, va0.x, vb0.x); AT_VTW(2, va0.y, vb0.y); AT_VTW(4, va0.z, vb0.z); AT_VTW(6, va0.w, vb0.w); AT_VTW(8, va1.x, vb1.x); AT_VTW(10, va1.y, vb1.y); AT_VTW(12, va1.z, vb1.z); AT_VTW(14, va1.w, vb1.w); } while (0)
#define AT_VTW(e, x, y) *(LAS unsigned*)(dst + (e) * ATT_VT_PITCH) = ((x) & 0xffffu) | ((y) << 16); *(LAS unsigned*)(dst + ((e) + 1) * ATT_VT_PITCH) = ((x) >> 16) | ((y) & 0xffff0000u)
    const int uid0 = F.vcu;
    __syncthreads();
    if (uid0 < BATCH * AKV * 32) { AT_LOAD(uid0); AT_QLOAD(uid0); AT_STAGE(0); }
    __syncthreads();
    int par = 0;
    for (int uid = uid0; uid < BATCH * AKV * 32; uid += F.G) {
        const int b = uid >> 7, kvh = (uid >> 5) & 3, qblk = uid & 31;
        const int head = kvh * 4 + (w >> 1);
        LAS unsigned char* Ks = F.lds + par * ATT_BUF; LAS unsigned char* Vt = Ks + ATT_VT_OFF;
        bf16x8 qf[2][4];
        { const long qrow1 = (long)b * SEQ + qblk * 128 + (w & 1) * 64 + 32 + q32;
#pragma unroll
            for (int s = 0; s < 4; ++s) { qf[0][s] = qn[s]; qf[1][s] = *(const bf16x8*)(Q + qrow1 * 1024 + head * 64 + 16 * s + 8 * hi); } }
        { const int nuid = uid + F.G; if (nuid < BATCH * AKV * 32) AT_LOAD(nuid); }
        { const int nuid = uid + F.G; if (nuid < BATCH * AKV * 32) AT_QLOAD(nuid); }
        const float sink2 = a.sinks[head] * 1.4426950408889634f;
#pragma unroll
        for (int sb = 0; sb < 2; ++sb) {
            const int r0 = (w & 1) * 64 + sb * 32, kt0 = r0 >> 5, rq = r0 + q32;
            const long qrow = (long)b * SEQ + qblk * 128 + rq;
            v2u zz[8];
#pragma unroll
            for (int i = 0; i < 8; ++i) zz[i] = *(const v2u*)(AZ + qrow * 1024 + head * 64 + 4 * hi + (i >> 2) * 32 + 8 * (i & 3));
            f32x16 p[5];
#pragma unroll
            for (int kt = 0; kt < 5; ++kt) { const int key = 32 * (kt0 + kt) + q32; f32x16 acc = {};
#pragma unroll
                for (int s = 0; s < 4; ++s) { const bf16x8 kf = *(const LAS bf16x8*)(Ks + key * 128 + (((2 * s + hi) ^ (key & 7)) << 4)); acc = __builtin_amdgcn_mfma_f32_32x32x16_bf16(kf, qf[sb][s], acc, 0, 0, 0); }
                p[kt] = acc; }
            float mx = sink2;
#pragma unroll
            for (int r = 0; r < 16; ++r) { p[0][r] = (crow(r, hi) > q32) ? p[0][r] : -INFINITY; p[4][r] = (crow(r, hi) <= q32) ? p[4][r] : -INFINITY; }
            if (qblk == 0) {
#pragma unroll
                for (int kt = 0; kt < 4; ++kt) if (kt0 + kt < 4) {
#pragma unroll
                    for (int r = 0; r < 16; ++r) p[kt][r] = -INFINITY; } }
#pragma unroll
            for (int kt = 0; kt < 5; ++kt)
#pragma unroll
                for (int r = 0; r < 16; ++r) mx = fmaxf(mx, p[kt][r]);
            mx = xor32_max(mx);
            float l;
            { typedef float at_f2 __attribute__((ext_vector_type(2)));
                const at_f2 mx2 = {mx, mx}; at_f2 l2 = {0.f, 0.f};
#pragma unroll
                for (int kt = 0; kt < 5; ++kt)
#pragma unroll
                    for (int r = 0; r < 16; r += 2) { at_f2 v = {p[kt][r], p[kt][r + 1]}; v = v - mx2; const at_f2 e = {__builtin_amdgcn_exp2f(v.x), __builtin_amdgcn_exp2f(v.y)}; p[kt][r] = e.x; p[kt][r + 1] = e.y; l2 += e; }
                l = l2.x + l2.y; }
            l = xor32_sum(l) + __builtin_amdgcn_exp2f(sink2 - mx);
            f32x16 o[2] = {f32x16{}, f32x16{}};
#pragma unroll
            for (int kt = 0; kt < 5; ++kt)
#pragma unroll
                for (int s = 0; s < 2; ++s) { v4u pw; pw.x = pg8::cvt_pk_bf16(p[kt][8 * s + 0], p[kt][8 * s + 1]); pw.y = pg8::cvt_pk_bf16(p[kt][8 * s + 2], p[kt][8 * s + 3]);
                    pw.z = pg8::cvt_pk_bf16(p[kt][8 * s + 4], p[kt][8 * s + 5]); pw.w = pg8::cvt_pk_bf16(p[kt][8 * s + 6], p[kt][8 * s + 7]);
                    const bf16x8 pb = __builtin_bit_cast(bf16x8, pw); const int kb = 32 * (kt0 + kt) + 16 * s + 4 * hi;
#pragma unroll
                    for (int dt = 0; dt < 2; ++dt) { const LAS unsigned char* vp = Vt + (dt * 32 + q32) * ATT_VT_PITCH + kb * 2;
                        const s16x4 v0 = *(const LAS s16x4*)vp, v1 = *(const LAS s16x4*)(vp + 16);
                        const bf16x8 vf = (bf16x8){v0[0], v0[1], v0[2], v0[3], v1[0], v1[1], v1[2], v1[3]};
                        o[dt] = __builtin_amdgcn_mfma_f32_32x32x16_bf16(vf, pb, o[dt], 0, 0, 0); } }
            const float rl = 1.0f / l; bf16* ap = AZ + qrow * 1024 + head * 64 + 4 * hi;
#pragma unroll
            for (int dt = 0; dt < 2; ++dt)
#pragma unroll
                for (int g = 0; g < 4; ++g) { bf16* pp = ap + dt * 32 + 8 * g; const v2u z = zz[dt * 4 + g]; v2u ov;
                    ov.x = pg8::cvt_pk_bf16(o[dt][4 * g + 0] * rl * pg8::bf_lo(z.x), o[dt][4 * g + 1] * rl * pg8::bf_hi(z.x));
                    ov.y = pg8::cvt_pk_bf16(o[dt][4 * g + 2] * rl * pg8::bf_lo(z.y), o[dt][4 * g + 3] * rl * pg8::bf_hi(z.y));
                    asm volatile("" :: "v"(ov.x), "v"(ov.y)); if (!nostore) *(v2u*)pp = ov; }
        }
        { const int nuid = uid + F.G; if (nuid < BATCH * AKV * 32) AT_STAGE(par ^ 1); }
        __syncthreads();
        par ^= 1;
    }
#undef AT_LOAD
#undef AT_STAGE
#undef AT_VTW
#undef AT_QLOAD
    __syncthreads();
}


constexpr int ML_PQ = 528, ML_PK2 = 576, ML_PS = 144, ML_PV = 80;
typedef short v4i16_t __attribute__((ext_vector_type(4)));
typedef __bf16 bf16x2_t __attribute__((ext_vector_type(2)));
__device__ __forceinline__ float dot2bf(unsigned a, unsigned b, float c) { return __builtin_amdgcn_fdot2_f32_bf16(__builtin_bit_cast(bf16x2_t, a), __builtin_bit_cast(bf16x2_t, b), c, false); }
__device__ __forceinline__ s16x4 lds_tr(const LAS unsigned char* p) { return __builtin_bit_cast(s16x4, __builtin_amdgcn_ds_read_tr16_b64_v4i16((LAS v4i16_t*)p)); }
constexpr int ML_TBL = 1536;
#define ML_GATES_T(T) do { const float bc = scan_sum64(lf_n, lane), u = ig_n - bc, pm = scan_max64(u, lane); \
            const float g = fmaxf(m_run, pm), g63 = lane_bcast(g, 63), bl = lane_bcast(bc, 63); \
            (T)[lane] = u; (T)[64 + lane] = g; { const float wv_ = __expf(u - g63); (T)[128 + lane] = wv_; ((LAS unsigned short*)((T) + 336))[lane] = (unsigned short)(pg8::cvt_pk_bf16(wv_, 0.f) & 0xffffu); } (T)[192 + lane] = __expf(m_run - g); (T)[256 + lane] = __expf(-(bc + g)); if (lane == 0) (T)[320] = __expf(m_run - g63); \
            m_run = bl + g63; } while (0)

constexpr int UP_K = 0, UP_V = UP_K + 2 * 64 * ML_PK2, UP_W = UP_V + 2 * 64 * ML_PK2, UP_WB = UP_W + 2048, UP_RED = UP_WB + 1024, UP_CW = UP_RED + 128, UP_END = UP_CW + 4096;
__device__ __forceinline__ void mlstm_usum_phase(Frame& F, const Args& a) {
    const bf16* MK = (const bf16*)(a.ws + WS_MK); bf16* KCO = (bf16*)(a.ws + WS_KC); const bf16* VH = (const bf16*)(a.ws + WS_MV);
    const float* IG = (const float*)(a.ws + WS_IG); const float* LF = (const float*)(a.ws + WS_LF);
    bf16* UK = (bf16*)(a.ws + WS_Q); float* UN = (float*)(a.ws + WS_UN); float* ST = (float*)(a.ws + WS_UST);
    LAS unsigned char* L = F.lds;
    const int w = F.wave;
    for (int uid = F.vcu; uid < BATCH * MH * 8; uid += F.G) {
        int t__ = F.tid; asm volatile("" : "+v"(t__)); const int tid = t__, lane = tid & 63, l31 = lane & 31, hi = lane >> 5;
        const int bh = uid >> 3, j = uid & 7, b = bh >> 2, h = bh & 3;
        const size_t rowb = (size_t)b * SEQ + (size_t)j * 512; const int colh = h * 256;
        v4u rk[7], rv[4];
#define UP_LOAD(c) do { int t_ = F.tid; asm volatile("" : "+v"(t_)); const int ss = t_ >> 3, cq = t_ & 7, c8 = t_ & 31, rg = t_ >> 5; (void)ss; (void)cq; (void)c8; (void)rg; unsigned o_ = (unsigned)((((c) * 64 + 4 * rg) * 1024 + colh + 8 * c8) * 2); asm volatile("" : "+v"(o_)); const char* k_ = (const char*)(MK + rowb * 1024) + o_; \
            _Pragma("unroll") for (int r = 0; r < 7; ++r) { rk[r] = (v4u){0u, 0u, 0u, 0u}; if (r >= 3 || j > 0 || (c) > 0 || rg > 0) rk[r] = *(const v4u*)(k_ + (r - 3) * 2048); } \
            unsigned ov_ = (unsigned)((((c) * 64 + ss) * 1024 + colh + 8 * cq) * 2); asm volatile("" : "+v"(ov_)); const char* v_ = (const char*)(VH + rowb * 1024) + ov_; \
            _Pragma("unroll") for (int i = 0; i < 4; ++i) rv[i] = __builtin_nontemporal_load((const v4u*)(v_ + 128 * i)); } while (0)
#define UP_LOADK(c) do { int t_ = F.tid; asm volatile("" : "+v"(t_)); const int c8 = t_ & 31, rg = t_ >> 5; unsigned o_ = (unsigned)((((c) * 64 + 4 * rg) * 1024 + colh + 8 * c8) * 2); asm volatile("" : "+v"(o_)); const char* k_ = (const char*)(MK + rowb * 1024) + o_; \
            _Pragma("unroll") for (int r = 0; r < 7; ++r) { rk[r] = (v4u){0u, 0u, 0u, 0u}; if (r >= 3 || j > 0 || (c) > 0 || rg > 0) rk[r] = *(const v4u*)(k_ + (r - 3) * 2048); } } while (0)
#define UP_SILU16(v) ((v) * pg8::sigmoidf_(v) * 0.0625f)
#define UP_CONV(kc) do { int t_ = F.tid; asm volatile("" : "+v"(t_)); const int c8 = t_ & 31; \
            _Pragma("unroll") for (int hf = 0; hf < 2; ++hf) {                  \
                f32x4 wt[4], sm[4]; \
                _Pragma("unroll") for (int t = 0; t < 4; ++t) { wt[t] = *(const LAS f32x4*)(L + UP_CW + (t * 256 + 8 * c8 + 4 * hf) * 4); sm[t] = (f32x4){0.f, 0.f, 0.f, 0.f}; } \
                _Pragma("unroll") for (int row = 0; row < 7; ++row) { const unsigned xa = hf ? rk[row].z : rk[row].x, xb = hf ? rk[row].w : rk[row].y; \
                    const f32x4 xv = (f32x4){pg8::bf_lo(xa), pg8::bf_hi(xa), pg8::bf_lo(xb), pg8::bf_hi(xb)}; \
                    _Pragma("unroll") for (int t = 0; t < 4; ++t) { const int r = row - t; if (r >= 0 && r < 4) sm[r] += wt[t] * xv; } } \
                _Pragma("unroll") for (int r = 0; r < 4; ++r) { const unsigned pa = pg8::cvt_pk_bf16(UP_SILU16(sm[r][0]), UP_SILU16(sm[r][1])), pb = pg8::cvt_pk_bf16(UP_SILU16(sm[r][2]), UP_SILU16(sm[r][3])); \
                    if (hf) { kc[r].z = pa; kc[r].w = pb; } else { kc[r].x = pa; kc[r].y = pb; } } \
                __builtin_amdgcn_sched_barrier(0); } } while (0)
#define UP_KOUT(kc, c) do { int t_ = F.tid; asm volatile("" : "+v"(t_)); const int ss = t_ >> 3, cq = t_ & 7, c8 = t_ & 31, rg = t_ >> 5; (void)ss; (void)cq; (void)c8; (void)rg; unsigned o_ = (unsigned)((((c) * 64 + 4 * rg) * 1024 + colh + 8 * c8) * 2); asm volatile("" : "+v"(o_)); char* k_ = (char*)(KCO + rowb * 1024) + o_; \
            _Pragma("unroll") for (int r = 0; r < 4; ++r) *(v4u*)(k_ + r * 2048) = kc[r]; } while (0)
        __syncthreads();
        { ((LAS float*)(L + UP_CW))[tid] = a.conv_k[(tid >> 8) * 1024 + colh + (tid & 255)]; ((LAS float*)(L + UP_CW))[tid + 512] = a.conv_k[((tid >> 8) + 2) * 1024 + colh + (tid & 255)]; }
        if (j == 7) {
            __syncthreads();
#pragma unroll 1
            for (int c = 0; c < 8; ++c) { UP_LOADK(c); v4u kc[4]; UP_CONV(kc); UP_KOUT(kc, c); }
            continue;
        }
#define UP_STAGE(bu, c) do { v4u kc[4]; UP_CONV(kc); UP_KOUT(kc, c); int t_ = F.tid; asm volatile("" : "+v"(t_)); const int ss = t_ >> 3, cq = t_ & 7, c8 = t_ & 31, rg = t_ >> 5; (void)ss; (void)cq; (void)c8; (void)rg; \
            _Pragma("unroll") for (int r = 0; r < 4; ++r) *(LAS v4u*)(L + UP_K + (bu) * 64 * ML_PK2 + (4 * rg + r) * ML_PK2 + 16 * c8) = kc[r]; \
            const float ws_ = ((const LAS float*)(L + UP_W))[(c) * 64 + ss]; \
            _Pragma("unroll") for (int i = 0; i < 4; ++i) { v4u x; \
                x.x = pg8::cvt_pk_bf16(pg8::bf_lo(rv[i].x) * ws_, pg8::bf_hi(rv[i].x) * ws_); x.y = pg8::cvt_pk_bf16(pg8::bf_lo(rv[i].y) * ws_, pg8::bf_hi(rv[i].y) * ws_); \
                x.z = pg8::cvt_pk_bf16(pg8::bf_lo(rv[i].z) * ws_, pg8::bf_hi(rv[i].z) * ws_); x.w = pg8::cvt_pk_bf16(pg8::bf_lo(rv[i].w) * ws_, pg8::bf_hi(rv[i].w) * ws_); \
                *(LAS v4u*)(L + UP_V + (bu) * 64 * ML_PK2 + ss * ML_PK2 + 16 * (cq + 8 * i)) = x; } } while (0)
        UP_LOAD(0);
        {
            const float lfv = LF[(size_t)bh * SEQ + j * 512 + tid], igv = IG[(size_t)bh * SEQ + j * 512 + tid];
            const float bc = scan_sum64(lfv, lane), tot = lane_bcast(bc, 63);
            LAS float* RED = (LAS float*)(L + UP_RED);
            if (lane == 0) RED[w] = tot;
            __syncthreads();
            float later = 0.f, gtot = 0.f;
#pragma unroll
            for (int c = 0; c < 8; ++c) { const float tc = RED[c]; gtot += tc; later += (c > w) ? tc : 0.f; }
            const float ls = (tot - bc) + later + igv;
            float mx = ls; mx = fmaxf(mx, dppf_id<0x111>(mx, -__builtin_inff())); mx = fmaxf(mx, dppf_id<0x112>(mx, -__builtin_inff())); mx = fmaxf(mx, dppf_id<0x114>(mx, -__builtin_inff())); mx = fmaxf(mx, dppf_id<0x118>(mx, -__builtin_inff()));
            const float wmax = fmaxf(fmaxf(lane_bcast(mx, 15), lane_bcast(mx, 31)), fmaxf(lane_bcast(mx, 47), lane_bcast(mx, 63)));
            if (lane == 0) RED[8 + w] = wmax;
            __syncthreads();
            float mp = RED[8];
#pragma unroll
            for (int c = 1; c < 8; ++c) mp = fmaxf(mp, RED[8 + c]);
            const float wv = __expf(ls - mp);
            ((LAS float*)(L + UP_W))[tid] = wv; ((LAS unsigned short*)(L + UP_WB))[tid] = (unsigned short)(pg8::cvt_pk_bf16(wv, 0.f) & 0xffffu);
            if (tid == 0) { ST[(bh * 8 + j) * 2] = gtot; ST[(bh * 8 + j) * 2 + 1] = mp; }
        }
        __syncthreads();
        UP_STAGE(0, 0); UP_LOAD(1);
        __syncthreads();
        f32x16 acc[8];
#pragma unroll
        for (int i = 0; i < 8; ++i) acc[i] = f32x16{};
        float nacc = 0.f;
#pragma unroll 1
        for (int c = 0; c < 8; ++c) {
            const int bu = c & 1;
            { int ln__ = F.lane; asm volatile("" : "+v"(ln__)); const int lane = ln__, hi = lane >> 5;
            float nsum = 0.f;
#pragma unroll
            for (int kk = 0; kk < 4; ++kk) {
                const LAS unsigned char* vp = L + UP_V + bu * 64 * ML_PK2 + (16 * kk + 8 * hi + ((lane & 15) >> 2)) * ML_PK2 + (32 * w + 16 * ((lane >> 4) & 1) + 4 * (lane & 3)) * 2;
                const s16x4 va = lds_tr(vp), vb = lds_tr(vp + 4 * ML_PK2); const bf16x8 vf = (bf16x8){va[0], va[1], va[2], va[3], vb[0], vb[1], vb[2], vb[3]};
#pragma unroll
                for (int i = 0; i < 8; ++i) { const LAS unsigned char* kp = L + UP_K + bu * 64 * ML_PK2 + (16 * kk + 8 * hi + ((lane & 15) >> 2)) * ML_PK2 + (32 * i + 16 * ((lane >> 4) & 1) + 4 * (lane & 3)) * 2;
                    const s16x4 ka = lds_tr(kp), kb = lds_tr(kp + 4 * ML_PK2); const bf16x8 kf = (bf16x8){ka[0], ka[1], ka[2], ka[3], kb[0], kb[1], kb[2], kb[3]};
                    acc[i] = __builtin_amdgcn_mfma_f32_32x32x16_bf16(kf, vf, acc[i], 0, 0, 0); }
                { const LAS unsigned char* kp = L + UP_K + bu * 64 * ML_PK2 + (16 * kk + 8 * hi + ((lane & 15) >> 2)) * ML_PK2 + (32 * w + 16 * ((lane >> 4) & 1) + 4 * (lane & 3)) * 2;
                    const s16x4 ka = lds_tr(kp), kb = lds_tr(kp + 4 * ML_PK2); const v4u kw = __builtin_bit_cast(v4u, (bf16x8){ka[0], ka[1], ka[2], ka[3], kb[0], kb[1], kb[2], kb[3]}), wq = *(const LAS v4u*)((const LAS unsigned short*)(L + UP_WB) + c * 64 + 16 * kk + 8 * hi);
                    nsum = dot2bf(kw.x, wq.x, nsum); nsum = dot2bf(kw.y, wq.y, nsum); nsum = dot2bf(kw.z, wq.z, nsum); nsum = dot2bf(kw.w, wq.w, nsum); } }
            nacc += xor32_sum(nsum); }
            if (c + 1 < 8) { UP_STAGE(bu ^ 1, c + 1); if (c + 2 < 8) UP_LOAD(c + 2); }
            __syncthreads();
        }
#undef UP_LOAD
#undef UP_LOADK
#undef UP_CONV
#undef UP_SILU16
#undef UP_KOUT
#undef UP_STAGE
        { bf16* up = UK + (size_t)(bh * 8 + j) * 65536 + (size_t)w * 8192 + lane * 8;
#pragma unroll
            for (int i = 0; i < 8; ++i)
#pragma unroll
                for (int hf = 0; hf < 2; ++hf) { v4u x; x.x = pg8::cvt_pk_bf16(acc[i][8 * hf + 0], acc[i][8 * hf + 1]); x.y = pg8::cvt_pk_bf16(acc[i][8 * hf + 2], acc[i][8 * hf + 3]);
                    x.z = pg8::cvt_pk_bf16(acc[i][8 * hf + 4], acc[i][8 * hf + 5]); x.w = pg8::cvt_pk_bf16(acc[i][8 * hf + 6], acc[i][8 * hf + 7]); *(v4u*)(up + (i * 2 + hf) * 512) = x; }
            if (hi == 0) UN[(size_t)(bh * 8 + j) * 256 + 32 * w + l31] = nacc; }
    }
}

__device__ __forceinline__ void mlstm_combine_phase(Frame& F, const Args& a) {
    const bf16* UK = (const bf16*)(a.ws + WS_Q); const float* UN = (const float*)(a.ws + WS_UN); const float* ST = (const float*)(a.ws + WS_UST);
    bf16* CK = (bf16*)(a.ws + WS_Q) + (size_t)32 * 8 * 65536; float* NCK = (float*)(a.ws + WS_NCK); float* MCK = (float*)(a.ws + WS_MCK);
    for (int blk = F.vcu; blk < 32 * 8; blk += F.G) {
        const int bh = blk >> 3, part = blk & 7;
        float ca[7], cb[7], m = 0.f;
#pragma unroll
        for (int j = 0; j < 7; ++j) { const float G = ST[(bh * 8 + j) * 2], mp = ST[(bh * 8 + j) * 2 + 1], mn = fmaxf(G + m, mp); ca[j] = __expf(G + m - mn); cb[j] = __expf(mp - mn); m = mn;
            if (part == 0 && F.tid == 0) MCK[bh * 8 + j + 1] = mn; }
#pragma unroll
        for (int q = 0; q < 2; ++q) { const size_t piece = (size_t)part * 1024 + q * 512 + F.tid;
            float c[8] = {0.f, 0.f, 0.f, 0.f, 0.f, 0.f, 0.f, 0.f};
            v4u uu[7];
#pragma unroll
            for (int j = 0; j < 7; ++j) uu[j] = __builtin_nontemporal_load((const v4u*)(UK + ((size_t)(bh * 8 + j) * 65536) + piece * 8));
#pragma unroll
            for (int j = 0; j < 7; ++j) { const v4u u = uu[j];
                c[0] = ca[j] * c[0] + cb[j] * pg8::bf_lo(u.x); c[1] = ca[j] * c[1] + cb[j] * pg8::bf_hi(u.x); c[2] = ca[j] * c[2] + cb[j] * pg8::bf_lo(u.y); c[3] = ca[j] * c[3] + cb[j] * pg8::bf_hi(u.y);
                c[4] = ca[j] * c[4] + cb[j] * pg8::bf_lo(u.z); c[5] = ca[j] * c[5] + cb[j] * pg8::bf_hi(u.z); c[6] = ca[j] * c[6] + cb[j] * pg8::bf_lo(u.w); c[7] = ca[j] * c[7] + cb[j] * pg8::bf_hi(u.w);
                v4u o; o.x = pg8::cvt_pk_bf16(c[0], c[1]); o.y = pg8::cvt_pk_bf16(c[2], c[3]); o.z = pg8::cvt_pk_bf16(c[4], c[5]); o.w = pg8::cvt_pk_bf16(c[6], c[7]);
                __builtin_nontemporal_store(o, (v4u*)(CK + ((size_t)(bh * 8 + j + 1) * 65536) + piece * 8)); } }
        if (part == 0 && F.tid < 256) { float nn = 0.f;
#pragma unroll
            for (int j = 0; j < 7; ++j) { nn = ca[j] * nn + cb[j] * UN[(size_t)(bh * 8 + j) * 256 + F.tid]; NCK[(size_t)(bh * 8 + j + 1) * 256 + F.tid] = nn; } }
    }
}

#define ML_LANES() int ln__ = F.lane, td__ = F.tid; asm volatile("" : "+v"(ln__), "+v"(td__)); const int lane = ln__, tid = td__, l15 = lane & 15, kq = lane >> 4, l31 = lane & 31, hi = lane >> 5, ss = tid >> 3, cq = tid & 7; (void)l15; (void)kq; (void)l31; (void)hi; (void)ss; (void)cq
constexpr int OU_QS = 0, OU_KS = OU_QS + 64 * ML_PQ, OU_VS = OU_KS + 64 * 512,
               OU_ST = OU_VS + 64 * ML_PK2, OU_NV = OU_ST + 64 * ML_PS, OU_GT = OU_NV + 1024, OU_RS = OU_GT + 2 * ML_TBL, OU_HT = OU_RS + 2 * 1024, OU_CW = OU_HT + 64 * ML_PQ, OU_END = OU_CW + 4096;
static_assert(OU_END <= LDSCTL_OFF && UP_END <= LDSCTL_OFF, "mLSTM LDS maps");
__device__ __forceinline__ void mlstm_out_phase(Frame& F, const Args& a, const int nostore = 0) {
    const bf16* MQ = (const bf16*)(a.ws + WS_MQ); const bf16* KC = (const bf16*)(a.ws + WS_KC); bf16* VH = (bf16*)(a.ws + WS_MV); const bf16* OG = (const bf16*)(a.ws + WS_OG);
    const float* IG = (const float*)(a.ws + WS_IG); const float* LF = (const float*)(a.ws + WS_LF);
    const bf16* CK = (const bf16*)(a.ws + WS_Q) + (size_t)32 * 8 * 65536; const float* NCK = (const float*)(a.ws + WS_NCK); const float* MCK = (const float*)(a.ws + WS_MCK);
    LAS unsigned char* L = F.lds;
    const int w = F.wave, ti = w >> 1, sh = (w ^ (w >> 2)) & 1;
    for (int uid = F.vcu; uid < BATCH * MH * 8; uid += F.G) {
        int t__ = F.tid; asm volatile("" : "+v"(t__)); const int tid = t__, lane = tid & 63, l15 = lane & 15, kq = lane >> 4, l31 = lane & 31, hi = lane >> 5; (void)l15; (void)kq;
        const int bh = uid >> 3, j = uid & 7, b = bh >> 2, h = bh & 3;
        const size_t rowb = (size_t)b * SEQ + (size_t)j * 512; const int colh = h * 256;
        const float* ig = IG + (size_t)bh * SEQ + j * 512; const float* lf = LF + (size_t)bh * SEQ + j * 512;
        const int ss = tid >> 3, cq = tid & 7;
        float m_run = (j > 0) ? MCK[bh * 8 + j] : 0.f, lf_n = 0.f, ig_n = 0.f;
        __syncthreads();
        unsigned Cp[8][8];
        { const bf16* ck = CK + (size_t)(bh * 8 + j) * 65536 + (size_t)w * 8192 + lane * 8;
#pragma unroll
            for (int i = 0; i < 8; ++i)
#pragma unroll
                for (int hf = 0; hf < 2; ++hf) { v4u x = (v4u){0u, 0u, 0u, 0u}; if (j > 0) x = *(const v4u*)(ck + (i * 2 + hf) * 512); Cp[i][4 * hf] = x.x; Cp[i][4 * hf + 1] = x.y; Cp[i][4 * hf + 2] = x.z; Cp[i][4 * hf + 3] = x.w; } }
        if (tid < 256) ((LAS float*)(L + OU_NV))[tid] = (j > 0) ? NCK[(size_t)(bh * 8 + j) * 256 + tid] : 0.f;
        if (tid < 512) ((LAS float*)(L + OU_RS))[tid] = 0.f;
#define OU_GLOAD(cc) do { if (w == 0) { lf_n = lf[(cc) * 64 + lane]; ig_n = ig[(cc) * 64 + lane]; } } while (0)
        v4u rq[7], rqc[4], rk[4], rv[4];
#define OU_LOAD(cc) do { int tl_ = F.tid; asm volatile("" : "+v"(tl_)); unsigned oq_ = (unsigned)((((cc) * 64 + 4 * (tl_ >> 5)) * 1024 + colh + 8 * (tl_ & 31)) * 2); asm volatile("" : "+v"(oq_)); const char* q_ = (const char*)(MQ + rowb * 1024) + oq_; \
            _Pragma("unroll") for (int r = 0; r < 7; ++r) { rq[r] = (v4u){0u, 0u, 0u, 0u}; if (r >= 3 || j > 0 || (cc) > 0 || (tl_ >> 5) > 0) rq[r] = *(const v4u*)(q_ + (r - 3) * 2048); } \
            unsigned o_ = (unsigned)((((cc) * 64 + (tl_ >> 3)) * 1024 + colh + 8 * (tl_ & 7)) * 2); asm volatile("" : "+v"(o_));     \
            const char* k_ = (const char*)(KC + rowb * 1024) + o_; const char* v_ = (const char*)(VH + rowb * 1024) + o_; \
            _Pragma("unroll") for (int i = 0; i < 4; ++i) { rk[i] = __builtin_nontemporal_load((const v4u*)(k_ + 128 * i)); rv[i] = __builtin_nontemporal_load((const v4u*)(v_ + 128 * i)); } } while (0)
#define OU_SILU(v) ((v) * pg8::sigmoidf_(v))
#define OU_QCONV() do { int t_ = F.tid; asm volatile("" : "+v"(t_)); const int c8_ = t_ & 31; \
            _Pragma("unroll") for (int hf = 0; hf < 2; ++hf) { f32x4 wt[4], sm[4]; \
                _Pragma("unroll") for (int t = 0; t < 4; ++t) { wt[t] = *(const LAS f32x4*)(L + OU_CW + (t * 256 + 8 * c8_ + 4 * hf) * 4); sm[t] = (f32x4){0.f, 0.f, 0.f, 0.f}; } \
                _Pragma("unroll") for (int row = 0; row < 7; ++row) { const unsigned xa = hf ? rq[row].z : rq[row].x, xb = hf ? rq[row].w : rq[row].y; \
                    const f32x4 xv = (f32x4){pg8::bf_lo(xa), pg8::bf_hi(xa), pg8::bf_lo(xb), pg8::bf_hi(xb)}; \
                    _Pragma("unroll") for (int t = 0; t < 4; ++t) { const int r = row - t; if (r >= 0 && r < 4) sm[r] += wt[t] * xv; } } \
                _Pragma("unroll") for (int r = 0; r < 4; ++r) { const unsigned pa = pg8::cvt_pk_bf16(OU_SILU(sm[r][0]), OU_SILU(sm[r][1])), pb = pg8::cvt_pk_bf16(OU_SILU(sm[r][2]), OU_SILU(sm[r][3])); \
                    if (hf) { rqc[r].z = pa; rqc[r].w = pb; } else { rqc[r].x = pa; rqc[r].y = pb; } } \
                __builtin_amdgcn_sched_barrier(0); } } while (0)
#define OU_STAGE() do { int ts_ = F.tid; asm volatile("" : "+v"(ts_)); const int ss_ = ts_ >> 3, cq_ = ts_ & 7, rg_ = ts_ >> 5, c8_ = ts_ & 31; \
            _Pragma("unroll") for (int r = 0; r < 4; ++r) *(LAS v4u*)(L + OU_QS + (4 * rg_ + r) * ML_PQ + 16 * c8_) = rqc[r]; \
            _Pragma("unroll") for (int i = 0; i < 4; ++i) { *(LAS v4u*)(L + OU_KS + ss_ * 512 + 16 * ((((cq_ + 8 * i) >> 2) ^ (ss_ & 3)) << 2 | ((cq_ + 8 * i) & 3))) = rk[i]; *(LAS v4u*)(L + OU_VS + ss_ * ML_PK2 + 16 * (cq_ + 8 * i)) = rv[i]; } } while (0)
        { ((LAS float*)(L + OU_CW))[tid] = a.conv_q[(tid >> 8) * 1024 + colh + (tid & 255)]; ((LAS float*)(L + OU_CW))[tid + 512] = a.conv_q[((tid >> 8) + 2) * 1024 + colh + (tid & 255)]; }
        OU_GLOAD(0); if (w == 0) { LAS float* T0 = (LAS float*)(L + OU_GT); ML_GATES_T(T0); } OU_GLOAD(1);
        OU_LOAD(0);
        __syncthreads();
        OU_QCONV(); OU_STAGE();
        __syncthreads();
#pragma unroll 1
        for (int cc = 0; cc < 8; ++cc) {
            const int tb = cc & 1; const LAS float* T = (const LAS float*)(L + OU_GT + tb * ML_TBL); LAS float* RS = (LAS float*)(L + OU_RS + tb * 1024);
            if (cc + 1 < 8) OU_LOAD(cc + 1);
            if (w == 0 && cc + 1 < 8) { LAS float* T1 = (LAS float*)(L + OU_GT + (tb ^ 1) * ML_TBL); ML_GATES_T(T1); if (cc + 2 < 8) OU_GLOAD(cc + 2); }
            {
                ML_LANES();
                f32x4 aS0 = {0.f, 0.f, 0.f, 0.f}, aS1 = aS0; float qn = 0.f;
#pragma unroll 2
                for (int kk = 0; kk < 8; ++kk) {
                    const bf16x8 qf = *(const LAS bf16x8*)(L + OU_QS + (16 * ti + l15) * ML_PQ + (32 * kk + 8 * kq) * 2);
                    const bf16x8 k0 = *(const LAS bf16x8*)(L + OU_KS + (32 * sh + l15) * 512 + ((kk ^ (l15 & 3)) << 6) + kq * 16);
                    const bf16x8 k1 = *(const LAS bf16x8*)(L + OU_KS + (32 * sh + 16 + l15) * 512 + ((kk ^ (l15 & 3)) << 6) + kq * 16);
                    aS0 = __builtin_amdgcn_mfma_f32_16x16x32_bf16(qf, k0, aS0, 0, 0, 0);
                    aS1 = __builtin_amdgcn_mfma_f32_16x16x32_bf16(qf, k1, aS1, 0, 0, 0);
                    if (sh == 0) { const f32x4 n0 = *(const LAS f32x4*)(L + OU_NV + (32 * kk + 8 * kq) * 4), n1 = *(const LAS f32x4*)(L + OU_NV + (32 * kk + 8 * kq + 4) * 4);
                        const v4u qw = __builtin_bit_cast(v4u, qf);
                        qn += pg8::bf_lo(qw.x) * n0[0] + pg8::bf_hi(qw.x) * n0[1] + pg8::bf_lo(qw.y) * n0[2] + pg8::bf_hi(qw.y) * n0[3] + pg8::bf_lo(qw.z) * n1[0] + pg8::bf_hi(qw.z) * n1[1] + pg8::bf_lo(qw.w) * n1[2] + pg8::bf_hi(qw.w) * n1[3]; }
                }
                if (sh == 0) { qn = xor32_sum(xor16_sum(qn)); if (kq == 0) RS[64 + 16 * ti + l15] = qn; }
                const float us0 = T[32 * sh + l15], us1 = T[32 * sh + 16 + l15];
                float rs[4];
#pragma unroll
                for (int r = 0; r < 4; ++r) { const int t = 16 * ti + 4 * kq + r; const float gt = T[64 + t];
                    const int s0 = 32 * sh + l15, s1 = s0 + 16;
                    const float d0 = (s0 <= t) ? aS0[r] * __expf(us0 - gt) : 0.f, d1 = (s1 <= t) ? aS1[r] * __expf(us1 - gt) : 0.f;
                    const unsigned pk = pg8::cvt_pk_bf16(d0, d1);
                    *(LAS unsigned short*)(L + OU_ST + t * ML_PS + s0 * 2) = (unsigned short)(pk & 0xffffu); *(LAS unsigned short*)(L + OU_ST + t * ML_PS + s1 * 2) = (unsigned short)(pk >> 16);
                    rs[r] = pg8::bf_lo(pk) + pg8::bf_hi(pk); }
#pragma unroll
                for (int r = 0; r < 4; ++r) { const float v = row16_sum(rs[r]); if (l15 == 0) atomicAdd((float*)(RS + 16 * ti + 4 * kq + r), v); }
            }
            if (cc + 1 < 8) OU_QCONV();
            __syncthreads();
            v4u ogr[4];
            { unsigned o_ = (unsigned)(((cc * 64 + (F.tid >> 5)) * 1024 + colh + 8 * (F.tid & 31)) * 2); asm volatile("" : "+v"(o_)); const char* g_ = (const char*)(OG + rowb * 1024) + o_;
#pragma unroll
                for (int i = 0; i < 4; ++i) ogr[i] = __builtin_nontemporal_load((const v4u*)(g_ + (size_t)i * 16 * 2048)); }
            { ML_LANES();
#pragma unroll 1
            for (int tt = 0; tt < 2; ++tt) {
                f32x16 aH = {}, aI = {};
#pragma unroll
                for (int kk = 0; kk < 4; ++kk) {
                    const int srow = 16 * kk + 8 * hi + ((lane & 15) >> 2);
                    const LAS unsigned char* vp = L + OU_VS + srow * ML_PK2 + (32 * w + 16 * ((lane >> 4) & 1) + 4 * (lane & 3)) * 2;
                    const s16x4 va = lds_tr(vp), vb = lds_tr(vp + 4 * ML_PK2);
                    const bf16x8 vfk = (bf16x8){va[0], va[1], va[2], va[3], vb[0], vb[1], vb[2], vb[3]};
                    const bf16x8 sf = *(const LAS bf16x8*)(L + OU_ST + (32 * tt + l31) * ML_PS + (16 * kk + 8 * hi) * 2);
                    aH = __builtin_amdgcn_mfma_f32_32x32x16_bf16(sf, vfk, aH, 0, 0, 0);
                }
#pragma unroll
                for (int i = 0; i < 8; ++i)
#pragma unroll
                    for (int s = 0; s < 2; ++s) { const v4u cw = (v4u){Cp[i][4 * s + 0], Cp[i][4 * s + 1], Cp[i][4 * s + 2], Cp[i][4 * s + 3]};
                        const bf16x8 cb = __builtin_bit_cast(bf16x8, cw);
                        const LAS unsigned char* qp = L + OU_QS + (32 * tt + l31) * ML_PQ + (32 * i + 16 * s + 4 * hi) * 2;
                        const s16x4 q0 = *(const LAS s16x4*)qp, q1 = *(const LAS s16x4*)(qp + 16);
                        const bf16x8 qf = (bf16x8){q0[0], q0[1], q0[2], q0[3], q1[0], q1[1], q1[2], q1[3]};
                        aI = __builtin_amdgcn_mfma_f32_32x32x16_bf16(qf, cb, aI, 0, 0, 0); }
#pragma unroll
                for (int g = 0; g < 4; ++g) { const int t0 = 32 * tt + 8 * g + 4 * hi;
                    const f32x4 wi = *(const LAS f32x4*)(T + 192 + t0), cl = *(const LAS f32x4*)(T + 256 + t0), rsum = *(const LAS f32x4*)(RS + t0), qnv = *(const LAS f32x4*)(RS + 64 + t0);
#pragma unroll
                    for (int e = 0; e < 4; ++e) { const float num = aH[4 * g + e] + wi[e] * aI[4 * g + e], den = rsum[e] + wi[e] * qnv[e];
                        const float hv = num * __builtin_amdgcn_rcpf(fmaxf(fabsf(den), cl[e]));
                        *(LAS unsigned short*)(L + OU_HT + (t0 + e) * ML_PQ + (32 * w + l31) * 2) = (unsigned short)(pg8::cvt_pk_bf16(hv, 0.f) & 0xffffu); } }
            }
            float nnew = 0.f;
            if (cc < 7) {
                const float decay = T[320];
                bf16x8 vw[4];
#pragma unroll
                for (int kk = 0; kk < 4; ++kk) { const f32x4 w0 = *(const LAS f32x4*)(T + 128 + 16 * kk + 8 * hi), w1 = *(const LAS f32x4*)(T + 128 + 16 * kk + 8 * hi + 4);
                    const LAS unsigned char* vp = L + OU_VS + (16 * kk + 8 * hi + ((lane & 15) >> 2)) * ML_PK2 + (32 * w + 16 * ((lane >> 4) & 1) + 4 * (lane & 3)) * 2; const s16x4 va = lds_tr(vp), vb = lds_tr(vp + 4 * ML_PK2);
                    const v4u x = __builtin_bit_cast(v4u, (bf16x8){va[0], va[1], va[2], va[3], vb[0], vb[1], vb[2], vb[3]}); v4u y;
                    y.x = pg8::cvt_pk_bf16(pg8::bf_lo(x.x) * w0[0], pg8::bf_hi(x.x) * w0[1]); y.y = pg8::cvt_pk_bf16(pg8::bf_lo(x.y) * w0[2], pg8::bf_hi(x.y) * w0[3]);
                    y.z = pg8::cvt_pk_bf16(pg8::bf_lo(x.z) * w1[0], pg8::bf_hi(x.z) * w1[1]); y.w = pg8::cvt_pk_bf16(pg8::bf_lo(x.w) * w1[2], pg8::bf_hi(x.w) * w1[3]); vw[kk] = __builtin_bit_cast(bf16x8, y); }
                float nsum = 0.f;
                const LAS unsigned char* kbase[4];
#pragma unroll
                for (int bq = 0; bq < 4; ++bq) kbase[bq] = L + OU_KS + (8 * hi + ((lane & 15) >> 2)) * 512 + ((bq ^ ((lane & 15) >> 2)) << 6) + (16 * ((lane >> 4) & 1) + 4 * (lane & 3)) * 2;
                { const LAS unsigned char* kw_ = L + OU_KS + (8 * hi + ((lane & 15) >> 2)) * 512 + (((w & 3) ^ ((lane & 15) >> 2)) << 6) + 256 * (w >> 2) + (16 * ((lane >> 4) & 1) + 4 * (lane & 3)) * 2;
#pragma unroll
                    for (int kk = 0; kk < 4; ++kk) { const f32x4 w0 = *(const LAS f32x4*)(T + 128 + 16 * kk + 8 * hi), w1 = *(const LAS f32x4*)(T + 128 + 16 * kk + 8 * hi + 4);
                        const s16x4 ka = lds_tr(kw_ + (16 * kk) * 512), kb = lds_tr(kw_ + (16 * kk + 4) * 512); const v4u kw = __builtin_bit_cast(v4u, (bf16x8){ka[0], ka[1], ka[2], ka[3], kb[0], kb[1], kb[2], kb[3]});
                        nsum += pg8::bf_lo(kw.x) * w0[0] + pg8::bf_hi(kw.x) * w0[1] + pg8::bf_lo(kw.y) * w0[2] + pg8::bf_hi(kw.y) * w0[3] + pg8::bf_lo(kw.z) * w1[0] + pg8::bf_hi(kw.z) * w1[1] + pg8::bf_lo(kw.w) * w1[2] + pg8::bf_hi(kw.w) * w1[3]; }
                }
#pragma unroll
                for (int i = 0; i < 8; ++i) {
                    f32x16 ct;
#pragma unroll
                    for (int q = 0; q < 8; ++q) { ct[2 * q] = pg8::bf_lo(Cp[i][q]) * decay; ct[2 * q + 1] = pg8::bf_hi(Cp[i][q]) * decay; }
#pragma unroll
                    for (int kk = 0; kk < 4; ++kk) {
                        const int srow = 16 * kk + 8 * hi + ((lane & 15) >> 2);
                        const LAS unsigned char* kp = kbase[i & 3] + (16 * kk) * 512 + 256 * (i >> 2);
                        const s16x4 ka = lds_tr(kp), kb = lds_tr(kp + 4 * 512);
                        const bf16x8 kf = (bf16x8){ka[0], ka[1], ka[2], ka[3], kb[0], kb[1], kb[2], kb[3]};
                        ct = __builtin_amdgcn_mfma_f32_32x32x16_bf16(kf, vw[kk], ct, 0, 0, 0);
                    }
#pragma unroll
                    for (int q = 0; q < 8; ++q) Cp[i][q] = pg8::cvt_pk_bf16(ct[2 * q], ct[2 * q + 1]);
                }
                nsum = xor32_sum(nsum);
                nnew = decay * ((const LAS float*)(L + OU_NV))[32 * w + l31] + nsum;
            }
            __syncthreads();
            if (hi == 0) ((LAS float*)(L + OU_NV))[32 * w + l31] = nnew;
            }
            { ML_LANES();
#pragma unroll
            for (int i = 0; i < 4; ++i) { const int id = tid + 512 * i, t = id >> 5, c8 = id & 31;
                const v4u hx = *(const LAS v4u*)(L + OU_HT + t * ML_PQ + c8 * 16);
                float s2 = (pg8::bf_lo(hx.x) * pg8::bf_lo(hx.x) + pg8::bf_hi(hx.x) * pg8::bf_hi(hx.x)) + (pg8::bf_lo(hx.y) * pg8::bf_lo(hx.y) + pg8::bf_hi(hx.y) * pg8::bf_hi(hx.y))
                         + (pg8::bf_lo(hx.z) * pg8::bf_lo(hx.z) + pg8::bf_hi(hx.z) * pg8::bf_hi(hx.z)) + (pg8::bf_lo(hx.w) * pg8::bf_lo(hx.w) + pg8::bf_hi(hx.w) * pg8::bf_hi(hx.w));
                s2 = xor16_sum(row16_sum(s2));
                const float rsq = __builtin_amdgcn_rsqf(s2 * (1.f / 256.f) + EPS);
                const size_t o = (rowb + (size_t)cc * 64 + t) * 1024 + colh + c8 * 8;
                const v4u g = ogr[i]; const f32x4 m0 = *(const f32x4*)(a.m_norm_w + colh + c8 * 8) * rsq, m1 = *(const f32x4*)(a.m_norm_w + colh + c8 * 8 + 4) * rsq; v4u ov;
                ov.x = pg8::cvt_pk_bf16(pg8::bf_lo(hx.x) * m0[0] * pg8::bf_lo(g.x), pg8::bf_hi(hx.x) * m0[1] * pg8::bf_hi(g.x)); ov.y = pg8::cvt_pk_bf16(pg8::bf_lo(hx.y) * m0[2] * pg8::bf_lo(g.y), pg8::bf_hi(hx.y) * m0[3] * pg8::bf_hi(g.y));
                ov.z = pg8::cvt_pk_bf16(pg8::bf_lo(hx.z) * m1[0] * pg8::bf_lo(g.z), pg8::bf_hi(hx.z) * m1[1] * pg8::bf_hi(g.z)); ov.w = pg8::cvt_pk_bf16(pg8::bf_lo(hx.w) * m1[2] * pg8::bf_lo(g.w), pg8::bf_hi(hx.w) * m1[3] * pg8::bf_hi(g.w));
                asm volatile("" :: "v"(ov.x), "v"(ov.y), "v"(ov.z), "v"(ov.w)); if (!nostore) __builtin_nontemporal_store(ov, (v4u*)(VH + o)); }
            if (tid < 256) ((LAS float*)(L + OU_RS + (tb ^ 1) * 1024))[tid] = 0.f;
            if (cc + 1 < 8) OU_STAGE();
            }
            __syncthreads();
        }
#undef OU_GLOAD
#undef OU_LOAD
#undef OU_STAGE
#undef OU_QCONV
#undef OU_SILU
    }
}
#undef ML_GATES_T

constexpr int N_PHASES = 8;
#ifndef PROBE
#define PROBE 0
#endif
__global__ void __launch_bounds__(NWAVES * 64, 2) skel_fwd(Args args) {
    extern __shared__ __attribute__((aligned(16))) unsigned char lds[];
    Frame F;
    F.lds = (LAS unsigned char*)lds;
    F.MISC = (volatile LAS unsigned*)(F.lds + MISC_OFF);
    F.tid = threadIdx.x; F.lane = F.tid & 63; F.wave = __builtin_amdgcn_readfirstlane(F.tid >> 6);
    F.G = gridDim.x; { const int bx = blockIdx.x; F.vcu = (F.G % 8 == 0) ? (bx % 8) * (F.G / 8) + bx / 8 : bx; }
    unsigned char* ws = args.ws;
    F.ctl = (gu32*)(ws + WS_CTL);
    for (int u = F.tid; u < (LDS_BYTES - LDSCTL_OFF) / 4; u += NWAVES * 64) ((LAS unsigned*)(F.lds + LDSCTL_OFF))[u] = 0u;
    __syncthreads();
    const int lo = args.ph_lo, hi = args.ph_hi;
    XcdBarrier bar; bar.bar = (unsigned*)(F.ctl + CW_BAR); bar.x = 0; bar.st = nullptr;
    if (hi - lo > 1) bar = xcd_barrier_post((unsigned*)(F.ctl + CW_BAR), F.MISC + 8);
#define IN(k) (lo <= (k) && (k) < hi)
#define BOTH(k) (IN(k) && IN((k) + 1))
#define GRID_BAR() xcd_barrier(bar)
    bf16* XN = (bf16*)(ws + WS_XN); bf16* QB = (bf16*)(ws + WS_Q); bf16* KB = (bf16*)(ws + WS_K); bf16* VB = (bf16*)(ws + WS_V); bf16* AZ = (bf16*)(ws + WS_AZ);
    bf16* MQ = (bf16*)(ws + WS_MQ); bf16* MK = (bf16*)(ws + WS_MK); bf16* MV = (bf16*)(ws + WS_MV); bf16* OG = (bf16*)(ws + WS_OG);
    bf16* GA = (bf16*)args.out; bf16* GM = (bf16*)args.out + (size_t)M * D;

    if (IN(0)) { p0_prologue(F, args); weight_copies(F, args); if (BOTH(0)) GRID_BAR(); }
    if (IN(1)) { p1_norm(F, args); if (BOTH(1)) GRID_BAR(); }
    if (IN(2)) {
        pg8::Gemm g{XN, (const bf16*)(ws + WS_WIN), D, D / 64};
        pg8::StaticOrder S; S.init(M, NPROJ, F.G, (int)blockIdx.x);
        pg8::EpiProj E{QB, KB, VB, AZ, MQ, MK, MV, OG, GA, GM, args.pos};
        pg8::gemm_phase<pg8::EpiProj, pg8::StaticOrder, true>(F.lds + RING_OFF, g, S, E);
        if (PROBE == 2) pg8::gemm_phase<pg8::EpiProj, pg8::StaticOrder, true>(F.lds + RING_OFF, g, S, E);
        if (BOTH(2)) GRID_BAR();
    }
    if (IN(3)) { attn_phase(F, args); if (PROBE == 3) attn_phase(F, args, args.pad); if (BOTH(3)) GRID_BAR(); }
    if (IN(4)) { mlstm_usum_phase(F, args); if (PROBE == 4) mlstm_usum_phase(F, args); GRID_BAR(); mlstm_combine_phase(F, args); if (BOTH(4)) GRID_BAR(); }
    if (IN(5)) { mlstm_out_phase(F, args); if (PROBE == 5) mlstm_out_phase(F, args, args.pad); if (BOTH(5)) GRID_BAR(); }
    if (IN(6)) {
        pg8::Gemm g{AZ, (const bf16*)(ws + WS_WATT), D, 2 * D / 64};
        static_assert(WS_MV - WS_AZ == (size_t)pg8::EpiMerge::DELTA_A && WS_WM - WS_WATT == (size_t)pg8::EpiMerge::DELTA_B, "segment deltas");
        pg8::StaticOrder S; S.init(M, D, F.G, (int)blockIdx.x);
        pg8::EpiMerge E{GA, GM, XN};
        pg8::gemm_phase<pg8::EpiMerge, pg8::StaticOrder, true>(F.lds + RING_OFF, g, S, E);
        if (PROBE == 6) pg8::gemm_phase<pg8::EpiMerge, pg8::StaticOrder, true>(F.lds + RING_OFF, g, S, E);
        if (BOTH(6)) GRID_BAR();
    }
    if (IN(7)) {
        pg8::Gemm g{XN, (const bf16*)(ws + WS_WOUT), D, D / 64};
        pg8::StaticOrder S; S.init(M, D, F.G, (int)blockIdx.x);
        struct BarCall { unsigned* cnt; unsigned* tmo; __device__ __forceinline__ void operator()(int pm) const {
            asm volatile("s_waitcnt vmcnt(0)" ::: "memory"); __syncthreads();
            if (threadIdx.x == 0) { unsigned* c = cnt + 16 * pm; (void)__hip_atomic_fetch_add(c, 1u, __ATOMIC_RELAXED, __HIP_MEMORY_SCOPE_AGENT); XB_SPIN(__hip_atomic_load(c, __ATOMIC_RELAXED, __HIP_MEMORY_SCOPE_AGENT) < 4u, tmo); }
            __syncthreads(); } };
        pg8::EpiOutNorm<BarCall> E{args.x, (const float*)(ws + WS_MOD), args.b_ada, args.fnorm_w, args.out, (float*)(ws + WS_RSUM), BarCall{(unsigned*)(ws + WS_PCNT), (unsigned*)(F.ctl + CW_BAR)}};
        pg8::gemm_phase<pg8::EpiOutNorm<BarCall>, pg8::StaticOrder, true>(F.lds + RING_OFF, g, S, E);
    }
#undef IN
#undef BOTH
#undef GRID_BAR
}

extern "C" void kernel_launch(void* const* d_in, const int* in_sizes, int n_in, void* d_out, int out_size, void* d_ws, size_t ws_size, hipStream_t stream) {
    static int grid = 0;
    if (grid == 0) {
        if (n_in != 16 || in_sizes[0] != M * D || out_size != M * D || ws_size < WS_END) { fprintf(stderr, "kernel_launch: unexpected shapes (n_in %d, in0 %d, out %d, ws %zu); nothing launched\n", n_in, n_in > 0 ? in_sizes[0] : -1, out_size, ws_size); grid = -1; return; }
        int dev = 0, cus = 0, per_cu = 0;
        if (hipGetDevice(&dev) != hipSuccess || hipDeviceGetAttribute(&cus, hipDeviceAttributeMultiprocessorCount, dev) != hipSuccess) { grid = -1; return; }
        if (hipFuncSetAttribute((const void*)skel_fwd, hipFuncAttributeMaxDynamicSharedMemorySize, LDS_BYTES) != hipSuccess) { fprintf(stderr, "kernel_launch: hipFuncSetAttribute failed\n"); grid = -1; return; }
        if (hipOccupancyMaxActiveBlocksPerMultiprocessor(&per_cu, (const void*)skel_fwd, NWAVES * 64, LDS_BYTES) != hipSuccess || per_cu < 1) fprintf(stderr, "kernel_launch: note: occupancy query reports %d\n", per_cu);
        (void)hipGetLastError();
        grid = cus;
    }
    if (grid < 0) return;
    if (hipMemsetAsync((char*)d_ws + WS_CTL, 0, CTL_ZERO_BYTES, stream) != hipSuccess) return;
    Args a{};
    a.x = (const float*)d_in[0]; a.c = (const float*)d_in[1]; a.pos = (const int*)d_in[2]; a.w_ada = (const float*)d_in[3]; a.b_ada = (const float*)d_in[4]; a.norm_w = (const float*)d_in[5];
    a.w_in = (const float*)d_in[6]; a.b_if = (const float*)d_in[7]; a.sinks = (const float*)d_in[8]; a.conv_q = (const float*)d_in[9]; a.conv_k = (const float*)d_in[10]; a.m_norm_w = (const float*)d_in[11];
    a.w_att = (const float*)d_in[12]; a.w_m = (const float*)d_in[13]; a.w_out = (const float*)d_in[14]; a.fnorm_w = (const float*)d_in[15];
    a.out = (float*)d_out; a.ws = (unsigned char*)d_ws; a.pad = PROBE ? 1 : 0;
    unsigned char* ws = (unsigned char*)d_ws;
    auto run = [&](int lo, int hi, int li) { a.ph_lo = lo; a.ph_hi = hi; a.li = li; hipLaunchKernelGGL(skel_fwd, dim3(grid), dim3(NWAVES * 64), LDS_BYTES, stream, a); };
    run(0, N_PHASES, 0);
}
```
